# Optimizing an MI355X kernel written in HIP

```python
import math
import jax
import jax.numpy as jnp
from jax import lax
import numpy as np

D_MODEL = 1024
BATCH = 16
SEQ = 256
DEPTH = 2
DEC_BATCH = 8
DEC_SEQ = 4096
PAST_LEN = 256

GRID_W = 64
BLOCK = 128
N_AB = (DEPTH + 1) // 2
N_CD = DEPTH // 2
A_HEADS = 8
A_KV = 2
A_HD = 64
A_WIN = 128
B_HEADS = 4
B_HD = 64
B_VD = 2 * B_HD
C_HEADS = 4
C_DK = 128
C_DV = 128
D_HEADS = 8
D_KV = 2
D_HD = 64
A_W = A_HEADS * A_HD
B_W = B_HEADS * B_VD
C_W = C_HEADS * C_DV
D_W = D_HEADS * D_HD
AB_SPLIT = (A_HEADS * A_HD, A_KV * A_HD, A_KV * A_HD, B_HEADS * 2 * B_HD, B_HEADS * 2 * B_HD, B_HEADS * B_VD, A_W, B_W)
CD_SPLIT = (C_HEADS * C_DK, C_HEADS * C_DK, C_HEADS * C_DV, D_HEADS * D_HD, D_KV * D_HD, D_KV * D_HD, C_W, D_W)
P_AB = sum(AB_SPLIT)
P_CD = sum(CD_SPLIT)
ROPE_THETA = 10000.0
EPS = 1e-6
NEG = -1e30
F32 = jnp.float32

kernel_name = 'hybrid_diffusion_prefix_step'


def rms_norm(x, g):
    xf = x.astype(F32)
    y = xf * lax.rsqrt(jnp.mean(xf * xf, axis=-1, keepdims=True) + EPS)
    return (y * g.astype(F32)).astype(x.dtype)


def adaln(x, cond, g, w, b):
    m = jax.nn.silu(cond) @ w + b
    shift, scale, gate = jnp.split(m[:, None, :], 3, axis=-1)
    return rms_norm(x, g) * (1 + scale) + shift, gate


def split_cols(z, sizes):
    return jnp.split(z, [int(s) for s in np.cumsum(sizes)[:-1]], axis=-1)


def heads(t, h):
    bsz, n, w = t.shape
    return t.reshape(bsz, n, h, w // h).transpose(0, 2, 1, 3)


def gqa_heads(t, g, h):
    bsz, n, w = t.shape
    return t.reshape(bsz, n, g, h // g, w // h).transpose(0, 2, 3, 1, 4)


def merge_heads(o):
    bsz, h, n, d = o.shape
    return o.transpose(0, 2, 1, 3).reshape(bsz, n, h * d)


def merge_gqa(o):
    bsz, g, r, n, d = o.shape
    return o.transpose(0, 3, 1, 2, 4).reshape(bsz, n, g * r * d)


def grid_rope(n, hd):
    rows = n // GRID_W
    row = jnp.repeat(jnp.arange(rows, dtype=F32), GRID_W)
    col = jnp.tile(jnp.arange(GRID_W, dtype=F32), rows)
    nf = hd // 4
    inv = ROPE_THETA ** (-jnp.arange(nf, dtype=F32) / nf)
    ang = jnp.concatenate([row[:, None] * inv, col[:, None] * inv], axis=-1)
    return jnp.cos(ang), jnp.sin(ang)


def rope(x, cs):
    cos, sin = cs
    x = x.astype(F32)
    half = x.shape[-1] // 2
    x1, x2 = x[..., :half], x[..., half:]
    return jnp.concatenate([x1 * cos - x2 * sin, x2 * cos + x1 * sin], axis=-1)


def to_blocks(t):
    *lead, n, d = t.shape
    return jnp.moveaxis(t.reshape(*lead, n // BLOCK, BLOCK, d), -3, 0)


def from_blocks(o):
    o = jnp.moveaxis(o, 0, -3)
    *lead, nb, bl, d = o.shape
    return o.reshape(*lead, nb * bl, d)


def softmax_sink(s, sink):
    if sink is None:
        return jax.nn.softmax(s, axis=-1)
    sk = jnp.broadcast_to(sink.astype(F32)[None, :, :, None, None], s.shape[:-1] + (1,))
    return jax.nn.softmax(jnp.concatenate([s, sk], axis=-1), axis=-1)[..., :-1]


def gqa_attention(q, k, v, sink):
    scale = q.shape[-1] ** -0.5

    def one(qi):
        s = jnp.einsum('bgrqd,bgkd->bgrqk', qi, k) * scale
        p = softmax_sink(s, sink)
        return jnp.einsum('bgrqk,bgkd->bgrqd', p, v)

    return from_blocks(lax.map(one, to_blocks(q)))


def window_attention(q, k, v, k_ctx, v_ctx, sink):
    n = q.shape[-2]
    scale = q.shape[-1] ** -0.5
    pad = ((0, 0), (0, 0), (BLOCK, BLOCK), (0, 0))
    kp, vp = jnp.pad(k, pad), jnp.pad(v, pad)
    r = jnp.arange(BLOCK)[:, None]
    m = jnp.arange(3 * BLOCK)[None, :]
    band = (m - r >= BLOCK - A_WIN) & (m - r <= BLOCK + A_WIN)

    def one(args):
        qi, b = args
        kw = lax.dynamic_slice_in_dim(kp, b * BLOCK, 3 * BLOCK, axis=2)
        vw = lax.dynamic_slice_in_dim(vp, b * BLOCK, 3 * BLOCK, axis=2)
        j = (b - 1) * BLOCK + m
        valid = band & (j >= 0) & (j < n)
        s_w = jnp.where(valid, jnp.einsum('bgrqd,bgkd->bgrqk', qi, kw) * scale, NEG)
        s_c = jnp.einsum('bgrqd,bgkd->bgrqk', qi, k_ctx) * scale
        p = softmax_sink(jnp.concatenate([s_w, s_c], axis=-1), sink)
        return (jnp.einsum('bgrqk,bgkd->bgrqd', p[..., :3 * BLOCK], vw)
                + jnp.einsum('bgrqk,bgkd->bgrqd', p[..., 3 * BLOCK:], v_ctx))

    return from_blocks(lax.map(one, (to_blocks(q), jnp.arange(n // BLOCK))))


def diff_attention(q1, q2, k1, k2, v, lam):
    scale = q1.shape[-1] ** -0.5

    def one(args):
        a, b = args
        p1 = jax.nn.softmax(jnp.einsum('bhqd,bhkd->bhqk', a, k1) * scale, axis=-1)
        p2 = jax.nn.softmax(jnp.einsum('bhqd,bhkd->bhqk', b, k2) * scale, axis=-1)
        return jnp.einsum('bhqk,bhke->bhqe', p1 - lam * p2, v)

    return from_blocks(lax.map(one, (to_blocks(q1), to_blocks(q2))))


def retention_chunks(q, k, v, lg, s0, inclusive):
    inc = 1 if inclusive else 0
    idx = jnp.arange(BLOCK, dtype=F32)
    rel = idx[:, None] - idx[None, :] - (1 - inc)
    mask = rel >= 0
    dmat = jnp.where(mask, jnp.exp(lg[:, None, None] * jnp.where(mask, rel, 0.0)), 0.0)
    cross = jnp.exp(lg[:, None] * (idx + inc))[None, :, :, None]
    kdec = jnp.exp(lg[:, None] * (BLOCK - 1 - idx))[None, :, :, None]
    cdec = jnp.exp(lg * BLOCK)[None, :, None, None]

    def step(state, xs):
        qc, kc, vc = xs
        att = jnp.einsum('bhid,bhjd->bhij', qc, kc) * dmat
        o = jnp.einsum('bhij,bhje->bhie', att, vc) + cross * jnp.einsum('bhid,bhde->bhie', qc, state)
        state = cdec * state + jnp.einsum('bhjd,bhje->bhde', kc * kdec, vc)
        return state, o

    s, o = lax.scan(step, s0, (to_blocks(q), to_blocks(k), to_blocks(v)))
    return from_blocks(o), s


def retention_bidir(q, k, v, lg_f, lg_b, s_f, s_b):
    o_f, s_f = retention_chunks(q, k, v, lg_f, s_f, True)
    o_b, s_b = retention_chunks(q[:, :, ::-1], k[:, :, ::-1], v[:, :, ::-1], lg_b, s_b, False)
    return o_f + o_b[:, :, ::-1], s_f, s_b


def head_group_norm(o, g):
    mu = jnp.mean(o, axis=-1, keepdims=True)
    var = jnp.mean(jnp.square(o - mu), axis=-1, keepdims=True)
    return (o - mu) * lax.rsqrt(var + EPS) * g.astype(F32)[None, :, None, :]


def decay(p):
    return -jnp.exp(p.astype(F32))


def diff_lambda(lq1, lk1, lq2, lk2, lam_init):
    e = lambda a, b: jnp.exp(jnp.sum(a.astype(F32) * b.astype(F32)))
    return e(lq1, lk1) - e(lq2, lk2) + lam_init


def gated_out(o1, o2, g1, g2, w_out):
    dt = g1.dtype
    y = jnp.concatenate([o1.astype(dt) * jax.nn.silu(g1), o2.astype(dt) * jax.nn.silu(g2)], axis=-1)
    return y @ w_out


def ab_project(h, w_in):
    qa, ka, va, qb, kb, vb, ga, gb = split_cols(h @ w_in, AB_SPLIT)
    return (gqa_heads(qa, A_KV, A_HEADS).astype(F32), heads(ka, A_KV), heads(va, A_KV),
            heads(qb, B_HEADS).astype(F32), heads(kb, B_HEADS), heads(vb, B_HEADS), ga, gb)


def ab_merge(oa, ob, ga, gb, w_out, b_norm_g, lam_init):
    ob = rms_norm(ob, b_norm_g) * (1.0 - lam_init)
    return gated_out(merge_gqa(oa), merge_heads(ob), ga, gb, w_out)


def ab_context(h, w_in, w_out, sink, lq1, lk1, lq2, lk2, b_norm_g, lam_init):
    qa, ka, va, qb, kb, vb, ga, gb = ab_project(h, w_in)
    oa = gqa_attention(qa, ka.astype(F32), va.astype(F32), sink.reshape(A_KV, A_HEADS // A_KV))
    lam = diff_lambda(lq1, lk1, lq2, lk2, lam_init)
    kbf = kb.astype(F32)
    ob = diff_attention(qb[..., :B_HD], qb[..., B_HD:], kbf[..., :B_HD], kbf[..., B_HD:], vb.astype(F32), lam)
    return ab_merge(oa, ob, ga, gb, w_out, b_norm_g, lam_init), ka, va, kb, vb


def ab_latent(h, ka_c, va_c, kb_c, vb_c, w_in, w_out, sink, lq1, lk1, lq2, lk2, b_norm_g, lam_init):
    qa, ka, va, qb, kb, vb, ga, gb = ab_project(h, w_in)
    n = h.shape[1]
    cs_a = grid_rope(n, A_HD)
    cs_b = grid_rope(n, B_HD)
    oa = window_attention(rope(qa, cs_a), rope(ka, cs_a), va.astype(F32), ka_c.astype(F32), va_c.astype(F32),
                          sink.reshape(A_KV, A_HEADS // A_KV))
    lam = diff_lambda(lq1, lk1, lq2, lk2, lam_init)
    kbc = kb_c.astype(F32)
    k1 = jnp.concatenate([rope(kb[..., :B_HD], cs_b), kbc[..., :B_HD]], axis=2)
    k2 = jnp.concatenate([rope(kb[..., B_HD:], cs_b), kbc[..., B_HD:]], axis=2)
    v = jnp.concatenate([vb.astype(F32), vb_c.astype(F32)], axis=2)
    ob = diff_attention(rope(qb[..., :B_HD], cs_b), rope(qb[..., B_HD:], cs_b), k1, k2, v, lam)
    return ab_merge(oa, ob, ga, gb, w_out, b_norm_g, lam_init)


def cd_project(h, w_in, dqg, dkg):
    qc, kc, vc, qd, kd, vd, gc, gd = split_cols(h @ w_in, CD_SPLIT)
    qc = heads(qc, C_HEADS).astype(F32)
    kc = heads(kc, C_HEADS).astype(F32) * (C_DK ** -0.5)
    vc = heads(vc, C_HEADS).astype(F32)
    qd = rms_norm(gqa_heads(qd, D_KV, D_HEADS).astype(F32), dqg)
    kd = rms_norm(heads(kd, D_KV), dkg)
    vd = heads(vd, D_KV)
    return qc, kc, vc, qd, kd, vd, gc, gd


def cd_merge(oc, od, gc, gd, w_out, c_norm_g):
    return gated_out(merge_heads(head_group_norm(oc, c_norm_g)), merge_gqa(od), gc, gd, w_out)


def cd_context(h, w_in, w_out, dec_f, dec_b, c_norm_g, dqg, dkg):
    qc, kc, vc, qd, kd, vd, gc, gd = cd_project(h, w_in, dqg, dkg)
    zero = jnp.zeros(qc.shape[:2] + (C_DK, C_DV), F32)
    oc, s_f, s_b = retention_bidir(qc, kc, vc, decay(dec_f), decay(dec_b), zero, zero)
    od = gqa_attention(qd, kd.astype(F32), vd.astype(F32), None)
    dt = h.dtype
    return cd_merge(oc, od, gc, gd, w_out, c_norm_g), s_f.astype(dt), s_b.astype(dt), kd, vd


def cd_latent(h, s_f, s_b, kd_c, vd_c, w_in, w_out, dec_f, dec_b, c_norm_g, dqg, dkg):
    qc, kc, vc, qd, kd, vd, gc, gd = cd_project(h, w_in, dqg, dkg)
    oc, _, _ = retention_bidir(qc, kc, vc, decay(dec_f), decay(dec_b), s_f.astype(F32), s_b.astype(F32))
    cs = grid_rope(h.shape[1], D_HD)
    k = jnp.concatenate([rope(kd, cs), kd_c.astype(F32)], axis=2)
    v = jnp.concatenate([vd.astype(F32), vd_c.astype(F32)], axis=2)
    od = gqa_attention(rope(qd, cs), k, v, None)
    return cd_merge(oc, od, gc, gd, w_out, c_norm_g)


def setup_inputs(seed: int = 0) -> dict:
    key = jax.random.key(seed)
    ks = iter(jax.random.split(key, 48))

    def nrm(shape, scale=1.0):
        return jax.random.normal(next(ks), shape, F32) * scale

    base = jnp.log(-jnp.log1p(-(2.0 ** (-5.0 - jnp.arange(C_HEADS, dtype=F32)))))
    return {
        'x_prompt': nrm((BATCH, SEQ, D_MODEL)),
        'x_sample': nrm((DEC_BATCH, DEC_SEQ, D_MODEL)),
        'cache_a_k': nrm((DEC_BATCH, N_AB, A_KV, PAST_LEN, A_HD)),
        'cache_a_v': nrm((DEC_BATCH, N_AB, A_KV, PAST_LEN, A_HD)),
        'cache_b_k': nrm((DEC_BATCH, N_AB, B_HEADS, PAST_LEN, 2 * B_HD)),
        'cache_b_v': nrm((DEC_BATCH, N_AB, B_HEADS, PAST_LEN, B_VD)),
        'state_c_fwd': nrm((DEC_BATCH, N_CD, C_HEADS, C_DK, C_DV), 0.5),
        'state_c_bwd': nrm((DEC_BATCH, N_CD, C_HEADS, C_DK, C_DV), 0.5),
        'cache_d_k': nrm((DEC_BATCH, N_CD, D_KV, PAST_LEN, D_HD)),
        'cache_d_v': nrm((DEC_BATCH, N_CD, D_KV, PAST_LEN, D_HD)),
        'c': nrm((DEC_BATCH, D_MODEL)),
        'c_ctx': nrm((D_MODEL,)),
        'norm_g': 1.0 + nrm((DEPTH, D_MODEL), 0.02),
        'mod_w': nrm((DEPTH, D_MODEL, 3 * D_MODEL), D_MODEL ** -0.5),
        'mod_b': nrm((DEPTH, 3 * D_MODEL), 0.02),
        'ab_w_in': nrm((N_AB, D_MODEL, P_AB), D_MODEL ** -0.5),
        'ab_w_out': nrm((N_AB, A_W + B_W, D_MODEL), (A_W + B_W) ** -0.5),
        'a_sink': nrm((N_AB, A_HEADS), 0.5),
        'b_lq1': nrm((N_AB, B_HD), 0.1),
        'b_lk1': nrm((N_AB, B_HD), 0.1),
        'b_lq2': nrm((N_AB, B_HD), 0.1),
        'b_lk2': nrm((N_AB, B_HD), 0.1),
        'b_norm_g': 1.0 + nrm((N_AB, B_VD), 0.02),
        'cd_w_in': nrm((N_CD, D_MODEL, P_CD), D_MODEL ** -0.5),
        'cd_w_out': nrm((N_CD, C_W + D_W, D_MODEL), (C_W + D_W) ** -0.5),
        'c_decay_f': base + nrm((N_CD, C_HEADS), 0.05),
        'c_decay_b': base + nrm((N_CD, C_HEADS), 0.05),
        'c_norm_g': 1.0 + nrm((N_CD, C_HEADS, C_DV), 0.02),
        'd_q_norm_g': 1.0 + nrm((N_CD, D_HD), 0.02),
        'd_k_norm_g': 1.0 + nrm((N_CD, D_HD), 0.02),
        'final_g': 1.0 + nrm((D_MODEL,), 0.02),
    }


def reference(x_prompt, x_sample, cache_a_k, cache_a_v, cache_b_k, cache_b_v, state_c_fwd, state_c_bwd,
              cache_d_k, cache_d_v, c, c_ctx, norm_g, mod_w, mod_b, ab_w_in, ab_w_out, a_sink,
              b_lq1, b_lk1, b_lq2, b_lk2, b_norm_g, cd_w_in, cd_w_out, c_decay_f, c_decay_b, c_norm_g,
              d_q_norm_g, d_k_norm_g, final_g):
    xp, xs = x_prompt, x_sample
    c_ctx_row = c_ctx[None, :]
    a_k, a_v, b_k, b_v, c_f, c_b, d_k, d_v = [], [], [], [], [], [], [], []
    for layer in range(DEPTH):
        i = layer // 2
        hp, gate_p = adaln(xp, c_ctx_row, norm_g[layer], mod_w[layer], mod_b[layer])
        hs, gate_s = adaln(xs, c, norm_g[layer], mod_w[layer], mod_b[layer])
        if layer % 2 == 0:
            lam_init = 0.8 - 0.6 * math.exp(-0.3 * layer)
            ab_w = (ab_w_in[i], ab_w_out[i], a_sink[i], b_lq1[i], b_lk1[i], b_lq2[i], b_lk2[i], b_norm_g[i], lam_init)
            yp, ka, va, kb, vb = ab_context(hp, *ab_w)
            ys = ab_latent(hs, cache_a_k[:, i], cache_a_v[:, i], cache_b_k[:, i], cache_b_v[:, i], *ab_w)
            a_k.append(ka)
            a_v.append(va)
            b_k.append(kb)
            b_v.append(vb)
        else:
            cd_w = (cd_w_in[i], cd_w_out[i], c_decay_f[i], c_decay_b[i], c_norm_g[i], d_q_norm_g[i], d_k_norm_g[i])
            yp, sf, sb, kd, vd = cd_context(hp, *cd_w)
            ys = cd_latent(hs, state_c_fwd[:, i], state_c_bwd[:, i], cache_d_k[:, i], cache_d_v[:, i], *cd_w)
            c_f.append(sf)
            c_b.append(sb)
            d_k.append(kd)
            d_v.append(vd)
        xp = xp + gate_p * yp
        xs = xs + gate_s * ys
    y_prompt = rms_norm(xp, final_g)
    y_sample = rms_norm(xs, final_g)
    new_a_k = jnp.stack(a_k, axis=1)
    new_a_v = jnp.stack(a_v, axis=1)
    new_b_k = jnp.stack(b_k, axis=1)
    new_b_v = jnp.stack(b_v, axis=1)
    new_c_fwd = jnp.stack(c_f, axis=1)
    new_c_bwd = jnp.stack(c_b, axis=1)
    new_d_k = jnp.stack(d_k, axis=1)
    new_d_v = jnp.stack(d_v, axis=1)
    return (y_prompt, y_sample, new_a_k, new_a_v, new_b_k, new_b_v, new_c_fwd, new_c_bwd, new_d_k, new_d_v)
```

```cpp
#include <hip/hip_runtime.h>
#include <hip/hip_cooperative_groups.h>
#include <cstdio>
#include <cstdint>
namespace cg = cooperative_groups;
namespace pg8 {
#define PG8_LAS __attribute__((address_space(3)))
typedef unsigned short bf16_t;
typedef short bf16x8 __attribute__((ext_vector_type(8)));
typedef float f32x4 __attribute__((ext_vector_type(4)));
typedef unsigned u32x4 __attribute__((ext_vector_type(4)));
constexpr int BM = 256, BK = 64, HALF = 128, HTB = HALF * BK * 2  , STAGE_BYTES = 8 * HTB, NXCD = 8, WGM = 8;

__host__ __device__ __forceinline__ int lds_byte(int r, int c) { const int st = (r >> 4) * 2 + (c >> 5), rr = r & 15, cc = c & 31, ob = rr * 64 + cc * 2; return st * 1024 + (ob ^ (((ob >> 9) & 1) << 5)); }
__host__ __device__ __forceinline__ void stage_rc(int b, int& R, int& C) { const int st = b / 1024, sb = b % 1024, swz = sb ^ (((sb >> 9) & 1) << 5); R = (st >> 1) * 16 + swz / 64; C = (st & 1) * 32 + (swz % 64) / 2; }
__host__ __device__ __forceinline__ int perm32(int rho) { const int n = rho >> 4, i = rho & 15; return 8 * (i >> 2) + 4 * n + (i & 3); }

struct Unit { int pm, pn; };
struct Gemm { const bf16_t* A; const bf16_t* Bt; int M, N, K; };

struct StaticOrder {
    int nM, nN, nwg, G, c;
    __host__ __device__ void init(int M, int N, int G_, int c_) { nM = M / BM; nN = N / BM; nwg = nM * nN; G = G_; c = c_; }
    __host__ __device__ bool next(int i, Unit& u) const {
        const long L = (long)i * G + c; if (L >= nwg) return false;
        int wgid = (int)L; { const int q = nwg / NXCD, r = nwg % NXCD, xcd = wgid % NXCD, off = wgid / NXCD; wgid = (xcd < r ? xcd * (q + 1) : r * (q + 1) + (xcd - r) * q) + off; }
        const int nig = WGM * nN, gid = wgid / nig, fm = gid * WGM, gsz = (nM - fm) < WGM ? (nM - fm) : WGM;
        u.pm = fm + ((wgid % nig) % gsz); u.pn = (wgid % nig) / gsz; return true;
    }
    __device__ __forceinline__ void a_ready(const Unit&) const {}
    __device__ __forceinline__ void done(const Unit&) const {}
};

__device__ __forceinline__ unsigned cvt_pk_bf16(float lo, float hi) { unsigned r; asm volatile("v_cvt_pk_bf16_f32 %0, %1, %2" : "=v"(r) : "v"(lo), "v"(hi)); return r; }
typedef float f32x2 __attribute__((ext_vector_type(2)));
__device__ __forceinline__ f32x2 gelu_pk(f32x2 v) {
    const f32x2 av = __builtin_elementwise_abs(v), d = av * 0.2316418882f + 1.0f;
    f32x2 t; t.x = __builtin_amdgcn_rcpf(d.x); t.y = __builtin_amdgcn_rcpf(d.y);
    f32x2 q = t * 0.5307027145f + (-0.7265760135f); q = q * t + 0.7107068705f; q = q * t + (-0.142248368f); q = q * t + 0.127414796f; q = q * t;
    const f32x2 s = (v * v) * (-0.72134752044f);
    f32x2 e; e.x = __builtin_amdgcn_exp2f(s.x); e.y = __builtin_amdgcn_exp2f(s.y);
    const f32x2 m = v * (q * e), r = v - m;
    f32x2 o; o.x = v.x < 0.f ? m.x : r.x; o.y = v.y < 0.f ? m.y : r.y; return o;
}

template <int ACT  > struct EpiBf16 {
    static constexpr bool PERM = true, AFTER_DRAIN = false; static_assert(ACT == 0 || ACT == 1, "EpiBf16: ACT is 0 (none) or 1 (gelu_pk)");
    bf16_t* O; int ldc; const float* bias; int split_cols; size_t split_stride; float scale0;
    __device__ __forceinline__ void operator()(const f32x4 (&acc)[2][2][4][2], const Unit& u, int wr, int wc, int fr, int fq) const {
        const int row0 = u.pm * BM + wr * 64 + fr; int colt = u.pn * BM; bf16_t* base = O;
        float sc = 1.f; if (split_cols) { const int t = colt / split_cols; base += (size_t)t * split_stride; colt -= t * split_cols; if (t == 0) sc = scale0; }
        const int col0 = colt + wc * 32 + 8 * fq, bcol0 = u.pn * BM + wc * 32 + 8 * fq;
        f32x4 bv[2][2];
#pragma unroll
        for (int bj = 0; bj < 2; ++bj)
#pragma unroll
            for (int n = 0; n < 2; ++n) bv[bj][n] = bias ? *(const f32x4*)(bias + bcol0 + bj * HALF + 4 * n) : (f32x4){0.f, 0.f, 0.f, 0.f};
#pragma unroll
        for (int ai = 0; ai < 2; ++ai)
#pragma unroll
            for (int m = 0; m < 4; ++m) { bf16_t* rowp = base + (size_t)(row0 + ai * HALF + m * 16) * ldc + col0;
#pragma unroll
                for (int bj = 0; bj < 2; ++bj) { f32x4 v0 = acc[ai][bj][m][0] + bv[bj][0], v1 = acc[ai][bj][m][1] + bv[bj][1];
                    if (ACT == 1) { f32x2 a = gelu_pk((f32x2){v0[0], v0[1]}), b = gelu_pk((f32x2){v0[2], v0[3]}), c = gelu_pk((f32x2){v1[0], v1[1]}), d = gelu_pk((f32x2){v1[2], v1[3]});
                        v0 = (f32x4){a.x, a.y, b.x, b.y}; v1 = (f32x4){c.x, c.y, d.x, d.y}; }
                    v0 = v0 * sc; v1 = v1 * sc; u32x4 w; w.x = cvt_pk_bf16(v0[0], v0[1]); w.y = cvt_pk_bf16(v0[2], v0[3]); w.z = cvt_pk_bf16(v1[0], v1[1]); w.w = cvt_pk_bf16(v1[2], v1[3]);
                    __builtin_nontemporal_store(w, (u32x4*)(rowp + bj * HALF)); } }
    }
};
template <class Epi, class Sched, bool ALIGN_EPI = false, bool SP2 = false>
__device__ __forceinline__ void gemm_phase(PG8_LAS unsigned char* lds, const Gemm g, const Sched& S, const Epi& E) {
    int tid_l = threadIdx.x; asm volatile("" : "+v"(tid_l));
    const int tid = tid_l, wid = __builtin_amdgcn_readfirstlane(tid >> 6), lane = tid & 63, wr = wid >> 2, wc = wid & 3, fr = lane & 15, fq = lane >> 4;
    const int K = g.K, nt = K / BK;
    unsigned voffA[2], voffB[2];
#pragma unroll
    for (int i = 0; i < 2; ++i) { int R, C; stage_rc(tid * 16 + i * 8192, R, C); const int Rb = Epi::PERM ? ((R & ~31) + perm32(R & 31)) : R;
        voffA[i] = (unsigned)(R * K + C) * 2u; voffB[i] = (unsigned)(Rb * K + C) * 2u; }
    const size_t kstep = (size_t)(BK * 2);
    const size_t hstep = (size_t)HALF * K * 2;
    const size_t tstep = 2 * hstep;
    const unsigned ldsw = (unsigned)wid * 1024u;
    const int aoff = lds_byte(wr * 64 + fr, fq * 8), boff = lds_byte(wc * 32 + fr, fq * 8);
#define PG8_SA(b, h) (((b) * 2 + (h)) * HTB)
#define PG8_SB(b, h) ((4 + (b) * 2 + (h)) * HTB)
#define PG8_STAGE(bufoff, gbase, voff) do { _Pragma("unroll") for (int _i = 0; _i < 2; ++_i) \
        __builtin_amdgcn_global_load_lds((const unsigned*)((const char*)(gbase) + (voff)[_i]), (PG8_LAS unsigned*)(lds + (bufoff) + ldsw + _i * 8192), 16, 0, 0); } while (0)
#define PG8_LDA(dst, b, h) do { _Pragma("unroll") for (int m = 0; m < 4; ++m) _Pragma("unroll") for (int k = 0; k < 2; ++k) dst[m][k] = *(const PG8_LAS bf16x8*)(lds + PG8_SA(b, h) + aoff + m * 2048 + k * 1024); } while (0)
#define PG8_LDB(dst, b, h) do { _Pragma("unroll") for (int n = 0; n < 2; ++n) _Pragma("unroll") for (int k = 0; k < 2; ++k) dst[n][k] = *(const PG8_LAS bf16x8*)(lds + PG8_SB(b, h) + boff + n * 2048 + k * 1024); } while (0)
#define PG8_MMA(ai, bj, At, Bt) do { __builtin_amdgcn_s_setprio(1); _Pragma("unroll") for (int m = 0; m < 4; ++m) _Pragma("unroll") for (int n = 0; n < 2; ++n) _Pragma("unroll") for (int k = 0; k < 2; ++k) \
        acc[ai][bj][m][n] = __builtin_amdgcn_mfma_f32_16x16x32_bf16(Bt[n][k], At[m][k], acc[ai][bj][m][n], 0, 0, 0); __builtin_amdgcn_s_setprio(0); } while (0)
#define PG8_WAIT_V(n) asm volatile("s_waitcnt vmcnt(" #n ")" ::: "memory")
#define PG8_WAIT_L(n) asm volatile("s_waitcnt lgkmcnt(" #n ")" ::: "memory")
#define PG8_BAR __builtin_amdgcn_s_barrier()
#define PG8_SCHED __builtin_amdgcn_sched_barrier(0)
    Unit cur, nxt; int ui = 0;
    if (!S.next(0, cur)) return;
    f32x4 acc[2][2][4][2];
#pragma unroll
    for (int a = 0; a < 2; ++a)
#pragma unroll
        for (int b = 0; b < 2; ++b)
#pragma unroll
            for (int m = 0; m < 4; ++m)
#pragma unroll
                for (int n = 0; n < 2; ++n) acc[a][b][m][n] = (f32x4){0.f, 0.f, 0.f, 0.f};
    bf16x8 At[4][2], B0[2][2], B1[2][2];
    const char* cA = (const char*)g.A + (size_t)cur.pm * tstep; const char* cB = (const char*)g.Bt + (size_t)cur.pn * tstep;
    S.a_ready(cur);
    if constexpr (SP2) {
        PG8_STAGE(PG8_SB(0, 0), cB, voffB); PG8_STAGE(PG8_SB(0, 1), cB + hstep, voffB); PG8_STAGE(PG8_SA(0, 0), cA, voffA); PG8_STAGE(PG8_SA(0, 1), cA + hstep, voffA);
        if (wr == 1) PG8_BAR;
        PG8_WAIT_V(2); PG8_BAR;
        PG8_STAGE(PG8_SB(1, 0), cB + kstep, voffB); PG8_STAGE(PG8_SA(1, 0), cA + kstep, voffA); PG8_STAGE(PG8_SB(1, 1), cB + hstep + kstep, voffB);
        PG8_WAIT_V(6); PG8_BAR;
    } else {
        PG8_STAGE(PG8_SB(0, 0), cB, voffB); PG8_STAGE(PG8_SA(0, 0), cA, voffA); PG8_STAGE(PG8_SB(0, 1), cB + hstep, voffB); PG8_STAGE(PG8_SA(0, 1), cA + hstep, voffA);
        if (wr == 1) PG8_BAR;
        PG8_WAIT_V(4); PG8_BAR;
        PG8_STAGE(PG8_SB(1, 0), cB + kstep, voffB); PG8_STAGE(PG8_SA(1, 0), cA + kstep, voffA); PG8_STAGE(PG8_SB(1, 1), cB + hstep + kstep, voffB);
        PG8_WAIT_V(6); PG8_BAR;
    }
    for (;;) {
        const bool has_next = S.next(ui + 1, nxt);
        const char* nA = has_next ? (const char*)g.A + (size_t)nxt.pm * tstep : cA; const char* nB = has_next ? (const char*)g.Bt + (size_t)nxt.pn * tstep : cB;
        for (int t = 0; t < nt; t += 2) {
            const bool last = (t == nt - 2);
            const char* a1 = cA + (size_t)(t + 1) * kstep;
            const char* a2 = last ? nA : cA + (size_t)(t + 2) * kstep; const char* b2 = last ? nB : cB + (size_t)(t + 2) * kstep;
            const char* a3 = a2 + kstep; const char* b3 = b2 + kstep;
            if (last && has_next) S.a_ready(nxt);
            if constexpr (SP2) {
            PG8_LDB(B0, 0, 0); PG8_LDB(B1, 0, 1); PG8_SCHED; PG8_LDA(At, 0, 0); PG8_STAGE(PG8_SA(1, 1), a1 + hstep, voffA);
            PG8_WAIT_V(8); PG8_WAIT_L(0); PG8_BAR; PG8_MMA(0, 0, At, B0); PG8_MMA(0, 1, At, B1); PG8_BAR; PG8_SCHED;
            PG8_LDA(At, 0, 1); PG8_STAGE(PG8_SB(0, 0), b2, voffB); PG8_STAGE(PG8_SB(0, 1), b2 + hstep, voffB); PG8_STAGE(PG8_SA(0, 0), a2, voffA);
            PG8_WAIT_V(8); PG8_WAIT_L(0); PG8_BAR; PG8_MMA(1, 0, At, B0); PG8_MMA(1, 1, At, B1); PG8_BAR; PG8_SCHED;
            PG8_LDB(B0, 1, 0); PG8_LDB(B1, 1, 1); PG8_SCHED; PG8_LDA(At, 1, 0); PG8_STAGE(PG8_SA(0, 1), a2 + hstep, voffA);
            PG8_WAIT_V(8); PG8_WAIT_L(0); PG8_BAR; PG8_MMA(0, 0, At, B0); PG8_MMA(0, 1, At, B1); PG8_BAR; PG8_SCHED;
            PG8_LDA(At, 1, 1); PG8_STAGE(PG8_SB(1, 0), b3, voffB); PG8_STAGE(PG8_SB(1, 1), b3 + hstep, voffB); PG8_STAGE(PG8_SA(1, 0), a3, voffA);
            PG8_WAIT_V(8); PG8_WAIT_L(0); PG8_BAR; PG8_MMA(1, 0, At, B0); PG8_MMA(1, 1, At, B1); PG8_BAR; PG8_SCHED;
            } else {
            PG8_LDB(B0, 0, 0); PG8_SCHED; PG8_LDA(At, 0, 0); PG8_STAGE(PG8_SA(1, 1), a1 + hstep, voffA);
            PG8_WAIT_L(8); PG8_BAR; PG8_WAIT_L(0); PG8_MMA(0, 0, At, B0); PG8_BAR; PG8_SCHED;
            PG8_LDB(B1, 0, 1); PG8_STAGE(PG8_SB(0, 0), b2, voffB);
            PG8_BAR; PG8_WAIT_L(0); PG8_MMA(0, 1, At, B1); PG8_BAR;
            PG8_LDA(At, 0, 1); PG8_STAGE(PG8_SA(0, 0), a2, voffA);
            PG8_BAR; PG8_WAIT_L(0); PG8_MMA(1, 0, At, B0); PG8_BAR; PG8_SCHED;
            PG8_STAGE(PG8_SB(0, 1), b2 + hstep, voffB);
            PG8_WAIT_V(6); PG8_BAR; PG8_MMA(1, 1, At, B1); PG8_BAR;
            PG8_LDB(B0, 1, 0); PG8_SCHED; PG8_LDA(At, 1, 0); PG8_STAGE(PG8_SA(0, 1), a2 + hstep, voffA);
            PG8_WAIT_L(8); PG8_BAR; PG8_WAIT_L(0); PG8_MMA(0, 0, At, B0); PG8_BAR; PG8_SCHED;
            PG8_LDB(B1, 1, 1); PG8_STAGE(PG8_SB(1, 0), b3, voffB);
            PG8_BAR; PG8_WAIT_L(0); PG8_MMA(0, 1, At, B1); PG8_BAR;
            PG8_LDA(At, 1, 1); PG8_STAGE(PG8_SA(1, 0), a3, voffA);
            PG8_BAR; PG8_WAIT_L(0); PG8_MMA(1, 0, At, B0); PG8_BAR; PG8_SCHED;
            PG8_STAGE(PG8_SB(1, 1), b3 + hstep, voffB);
            PG8_WAIT_V(6); PG8_BAR; PG8_MMA(1, 1, At, B1); PG8_BAR;
            }
        }
        if constexpr (ALIGN_EPI) { if (wr == 0) PG8_BAR; }
        if constexpr (!Epi::AFTER_DRAIN) { E(acc, cur, wr, wc, fr, fq); S.done(cur); }
        if (!has_next) break;
#pragma unroll
        for (int a = 0; a < 2; ++a)
#pragma unroll
            for (int b = 0; b < 2; ++b)
#pragma unroll
                for (int m = 0; m < 4; ++m)
#pragma unroll
                    for (int n = 0; n < 2; ++n) acc[a][b][m][n] = (f32x4){0.f, 0.f, 0.f, 0.f};
        cur = nxt; cA = nA; cB = nB; ++ui;
        if constexpr (ALIGN_EPI) { if (wr == 1) PG8_BAR; }
    }
    PG8_WAIT_V(0);
    if constexpr (!ALIGN_EPI) { if (wr == 0) PG8_BAR; }
    PG8_BAR;
    if constexpr (Epi::AFTER_DRAIN) { E.fused(acc, cur, wr, wc, fr, fq, lds, wid, lane); S.done(cur); }
#undef PG8_SA
#undef PG8_SB
#undef PG8_STAGE
#undef PG8_LDA
#undef PG8_LDB
#undef PG8_MMA
#undef PG8_WAIT_V
#undef PG8_WAIT_L
#undef PG8_BAR
#undef PG8_SCHED
}
}
#ifndef LAS
#define LAS __attribute__((address_space(3)))
#endif
#define XB_TMO      128
#define XB_XCNT(j)  (256  + 64 * (j))
#define XB_XSUB(j)  (1280 + 64 * (j))
#define XB_XGEN(j)  (2304 + 64 * (j))
#define XB_TOP      3328
#define XB_TOPGEN   3392
#define XCD_BAR_WORDS 3456
#define XB_SPIN_CAP (1u << 18)

__device__ __forceinline__ unsigned xb_ld(unsigned* p)              { return __hip_atomic_load(p, __ATOMIC_RELAXED, __HIP_MEMORY_SCOPE_AGENT); }
__device__ __forceinline__ unsigned xb_add(unsigned* p, unsigned v) { return __hip_atomic_fetch_add(p, v, __ATOMIC_RELAXED, __HIP_MEMORY_SCOPE_AGENT); }
__device__ __forceinline__ unsigned xb_xcc_id() { return (unsigned)__builtin_amdgcn_s_getreg((3 << 11) | 20) & 0xFu; }
#define XB_SPIN(cond, bar) do { unsigned _sp = 0; while (cond) { __builtin_amdgcn_s_sleep(1); \
    if ((++_sp & 255u) == 0u) { if (xb_ld(&(bar)[XB_TMO])) break; if (_sp > XB_SPIN_CAP) { atomicAdd(&(bar)[XB_TMO], 1u); break; } } } } while (0)

struct XcdBarrier {
    unsigned* bar; unsigned x;
    volatile LAS unsigned* st;
};

__device__ __forceinline__ XcdBarrier xcd_barrier_post(unsigned* bar, volatile LAS unsigned* st) {
    XcdBarrier b; b.bar = bar; b.x = xb_xcc_id(); b.st = st;
    if (threadIdx.x == 0) (void)xb_add(&bar[XB_XCNT(b.x)], 1u);
    return b;
}
__device__ __forceinline__ void xcd_barrier_complete(unsigned* bar, unsigned x, unsigned& nloc, unsigned& nx) {
    const unsigned G = gridDim.x * gridDim.y * gridDim.z;
    unsigned sum, cnt, mine, sp = 0u;
    for (;;) {
        sum = 0u; cnt = 0u; mine = 0u;
#pragma unroll
        for (unsigned j = 0; j < 16; ++j) { const unsigned c = xb_ld(&bar[XB_XCNT(j)]); sum += c; cnt += (c > 0u) ? 1u : 0u; mine = (j == x) ? c : mine; }
        if (sum == G) break;
        __builtin_amdgcn_s_sleep(1);
        if ((++sp & 255u) == 0u) { if (xb_ld(&bar[XB_TMO])) break; if (sp > XB_SPIN_CAP) { atomicAdd(&bar[XB_TMO], 1u); break; } }
    }
    nloc = mine > 0u ? mine : 1u; nx = cnt > 0u ? cnt : 1u;
}

__device__ __forceinline__ void xcd_barrier(const XcdBarrier& b) {
    asm volatile("s_waitcnt vmcnt(0)" ::: "memory");
    __syncthreads();
    if (threadIdx.x == 0) {
        unsigned* bar = b.bar;
        __builtin_amdgcn_s_waitcnt(0);
        unsigned nloc = b.st[0], nx = b.st[1];
        if (nloc == 0u) { xcd_barrier_complete(bar, b.x, nloc, nx); b.st[0] = nloc; b.st[1] = nx; }
        const unsigned old = xb_add(&bar[XB_XSUB(b.x)], 1u);
        const unsigned gen = old / nloc;
        if (old + 1u == (gen + 1u) * nloc) {
            __builtin_amdgcn_fence(__ATOMIC_RELEASE, "agent");
            asm volatile("s_waitcnt vmcnt(0)" ::: "memory");
            const unsigned og = xb_add(&bar[XB_TOP], 1u);
            const unsigned tg = og / nx;
            if (og + 1u == (tg + 1u) * nx) xb_add(&bar[XB_TOPGEN], 1u);
            else XB_SPIN(xb_ld(&bar[XB_TOPGEN]) == tg, bar);
            __builtin_amdgcn_fence(__ATOMIC_ACQUIRE, "agent");
            xb_add(&bar[XB_XGEN(b.x)], 1u);
            asm volatile("s_waitcnt vmcnt(0)" ::: "memory");
        } else {
            XB_SPIN(xb_ld(&bar[XB_XGEN(b.x)]) == gen, bar);
            __builtin_amdgcn_fence(__ATOMIC_ACQUIRE, "agent");
            asm volatile("s_waitcnt vmcnt(0)" ::: "memory");
        }
    }
    __syncthreads();
}

typedef unsigned short bf16_t;
typedef short bf16x8 __attribute__((ext_vector_type(8)));
typedef float f32x4 __attribute__((ext_vector_type(4)));
typedef float f32x16 __attribute__((ext_vector_type(16)));
typedef unsigned u32x4 __attribute__((ext_vector_type(4)));
typedef unsigned u32x2 __attribute__((ext_vector_type(2)));
#define LAS __attribute__((address_space(3)))

constexpr int DM = 1024, MTOT = 36864, NCTXTOK = 4096, PZ = 3328;
constexpr int NKL = 4352;
constexpr float LOG2E = 1.4426950408889634f;
constexpr float QSCALE = 0.125f * LOG2E;
constexpr float EPS = 1e-6f;
constexpr float KSCALE_C = 0.08838834764831845f;

constexpr size_t O_YP = 0, O_YS = 4194304, O_AK = 37748736, O_AV = 38273024, O_BK = 38797312, O_BV = 40894464,
                 O_CF = 42991616, O_CB = 44040192, O_DK = 45088768, O_DV = 45613056, O_END = 46137344;

constexpr size_t MiB = 1u << 20;
constexpr size_t WS_MOD = 0;
constexpr size_t WS_ROPE = 256 * 1024;
constexpr size_t WS_LAM = 300 * 1024;
constexpr size_t WS_BAR = 512 * 1024;
constexpr size_t WS_WIN_AB = 1 * MiB, WS_WOUT_AB = 8 * MiB, WS_WIN_CD = 10 * MiB, WS_WOUT_CD = 17 * MiB;
constexpr size_t WS_XN = 20 * MiB;
constexpr size_t WS_Z = 92 * MiB;
constexpr size_t WS_KV = 326 * MiB;
constexpr size_t L0_KA_LAT = WS_KV;
constexpr size_t L0_VTA_LAT = L0_KA_LAT + 8912896;
constexpr size_t L0_KB1_LAT = L0_VTA_LAT + 8912896;
constexpr size_t L0_KB2_LAT = L0_KB1_LAT + 17825792;
constexpr size_t L0_VTB_LAT = L0_KB2_LAT + 17825792;
constexpr size_t L0_KA_CTX = L0_VTB_LAT + 35651584;
constexpr size_t L0_VTA_CTX = L0_KA_CTX + 1 * MiB;
constexpr size_t L0_KB1_CTX = L0_VTA_CTX + 1 * MiB;
constexpr size_t L0_KB2_CTX = L0_KB1_CTX + 2 * MiB;
constexpr size_t L0_VTB_CTX = L0_KB2_CTX + 2 * MiB;
constexpr size_t L0_END = L0_VTB_CTX + 4 * MiB;
constexpr size_t L1_KTL = WS_KV;
constexpr size_t L1_VTL = L1_KTL + 32 * MiB;
constexpr size_t L1_KTC = L1_VTL + 32 * MiB;
constexpr size_t L1_VTC = L1_KTC + 4 * MiB;
constexpr size_t L1_KD_LAT = L1_VTC + 4 * MiB;
constexpr size_t L1_VTD_LAT = L1_KD_LAT + 8912896;
constexpr size_t L1_KD_CTX = L1_VTD_LAT + 8912896;
constexpr size_t L1_VTD_CTX = L1_KD_CTX + 1 * MiB;
constexpr size_t L1_STF_L = L1_VTD_CTX + 1 * MiB;
constexpr size_t L1_STB_L = L1_STF_L + 32 * MiB;
constexpr size_t L1_STF_C = L1_STB_L + 32 * MiB;
constexpr size_t L1_STB_C = L1_STF_C + 4 * MiB;
constexpr size_t L1_END = L1_STB_C + 4 * MiB;
constexpr size_t L1_KF_HI = L1_END;
constexpr size_t L1_KF_LO = 1 * MiB;
constexpr size_t WS_NEED = (L0_END > L1_END ? L0_END : L1_END);
static_assert(L1_KF_LO + 9 * MiB <= WS_WIN_CD, "Kf low part must not reach the layer-1 weight copies");
static_assert(WS_NEED <= 512 * MiB, "workspace map");

constexpr int LDS_BYTES = 136192;
constexpr int LDS_BAR = 135680;
#ifndef PHM
#define PHM 0xFFFFF
#endif
#ifndef REP_A
#define REP_A 1
#endif
#ifndef REP_G2
#define REP_G2 1
#endif
#ifndef REP_PREP
#define REP_PREP 1
#endif
#ifndef REP_SCAN
#define REP_SCAN 1
#endif
#ifndef REP_RET
#define REP_RET 1
#endif
#ifndef REP_SM
#define REP_SM 1
#endif
#ifndef REP_P4
#define REP_P4 1
#endif
#ifndef REP_P10
#define REP_P10 1
#endif

struct Params { const float* in[31]; float* out; unsigned char* ws; };
enum { I_XP = 0, I_XS, I_CAK, I_CAV, I_CBK, I_CBV, I_SCF, I_SCB, I_CDK, I_CDV, I_C, I_CCTX, I_NORMG, I_MODW, I_MODB,
       I_ABWIN, I_ABWOUT, I_SINK, I_LQ1, I_LK1, I_LQ2, I_LK2, I_BNG, I_CDWIN, I_CDWOUT, I_DECF, I_DECB, I_CNG, I_DQG, I_DKG, I_FING };

__device__ __forceinline__ unsigned cvtpk(float lo, float hi) {
    typedef float f2_t __attribute__((ext_vector_type(2))); typedef __bf16 b2_t __attribute__((ext_vector_type(2)));
    f2_t v = {lo, hi}; b2_t b = __builtin_convertvector(v, b2_t); return __builtin_bit_cast(unsigned, b);
}
__device__ __forceinline__ float bflo(unsigned w) { return __uint_as_float(w << 16); }
__device__ __forceinline__ float bfhi(unsigned w) { return __uint_as_float(w & 0xffff0000u); }
__device__ __forceinline__ void unpack8(const u32x4 w, float (&v)[8]) {
    v[0] = bflo(w.x); v[1] = bfhi(w.x); v[2] = bflo(w.y); v[3] = bfhi(w.y); v[4] = bflo(w.z); v[5] = bfhi(w.z); v[6] = bflo(w.w); v[7] = bfhi(w.w);
}
__device__ __forceinline__ u32x4 pack8(const float (&v)[8]) {
    u32x4 w; w.x = cvtpk(v[0], v[1]); w.y = cvtpk(v[2], v[3]); w.z = cvtpk(v[4], v[5]); w.w = cvtpk(v[6], v[7]); return w;
}
__device__ __forceinline__ float fexp2(float x) { return __builtin_amdgcn_exp2f(x); }
__device__ __forceinline__ float siluf(float g) { return g * __builtin_amdgcn_rcpf(1.0f + fexp2(-g * LOG2E)); }
__device__ __forceinline__ float wave_sum(float v) {
#pragma unroll
    for (int o = 1; o < 64; o <<= 1) v += __shfl_xor(v, o);
    return v;
}
__device__ __forceinline__ int crow(int r, int hi) { return (r & 3) + 8 * (r >> 2) + 4 * hi; }
__device__ __forceinline__ size_t kf_base(int sh) { return sh < 23 ? L1_KF_HI + (size_t)sh * MiB : L1_KF_LO + (size_t)(sh - 23) * MiB; }
#define MFMA32(a, b, c) __builtin_amdgcn_mfma_f32_32x32x16_bf16((a), (b), (c), 0, 0, 0)

struct EpiResid {
    static constexpr bool PERM = false, AFTER_DRAIN = false;
    const float* xp; const float* xs; float* out; const float* mod;
    __device__ __forceinline__ void operator()(const pg8::f32x4 (&acc)[2][2][4][2], const pg8::Unit& u, int wr, int wc, int fr, int fq) const {
        const int pm = u.pm;
        const float* xin = pm < 16 ? xp + (size_t)pm * 256 * DM : xs + (size_t)(pm - 16) * 256 * DM;
        float* xo = out + (size_t)pm * 256 * DM;
        const int mrow = pm < 16 ? 0 : 1 + ((pm - 16) >> 4);
        const float* gate = mod + mrow * 3072 + 2048;
        const int col0 = u.pn * 256 + wc * 32 + 4 * fq;
#pragma unroll
        for (int bj = 0; bj < 2; ++bj)
#pragma unroll
            for (int n = 0; n < 2; ++n) {
                const pg8::f32x4 g = *(const pg8::f32x4*)(gate + col0 + bj * 128 + n * 16);
#pragma unroll
                for (int ai = 0; ai < 2; ++ai)
#pragma unroll
                    for (int m = 0; m < 4; ++m) {
                        const size_t off = (size_t)(ai * 128 + wr * 64 + m * 16 + fr) * DM + col0 + bj * 128 + n * 16;
                        const pg8::f32x4 xv = *(const pg8::f32x4*)(xin + off);
                        *(pg8::f32x4*)(xo + off) = xv + g * acc[ai][bj][m][n];
                    }
            }
    }
};

__device__ __forceinline__ void transpose_item(const float* __restrict__ W, int K, int N, bf16_t* __restrict__ WT, float* scr, int item, int lane) {
    const int nblk = N / 32, kb = item / nblk, nb = item % nblk, k0 = 64 * kb, n0 = 32 * nb;
#pragma unroll 8
    for (int i = 0; i < 32; ++i) { const int kk = 2 * i + (lane >> 5); scr[kk * 33 + (lane & 31)] = W[(size_t)(k0 + kk) * N + n0 + (lane & 31)]; }
    asm volatile("s_waitcnt lgkmcnt(0)" ::: "memory");
    const int c = lane & 7;
#pragma unroll
    for (int j = 0; j < 4; ++j) {
        const int n = (lane >> 3) + 8 * j; const float* s = scr + (8 * c) * 33 + n;
        u32x4 o; o.x = cvtpk(s[0 * 33], s[1 * 33]); o.y = cvtpk(s[2 * 33], s[3 * 33]); o.z = cvtpk(s[4 * 33], s[5 * 33]); o.w = cvtpk(s[6 * 33], s[7 * 33]);
        *(u32x4*)(WT + (size_t)(n0 + n) * K + k0 + 8 * c) = o;
    }
    asm volatile("s_waitcnt lgkmcnt(0)" ::: "memory");
}

__device__ __forceinline__ void phase0(const Params& p, unsigned char* lds, int tid, int blk, int G) {
    const int lane = tid & 63, wave = tid >> 6;
    unsigned char* ws = p.ws;
    {
        float* scr = (float*)(lds + wave * 16384);
        const int gw = blk * 8 + wave, NGW = G * 8;
        constexpr int I_IN = 16 * 104, I_OUT = 16 * 32, NIT = 2 * (I_IN + I_OUT);
        for (int it = gw; it < NIT; it += NGW) {
            int r = it;
            if (r < I_IN) { transpose_item(p.in[I_ABWIN], 1024, PZ, (bf16_t*)(ws + WS_WIN_AB), scr, r, lane); continue; } r -= I_IN;
            if (r < I_OUT) { transpose_item(p.in[I_ABWOUT], 1024, 1024, (bf16_t*)(ws + WS_WOUT_AB), scr, r, lane); continue; } r -= I_OUT;
            if (r < I_IN) { transpose_item(p.in[I_CDWIN], 1024, PZ, (bf16_t*)(ws + WS_WIN_CD), scr, r, lane); continue; } r -= I_IN;
            transpose_item(p.in[I_CDWOUT], 1024, 1024, (bf16_t*)(ws + WS_WOUT_CD), scr, r, lane);
        }
    }
    __syncthreads();
    {
        float* red = (float*)lds;
        const int c = tid & 31, kp = tid >> 5;
        for (int cgp = blk; cgp < 256; cgp += G) {
            const int layer = cgp >> 7, colb = (cgp & 127) * 24;
            const float* W = p.in[I_MODW] + (size_t)layer * 1024 * 3072;
            float acc[9];
#pragma unroll
            for (int r = 0; r < 9; ++r) acc[r] = 0.f;
            if (c < 24) {
                for (int k = kp * 64; k < kp * 64 + 64; ++k) {
                    const float w = W[(size_t)k * 3072 + colb + c];
                    acc[0] += siluf(p.in[I_CCTX][k]) * w;
#pragma unroll
                    for (int b = 0; b < 8; ++b) acc[1 + b] += siluf(p.in[I_C][b * 1024 + k]) * w;
                }
#pragma unroll
                for (int r = 0; r < 9; ++r) red[(kp * 9 + r) * 24 + c] = acc[r];
            }
            __syncthreads();
            if (tid < 216) {
                const int r = tid / 24, cc = tid % 24; float s = 0.f;
                for (int q = 0; q < 16; ++q) s += red[(q * 9 + r) * 24 + cc];
                ((float*)(ws + WS_MOD))[(size_t)(layer * 9 + r) * 3072 + colb + cc] = s + p.in[I_MODB][layer * 3072 + colb + cc];
            }
            __syncthreads();
        }
    }
    {
        const int gt = blk * 512 + tid;
        if (gt < 1024) {
            const int pos = gt >> 4, f = gt & 15;
            const float inv = exp2f(-(float)f * (13.287712379549449f / 16.0f));
            const float ang = (float)pos * inv;
            ((float*)(ws + WS_ROPE))[gt] = cosf(ang);
            ((float*)(ws + WS_ROPE))[1024 + gt] = sinf(ang);
        }
        if (blk == 0 && tid == 0) {
            float s1 = 0.f, s2 = 0.f;
            for (int i = 0; i < 64; ++i) { s1 += p.in[I_LQ1][i] * p.in[I_LK1][i]; s2 += p.in[I_LQ2][i] * p.in[I_LK2][i]; }
            *(float*)(ws + WS_LAM) = expf(s1) - expf(s2) + 0.2f;
        }
    }
}

constexpr int ROWS_IN_FLIGHT = 3;
__device__ __forceinline__ void adaln_rows(const float* xp, const float* xs, const float* __restrict__ g, const float* __restrict__ mod,
                                           bf16_t* __restrict__ XN, int gw, int NGW, int lane) {
    constexpr int NR = ROWS_IN_FLIGHT;
    for (int row0 = gw; row0 < MTOT; row0 += NR * NGW) {
        int rw[NR]; f32x4 v[NR][4];
#pragma unroll
        for (int k = 0; k < NR; ++k) {
            rw[k] = (row0 + k * NGW < MTOT) ? row0 + k * NGW : row0;
            const float* xr = rw[k] < NCTXTOK ? xp + (size_t)rw[k] * DM : xs + (size_t)(rw[k] - NCTXTOK) * DM;
#pragma unroll
            for (int j = 0; j < 4; ++j) v[k][j] = __builtin_nontemporal_load((const f32x4*)(xr + 4 * (lane + 64 * j)));
        }
        float rinv[NR];
#pragma unroll
        for (int k = 0; k < NR; ++k) {
            float ss = 0.f;
#pragma unroll
            for (int j = 0; j < 4; ++j) ss += (v[k][j].x * v[k][j].x + v[k][j].y * v[k][j].y) + (v[k][j].z * v[k][j].z + v[k][j].w * v[k][j].w);
            rinv[k] = rsqrtf(wave_sum(ss) * (1.0f / DM) + EPS);
        }
#pragma unroll
        for (int j = 0; j < 4; ++j) {
            const int col = 4 * (lane + 64 * j);
            const f32x4 gg = *(const f32x4*)(g + col);
#pragma unroll
            for (int k = 0; k < NR; ++k) {
                const float* sh = mod + (rw[k] < NCTXTOK ? 0 : 1 + ((rw[k] - NCTXTOK) >> 12)) * 3072;
                const f32x4 h = v[k][j] * rinv[k] * gg * (*(const f32x4*)(sh + 1024 + col) + 1.0f) + *(const f32x4*)(sh + col);
                u32x2 w; w.x = cvtpk(h.x, h.y); w.y = cvtpk(h.z, h.w);
                *(u32x2*)(XN + (size_t)rw[k] * DM + col) = w;
            }
        }
    }
}
__device__ __forceinline__ void final_rows(float* x, const float* __restrict__ g, int gw, int NGW, int lane) {
    constexpr int NR = ROWS_IN_FLIGHT;
    for (int row0 = gw; row0 < MTOT; row0 += NR * NGW) {
        int rw[NR]; f32x4 v[NR][4];
#pragma unroll
        for (int k = 0; k < NR; ++k) {
            rw[k] = (row0 + k * NGW < MTOT) ? row0 + k * NGW : -1;
            const float* xr = x + (size_t)(rw[k] < 0 ? row0 : rw[k]) * DM;
#pragma unroll
            for (int j = 0; j < 4; ++j) v[k][j] = __builtin_nontemporal_load((const f32x4*)(xr + 4 * (lane + 64 * j)));
        }
        float rinv[NR];
#pragma unroll
        for (int k = 0; k < NR; ++k) {
            float ss = 0.f;
#pragma unroll
            for (int j = 0; j < 4; ++j) ss += (v[k][j].x * v[k][j].x + v[k][j].y * v[k][j].y) + (v[k][j].z * v[k][j].z + v[k][j].w * v[k][j].w);
            rinv[k] = rsqrtf(wave_sum(ss) * (1.0f / DM) + EPS);
        }
#pragma unroll
        for (int j = 0; j < 4; ++j) {
            const int col = 4 * (lane + 64 * j);
            const f32x4 gg = *(const f32x4*)(g + col);
#pragma unroll
            for (int k = 0; k < NR; ++k)
                if (rw[k] >= 0) __builtin_nontemporal_store(v[k][j] * rinv[k] * gg, (f32x4*)(x + (size_t)rw[k] * DM + col));
        }
    }
}

template <bool F32SRC>
__device__ __forceinline__ void tile64(const void* src, size_t sp, bool rms, bool rope, const float* __restrict__ gain, int pos0,
                                       const float* __restrict__ cosT, const float* __restrict__ sinT,
                                       float* df, size_t dfp, bf16_t* dk, size_t dkp, bf16_t* dt, size_t dtp, unsigned char* ldsw, int lane,
                                       const int fragmode = 0, const int fraghalf = 0, const int fragtq = 0, bf16_t* dkf = nullptr) {
    const int tr = lane >> 3, ch = lane & 7;
    unsigned short* T = (unsigned short*)ldsw;
#pragma unroll
    for (int g8 = 0; g8 < 8; ++g8) {
        const int tok = g8 * 8 + tr;
        float v[8];
        if (F32SRC) {
            const float* s = (const float*)src + (size_t)tok * sp + ch * 8;
            const f32x4 a = *(const f32x4*)s, b = *(const f32x4*)(s + 4);
            v[0] = a.x; v[1] = a.y; v[2] = a.z; v[3] = a.w; v[4] = b.x; v[5] = b.y; v[6] = b.z; v[7] = b.w;
        } else {
            const bf16_t* s = (const bf16_t*)src + (size_t)tok * sp + ch * 8;
            unpack8(*(const u32x4*)s, v);
        }
        if (rms) {
            float ss = 0.f;
#pragma unroll
            for (int e = 0; e < 8; ++e) ss += v[e] * v[e];
            ss += __shfl_xor(ss, 1); ss += __shfl_xor(ss, 2); ss += __shfl_xor(ss, 4);
            const float rinv = rsqrtf(ss * (1.0f / 64.0f) + EPS);
#pragma unroll
            for (int e = 0; e < 8; ++e) v[e] *= rinv * gain[ch * 8 + e];
        }
        if (df) {
            float* o = df + (size_t)tok * dfp + ch * 8;
            __builtin_nontemporal_store((f32x4){v[0], v[1], v[2], v[3]}, (f32x4*)o); __builtin_nontemporal_store((f32x4){v[4], v[5], v[6], v[7]}, (f32x4*)(o + 4));
        }
        if (rope) {
            const int pos = pos0 + tok, c4 = ch & 3;
            const int trow = c4 < 2 ? (pos >> 6) : (pos & 63), f0 = 8 * (c4 & 1);
#pragma unroll
            for (int e = 0; e < 8; ++e) {
                const float other = __shfl_xor(v[e], 4);
                const float cs = cosT[trow * 16 + f0 + e], sn = sinT[trow * 16 + f0 + e];
                v[e] = ch < 4 ? v[e] * cs - other * sn : v[e] * cs + other * sn;
            }
        }
        if (dk) *(u32x4*)(dk + (size_t)tok * dkp + ch * 8) = pack8(v);
        if (dkf) {
            const int tl = 64 * fragtq + tok, t5 = tl & 31, pit = (t5 & 0x13) | ((t5 & 4) << 1) | ((t5 & 8) >> 1);
            *(u32x4*)(dkf + (size_t)((((tl >> 5) * 8 + 4 * fraghalf + (ch >> 1)) * 64 + (ch & 1) * 32 + pit) * 8)) = pack8(v);
        }
        if (dt) {
#pragma unroll
            for (int e = 0; e < 8; ++e) T[(ch * 8 + e) * 72 + tok] = (unsigned short)(cvtpk(v[e], 0.f) & 0xffffu);
        }
    }
    if (dt) {
        asm volatile("s_waitcnt lgkmcnt(0)" ::: "memory");
#pragma unroll
        for (int k = 0; k < 8; ++k) {
            const int d = tr + 8 * k, c8 = ch;
            const u32x4 w = *(const u32x4*)(T + d * 72 + c8 * 8);
            if (fragmode) {
                const int e = 64 * fraghalf + d, tl = 64 * fragtq + 8 * c8;
                *(u32x4*)(dt + (size_t)((((e >> 5) * 8 + (tl >> 4)) * 64 + ((tl >> 3) & 1) * 32 + (e & 31)) * 8)) = w;
            } else *(u32x4*)(dt + (size_t)d * dtp + c8 * 8) = w;
        }
        asm volatile("s_waitcnt lgkmcnt(0)" ::: "memory");
    }
}

__device__ __forceinline__ void prep_layer0(const Params& p, unsigned char* lds, int tid, int blk, int G) {
    unsigned char* ws = p.ws; float* out = p.out;
    const int lane = tid & 63, wave = __builtin_amdgcn_readfirstlane(tid >> 6); unsigned char* ldsw = lds + wave * 9216; const int gwp = wave * G + blk, NGWp = G * 8;
    const bf16_t* Z = (const bf16_t*)(ws + WS_Z);
    const float* cosT = (const float*)(ws + WS_ROPE); const float* sinT = cosT + 1024;
    for (int u = gwp; u < 12160; u += NGWp) {
        if (u < 11520) {
            const int tt = u / 20, g = u % 20;
            const bool ctx = tt < 64;
            const int b = ctx ? (tt >> 2) : ((tt - 64) >> 6);
            const int t0 = ctx ? (tt & 3) * 64 : ((tt - 64) & 63) * 64;
            const size_t row0 = (size_t)tt * 64;
            const int NK = ctx ? 256 : NKL, koff = ctx ? t0 : 256 + t0;
            float* df = nullptr; size_t dfp = 0; bf16_t* dk = nullptr; bf16_t* dt = nullptr; size_t dtp = NK; int zcol; bool rope = false;
            if (g < 2) {
                zcol = 512 + 64 * g; rope = !ctx;
                dk = (bf16_t*)(ws + (ctx ? L0_KA_CTX : L0_KA_LAT)) + ((size_t)(b * 2 + g) * NK + koff) * 64;
                if (ctx) { df = out + O_AK + ((size_t)(b * 2 + g) * 256 + t0) * 64; dfp = 64; }
            } else if (g < 4) {
                const int hd = g - 2; zcol = 640 + 64 * hd;
                dt = (bf16_t*)(ws + (ctx ? L0_VTA_CTX : L0_VTA_LAT)) + (size_t)(b * 2 + hd) * 64 * NK + koff;
                if (ctx) { df = out + O_AV + ((size_t)(b * 2 + hd) * 256 + t0) * 64; dfp = 64; }
            } else if (g < 12) {
                const int idx = g - 4, hd = idx >> 1, half = idx & 1; zcol = 1280 + 128 * hd + 64 * half; rope = !ctx;
                const size_t base = ctx ? (half ? L0_KB2_CTX : L0_KB1_CTX) : (half ? L0_KB2_LAT : L0_KB1_LAT);
                dk = (bf16_t*)(ws + base) + ((size_t)(b * 4 + hd) * NK + koff) * 64;
                if (ctx) { df = out + O_BK + ((size_t)(b * 4 + hd) * 256 + t0) * 128 + 64 * half; dfp = 128; }
            } else {
                const int idx = g - 12, hd = idx >> 1, half = idx & 1; zcol = 1792 + 128 * hd + 64 * half;
                dt = (bf16_t*)(ws + (ctx ? L0_VTB_CTX : L0_VTB_LAT)) + ((size_t)(b * 4 + hd) * 128 + 64 * half) * NK + koff;
                if (ctx) { df = out + O_BV + ((size_t)(b * 4 + hd) * 256 + t0) * 128 + 64 * half; dfp = 128; }
            }
            tile64<false>(Z + row0 * PZ + zcol, PZ, false, rope, nullptr, t0, cosT, sinT, df, dfp, dk, 64, dt, dtp, ldsw, lane);
        } else {
            const int cu = u - 11520, g = cu % 20, r = cu / 20, b = r >> 2, t0 = (r & 3) * 64;
            const float* src; size_t sp; bf16_t* dk = nullptr; bf16_t* dt = nullptr;
            if (g < 2) {
                src = p.in[I_CAK] + ((size_t)(b * 2 + g) * 256 + t0) * 64; sp = 64;
                dk = (bf16_t*)(ws + L0_KA_LAT) + ((size_t)(b * 2 + g) * NKL + t0) * 64;
            } else if (g < 4) {
                const int hd = g - 2; src = p.in[I_CAV] + ((size_t)(b * 2 + hd) * 256 + t0) * 64; sp = 64;
                dt = (bf16_t*)(ws + L0_VTA_LAT) + (size_t)(b * 2 + hd) * 64 * NKL + t0;
            } else if (g < 12) {
                const int idx = g - 4, hd = idx >> 1, half = idx & 1;
                src = p.in[I_CBK] + ((size_t)(b * 4 + hd) * 256 + t0) * 128 + 64 * half; sp = 128;
                dk = (bf16_t*)(ws + (half ? L0_KB2_LAT : L0_KB1_LAT)) + ((size_t)(b * 4 + hd) * NKL + t0) * 64;
            } else {
                const int idx = g - 12, hd = idx >> 1, half = idx & 1;
                src = p.in[I_CBV] + ((size_t)(b * 4 + hd) * 256 + t0) * 128 + 64 * half; sp = 128;
                dt = (bf16_t*)(ws + L0_VTB_LAT) + ((size_t)(b * 4 + hd) * 128 + 64 * half) * NKL + t0;
            }
            tile64<true>(src, sp, false, false, nullptr, 0, cosT, sinT, nullptr, 0, dk, 64, dt, NKL, ldsw, lane);
        }
    }
}

__device__ __forceinline__ void prep_layer1(const Params& p, unsigned char* lds, int tid, int blk, int G) {
    unsigned char* ws = p.ws; float* out = p.out;
    const int lane = tid & 63, wave = __builtin_amdgcn_readfirstlane(tid >> 6); unsigned char* ldsw = lds + wave * 9216; const int gwp = wave * G + blk, NGWp = G * 8;
    const bf16_t* Z = (const bf16_t*)(ws + WS_Z);
    const float* cosT = (const float*)(ws + WS_ROPE); const float* sinT = cosT + 1024;
    for (int u = gwp; u < 11520 + 128; u += NGWp) {
        if (u < 11520) {
            const int tt = u / 20, g = u % 20;
            const bool ctx = tt < 64;
            const int b = ctx ? (tt >> 2) : ((tt - 64) >> 6);
            const int t0 = ctx ? (tt & 3) * 64 : ((tt - 64) & 63) * 64;
            const size_t row0 = (size_t)tt * 64;
            float* df = nullptr; bf16_t* dk = nullptr; bf16_t* dt = nullptr; size_t dtp = 0; int zcol; bool rope = false, rms = false;
            int fragmode = 0, fraghalf = 0, fragtq = 0; bf16_t* dkf = nullptr;
            if (g < 16) {
                const int idx = g & 7, hd = idx >> 1, half = idx & 1; const bool isv = g >= 8;
                zcol = (isv ? 1024 : 512) + 128 * hd + 64 * half;
                const int NS = ctx ? 256 : 4096; dtp = NS;
                const size_t base = ctx ? (isv ? L1_VTC : L1_KTC) : (isv ? L1_VTL : L1_KTL);
                dt = (bf16_t*)(ws + base) + (size_t)(b * 4 + hd) * 128 * NS + (size_t)(t0 >> 7) * 16384;
                fragmode = 1; fraghalf = half; fragtq = (t0 >> 6) & 1;
            } else if (g < 18) {
                const int hd = g - 16; zcol = 2048 + 64 * hd; rms = true; rope = !ctx;
                const int NK = ctx ? 256 : NKL, koff = ctx ? t0 : 256 + t0;
                dk = (bf16_t*)(ws + (ctx ? L1_KD_CTX : L1_KD_LAT)) + ((size_t)(b * 2 + hd) * NK + koff) * 64;
                if (ctx) df = out + O_DK + ((size_t)(b * 2 + hd) * 256 + t0) * 64;
            } else {
                const int hd = g - 18; zcol = 2176 + 64 * hd;
                const int NK = ctx ? 256 : NKL, koff = ctx ? t0 : 256 + t0; dtp = NK;
                dt = (bf16_t*)(ws + (ctx ? L1_VTD_CTX : L1_VTD_LAT)) + (size_t)(b * 2 + hd) * 64 * NK + koff;
                if (ctx) df = out + O_DV + ((size_t)(b * 2 + hd) * 256 + t0) * 64;
            }
            tile64<false>(Z + row0 * PZ + zcol, PZ, rms, rope, p.in[I_DKG], t0, cosT, sinT, df, 64, dk, 64, dt, dtp, ldsw, lane, fragmode, fraghalf, fragtq, dkf);
        } else {
            const int cu = u - 11520, g = cu & 3, r = cu >> 2, b = r >> 2, t0 = (r & 3) * 64;
            const float* src; bf16_t* dk = nullptr; bf16_t* dt = nullptr;
            if (g < 2) {
                src = p.in[I_CDK] + ((size_t)(b * 2 + g) * 256 + t0) * 64;
                dk = (bf16_t*)(ws + L1_KD_LAT) + ((size_t)(b * 2 + g) * NKL + t0) * 64;
            } else {
                const int hd = g - 2; src = p.in[I_CDV] + ((size_t)(b * 2 + hd) * 256 + t0) * 64;
                dt = (bf16_t*)(ws + L1_VTD_LAT) + (size_t)(b * 2 + hd) * 64 * NKL + t0;
            }
            tile64<true>(src, 64, false, false, nullptr, 0, cosT, sinT, nullptr, 0, dk, 64, dt, NKL, ldsw, lane);
        }
    }
}

template <bool RMS, bool ROPE>
__device__ __forceinline__ void load_q(const bf16_t* zq, int hi, const float* __restrict__ gain, int pos,
                                       const float* __restrict__ cosT, const float* __restrict__ sinT, bf16x8 (&qf)[4]) {
    float v[4][8];
#pragma unroll
    for (int kk = 0; kk < 4; ++kk) unpack8(*(const u32x4*)(zq + 16 * kk + 8 * hi), v[kk]);
    if (RMS) {
        float ss = 0.f;
#pragma unroll
        for (int kk = 0; kk < 4; ++kk)
#pragma unroll
            for (int e = 0; e < 8; ++e) ss += v[kk][e] * v[kk][e];
        ss += __shfl_xor(ss, 32);
        const float rinv = rsqrtf(ss * (1.0f / 64.0f) + EPS);
#pragma unroll
        for (int kk = 0; kk < 4; ++kk)
#pragma unroll
            for (int e = 0; e < 8; ++e) v[kk][e] *= rinv * gain[16 * kk + 8 * hi + e];
    }
    if (ROPE) {
        const int prow = pos >> 6, pcol = pos & 63;
#pragma unroll
        for (int kk = 0; kk < 2; ++kk) {
            const int trow = kk == 0 ? prow : pcol;
#pragma unroll
            for (int e = 0; e < 8; ++e) {
                const float cs = cosT[trow * 16 + 8 * hi + e], sn = sinT[trow * 16 + 8 * hi + e];
                const float x1 = v[kk][e], x2 = v[kk + 2][e];
                v[kk][e] = x1 * cs - x2 * sn; v[kk + 2][e] = x2 * cs + x1 * sn;
            }
        }
    }
#pragma unroll
    for (int kk = 0; kk < 4; ++kk) {
#pragma unroll
        for (int e = 0; e < 8; ++e) v[kk][e] *= QSCALE;
        qf[kk] = __builtin_bit_cast(bf16x8, pack8(v[kk]));
    }
}

template <int DV, bool WINDOW>
__device__ __forceinline__ void compute_tile(const unsigned char* base, const unsigned rdK, const unsigned rdV, const bf16x8 (&qf)[4], f32x16& negm,
                                             f32x16 (&O)[DV / 32], float& m_run, float& l_run, const bool mtile, const int j0, const int qpos, const int hi, const bool first) {
    constexpr int NDB = DV / 32;
    constexpr float THR = 8.0f;
    f32x16 s0, s1;
    bf16x8 kf0[4], kf1[4], vf[NDB][4];
#pragma unroll
    for (int kk = 0; kk < 4; ++kk) { kf0[kk] = *(const bf16x8*)(base + rdK + kk * 32); kf1[kk] = *(const bf16x8*)(base + rdK + 32 * 144 + kk * 32); }
#pragma unroll
    for (int db = 0; db < NDB; ++db)
#pragma unroll
        for (int q = 0; q < 4; ++q) vf[db][q] = *(const bf16x8*)(base + rdV + db * 32 * 144 + q * 32);
    __builtin_amdgcn_sched_barrier(0);
    __builtin_amdgcn_s_setprio(1);
    s0 = MFMA32(kf0[0], qf[0], negm); s1 = MFMA32(kf1[0], qf[0], negm);
#pragma unroll
    for (int kk = 1; kk < 4; ++kk) { s0 = MFMA32(kf0[kk], qf[kk], s0); s1 = MFMA32(kf1[kk], qf[kk], s1); }
    __builtin_amdgcn_s_setprio(0);
    if (WINDOW && mtile) {
#pragma unroll
        for (int r = 0; r < 16; ++r) {
            const int j = j0 + 16 * (r >> 3) + 8 * hi + (r & 7);
            const int d0 = qpos - j, d1 = d0 - 32;
            if (d0 > 128 || d0 < -128) s0[r] = -1e30f;
            if (d1 > 128 || d1 < -128) s1[r] = -1e30f;
        }
    }
    float mx = fmaxf(s0[0], s1[0]);
#pragma unroll
    for (int r = 1; r < 16; ++r) mx = fmaxf(mx, fmaxf(s0[r], s1[r]));
    {
        auto rr = __builtin_amdgcn_permlane32_swap(__float_as_uint(mx), __float_as_uint(mx), false, false);
        mx = fmaxf(__uint_as_float(rr[0]), __uint_as_float(rr[1]));
    }
    if (first || __any(mx > THR)) {
        const float dl = first ? mx : fmaxf(mx, 0.f);
        m_run += dl;
#pragma unroll
        for (int r = 0; r < 16; ++r) { s0[r] -= dl; s1[r] -= dl; negm[r] = -m_run; }
        const float alpha = fexp2(-dl);
        l_run *= alpha;
#pragma unroll
        for (int db = 0; db < NDB; ++db)
#pragma unroll
            for (int r = 0; r < 16; ++r) O[db][r] *= alpha;
    }
    float rs = 0.f;
#pragma unroll
    for (int r = 0; r < 16; ++r) { s0[r] = fexp2(s0[r]); s1[r] = fexp2(s1[r]); rs += s0[r] + s1[r]; }
    l_run += rs;
    u32x4 w00, w01, w10, w11;
    w00.x = cvtpk(s0[0], s0[1]); w00.y = cvtpk(s0[2], s0[3]); w00.z = cvtpk(s0[4], s0[5]); w00.w = cvtpk(s0[6], s0[7]);
    w01.x = cvtpk(s0[8], s0[9]); w01.y = cvtpk(s0[10], s0[11]); w01.z = cvtpk(s0[12], s0[13]); w01.w = cvtpk(s0[14], s0[15]);
    w10.x = cvtpk(s1[0], s1[1]); w10.y = cvtpk(s1[2], s1[3]); w10.z = cvtpk(s1[4], s1[5]); w10.w = cvtpk(s1[6], s1[7]);
    w11.x = cvtpk(s1[8], s1[9]); w11.y = cvtpk(s1[10], s1[11]); w11.z = cvtpk(s1[12], s1[13]); w11.w = cvtpk(s1[14], s1[15]);
    const bf16x8 p00 = __builtin_bit_cast(bf16x8, w00), p01 = __builtin_bit_cast(bf16x8, w01), p10 = __builtin_bit_cast(bf16x8, w10), p11 = __builtin_bit_cast(bf16x8, w11);
    __builtin_amdgcn_s_setprio(1);
#pragma unroll
    for (int db = 0; db < NDB; ++db) {
        O[db] = MFMA32(vf[db][0], p00, O[db]);
        O[db] = MFMA32(vf[db][1], p01, O[db]);
        O[db] = MFMA32(vf[db][2], p10, O[db]);
        O[db] = MFMA32(vf[db][3], p11, O[db]);
    }
    __builtin_amdgcn_s_setprio(0);
}

template <int DV, bool WINDOW>
__device__ __forceinline__ void compute_block32(const unsigned char* kb, const unsigned char* vb0, const bf16x8 (&qf)[4], f32x16& negm,
                                                f32x16 (&O)[DV / 32], float& m_run, float& l_run, const bool mtile, const int jb0, const int qpos, const int hi, const bool first) {
    constexpr int NDB = DV / 32;
    constexpr float THR = 8.0f;
    f32x16 s;
    bf16x8 kf[4], vf[NDB][2];
#pragma unroll
    for (int kk = 0; kk < 4; ++kk) kf[kk] = *(const bf16x8*)(kb + kk * 32);
#pragma unroll
    for (int db = 0; db < NDB; ++db) { vf[db][0] = *(const bf16x8*)(vb0 + db * 32 * 144); vf[db][1] = *(const bf16x8*)(vb0 + db * 32 * 144 + 32); }
    __builtin_amdgcn_sched_barrier(0);
#pragma unroll
    for (int r = 0; r < 16; ++r) s[r] = 0.f;
    __builtin_amdgcn_s_setprio(1);
#pragma unroll
    for (int kk = 0; kk < 4; ++kk) s = MFMA32(kf[kk], qf[kk], s);
    __builtin_amdgcn_s_setprio(0);
    if (WINDOW && mtile) {
#pragma unroll
        for (int r = 0; r < 16; ++r) {
            const int j = jb0 + 16 * (r >> 3) + 8 * hi + (r & 7);
            const int d0 = qpos - j;
            if (d0 > 128 || d0 < -128) s[r] = -1e30f;
        }
    }
    float mx = s[0];
#pragma unroll
    for (int r = 1; r < 16; ++r) mx = fmaxf(mx, s[r]);
    {
        auto rr = __builtin_amdgcn_permlane32_swap(__float_as_uint(mx), __float_as_uint(mx), false, false);
        mx = fmaxf(__uint_as_float(rr[0]), __uint_as_float(rr[1]));
    }
    mx -= m_run;
    if (first || __any(mx > THR)) {
        const float dl = first ? mx : fmaxf(mx, 0.f);
        m_run += dl;
        const float alpha = fexp2(-dl);
        l_run *= alpha;
#pragma unroll
        for (int db = 0; db < NDB; ++db)
#pragma unroll
            for (int r = 0; r < 16; ++r) O[db][r] *= alpha;
    }
    float rs = 0.f;
#pragma unroll
    for (int r = 0; r < 16; ++r) { s[r] = fexp2(s[r] - m_run); rs += s[r]; }
    l_run += rs;
    u32x4 w0, w1;
    w0.x = cvtpk(s[0], s[1]); w0.y = cvtpk(s[2], s[3]); w0.z = cvtpk(s[4], s[5]); w0.w = cvtpk(s[6], s[7]);
    w1.x = cvtpk(s[8], s[9]); w1.y = cvtpk(s[10], s[11]); w1.z = cvtpk(s[12], s[13]); w1.w = cvtpk(s[14], s[15]);
    const bf16x8 p0 = __builtin_bit_cast(bf16x8, w0), p1 = __builtin_bit_cast(bf16x8, w1);
    __builtin_amdgcn_s_setprio(1);
#pragma unroll
    for (int db = 0; db < NDB; ++db) {
        O[db] = MFMA32(vf[db][0], p0, O[db]);
        O[db] = MFMA32(vf[db][1], p1, O[db]);
    }
    __builtin_amdgcn_s_setprio(0);
}

template <int DV, bool WINDOW>
__device__ __forceinline__ void attn_pass(const bf16x8 (&qf)[4], const bf16_t* __restrict__ Kg, const bf16_t* __restrict__ Vg, const int NK,
                                          const int nt_lead, const int lt_lo, const int lt_hi, const int qpos, const int wq0,
                                          f32x16 (&O)[DV / 32], float& m_run, float& l_run, unsigned char* lds, const int tid) {
    constexpr int NDB = DV / 32, NVH = DV / 64, BUFB = 9216 + DV * 144;
    constexpr float THR = 8.0f;
    const int lane = tid & 63, i = lane & 31, hi = lane >> 5;
    const int pi = (i & 0x13) | ((i & 4) << 1) | ((i & 8) >> 1);
    const int krow = tid >> 3, kch = tid & 7;
    const int T = nt_lead + (lt_hi - lt_lo);
    const unsigned stK = krow * 144 + kch * 16;
    const unsigned rdK = pi * 144 + hi * 16, rdV = 9216 + i * 144 + hi * 16;
    u32x4 kregA, vregA[NVH], kregB, vregB[NVH];
    f32x16 negm;
#pragma unroll
    for (int r = 0; r < 16; ++r) negm[r] = 0.f;
    m_run = 0.f;
#define TILE_OF(it) ((it) < nt_lead ? (it) : lt_lo + ((it) - nt_lead))
#define LOADT(KR, VR, kt) do { KR = *(const u32x4*)(Kg + (size_t)((kt) * 64 + krow) * 64 + kch * 8); \
        _Pragma("unroll") for (int h_ = 0; h_ < NVH; ++h_) VR[h_] = *(const u32x4*)(Vg + (size_t)(h_ * 64 + krow) * NK + (kt) * 64 + kch * 8); } while (0)
#define STORET(KR, VR, buf) do { *(u32x4*)(lds + (buf) * BUFB + stK) = KR; \
        _Pragma("unroll") for (int h_ = 0; h_ < NVH; ++h_) *(u32x4*)(lds + (buf) * BUFB + 9216 + (h_ * 64 + krow) * 144 + kch * 16) = VR[h_]; } while (0)
#define STEP(it, KR, VR) do { \
        STORET(KR, VR, ((it) + 1) & 1); \
        { const int i3_ = ((it) + 3 < T) ? (it) + 3 : T - 1; const int kt3 = TILE_OF(i3_); LOADT(KR, VR, kt3); } \
        const int kt = TILE_OF(it); \
        const bool mtile = WINDOW && ((it) >= nt_lead); \
        const int j0 = kt * 64 - 256; \
        bool active = true; \
        if (mtile) active = (j0 + 63 >= wq0 - 128) && (j0 <= wq0 + 31 + 128); \
        if (active) { if (DV == 128) { const unsigned char* b_ = lds + ((it) & 1) * BUFB; \
                compute_block32<DV, WINDOW>(b_ + rdK, b_ + rdV, qf, negm, O, m_run, l_run, mtile, j0, qpos, hi, (it) == 0); \
                compute_block32<DV, WINDOW>(b_ + rdK + 32 * 144, b_ + rdV + 64, qf, negm, O, m_run, l_run, mtile, j0 + 32, qpos, hi, false); } \
            else compute_tile<DV, WINDOW>(lds + ((it) & 1) * BUFB, rdK, rdV, qf, negm, O, m_run, l_run, mtile, j0, qpos, hi, (it) == 0); } \
        asm volatile("s_waitcnt lgkmcnt(0)\n\ts_barrier" ::: "memory"); } while (0)
    { const int kt0 = TILE_OF(0); LOADT(kregA, vregA, kt0); }
    { const int i1_ = T > 1 ? 1 : T - 1; const int kt1 = TILE_OF(i1_); LOADT(kregB, vregB, kt1); }
    STORET(kregA, vregA, 0);
    { const int i2_ = T > 2 ? 2 : T - 1; const int kt2 = TILE_OF(i2_); LOADT(kregA, vregA, kt2); }
    asm volatile("s_waitcnt lgkmcnt(0)\n\ts_barrier" ::: "memory");
    for (int it = 0; it < T; it += 2) {
        STEP(it, kregB, vregB);
        if (it + 1 < T) STEP(it + 1, kregA, vregA);
    }
#undef TILE_OF
#undef LOADT
#undef STORET
#undef STEP
}

template <int NDB>
__device__ __forceinline__ void write_y(const f32x16 (&R)[NDB], const bf16_t* zgate, bf16_t* yout, int hi) {
#pragma unroll
    for (int db = 0; db < NDB; ++db)
#pragma unroll
        for (int g = 0; g < 4; g += 2) {
            float v[8];
#pragma unroll
            for (int k = 0; k < 4; ++k) {
                auto rr = __builtin_amdgcn_permlane32_swap(__float_as_uint(R[db][4 * g + k]), __float_as_uint(R[db][4 * (g + 1) + k]), false, false);
                v[k] = __uint_as_float(rr[0]); v[4 + k] = __uint_as_float(rr[1]);
            }
            const int d0 = 32 * db + 8 * (g + hi);
            const u32x4 gw = *(const u32x4*)(zgate + d0);
            u32x4 o;
            o.x = cvtpk(v[0] * siluf(bflo(gw.x)), v[1] * siluf(bfhi(gw.x))); o.y = cvtpk(v[2] * siluf(bflo(gw.y)), v[3] * siluf(bfhi(gw.y)));
            o.z = cvtpk(v[4] * siluf(bflo(gw.z)), v[5] * siluf(bfhi(gw.z))); o.w = cvtpk(v[6] * siluf(bflo(gw.w)), v[7] * siluf(bfhi(gw.w)));
            *(u32x4*)(yout + d0) = o;
        }
}

template <int NDB>
__device__ __forceinline__ void softmax1(f32x16& s, f32x16 (&O)[NDB], float& m_run, float& l_run, const bool first, bf16x8& p0, bf16x8& p1) {
    constexpr float THR = 8.0f;
    float mx = s[0];
#pragma unroll
    for (int r = 1; r < 16; ++r) mx = fmaxf(mx, s[r]);
    {
        auto rr = __builtin_amdgcn_permlane32_swap(__float_as_uint(mx), __float_as_uint(mx), false, false);
        mx = fmaxf(__uint_as_float(rr[0]), __uint_as_float(rr[1]));
    }
    mx -= m_run;
    if (first || __any(mx > THR)) {
        const float dl = first ? mx : fmaxf(mx, 0.f);
        m_run += dl;
        const float alpha = fexp2(-dl);
        l_run *= alpha;
#pragma unroll
        for (int db = 0; db < NDB; ++db)
#pragma unroll
            for (int r = 0; r < 16; ++r) O[db][r] *= alpha;
    }
    float rs = 0.f;
#pragma unroll
    for (int r = 0; r < 16; ++r) { s[r] = fexp2(s[r] - m_run); rs += s[r]; }
    l_run += rs;
    u32x4 w0, w1;
    w0.x = cvtpk(s[0], s[1]); w0.y = cvtpk(s[2], s[3]); w0.z = cvtpk(s[4], s[5]); w0.w = cvtpk(s[6], s[7]);
    w1.x = cvtpk(s[8], s[9]); w1.y = cvtpk(s[10], s[11]); w1.z = cvtpk(s[12], s[13]); w1.w = cvtpk(s[14], s[15]);
    p0 = __builtin_bit_cast(bf16x8, w0); p1 = __builtin_bit_cast(bf16x8, w1);
}
__device__ __forceinline__ void attn_pass_q2(const bf16x8 (&qfA)[4], const bf16x8 (&qfB)[4], const bf16_t* __restrict__ Kg, const bf16_t* __restrict__ Vg, const int NK, const int T,
                                             f32x16 (&OA)[2], f32x16 (&OB)[2], float& mA, float& lA, float& mB, float& lB, unsigned char* lds, const int tid) {
    constexpr int BUFB = 9216 + 64 * 144;
    const int lane = tid & 63, i = lane & 31, hi = lane >> 5;
    const int pi = (i & 0x13) | ((i & 4) << 1) | ((i & 8) >> 1);
    const int krow = tid >> 3, kch = tid & 7;
    const unsigned stK = krow * 144 + kch * 16;
    const unsigned rdK = pi * 144 + hi * 16, rdV = 9216 + i * 144 + hi * 16;
    u32x4 kreg, vreg;
    mA = 0.f; mB = 0.f;
    const unsigned kgo = (unsigned)(krow * 64 + kch * 8) * 2u, vgo = (unsigned)(krow * NK + kch * 8) * 2u;
#define LOADT2(kt) do { kreg = *(const u32x4*)((const char*)Kg + (size_t)(kt) * 8192 + kgo); vreg = *(const u32x4*)((const char*)Vg + (size_t)(kt) * 128 + vgo); } while (0)
#define STORET2(off) do { *(u32x4*)(lds + (off) + stK) = kreg; *(u32x4*)(lds + (off) + 9216 + stK) = vreg; } while (0)
#define QK2(SA, SB, kptr) do { bf16x8 kf_[4]; \
        _Pragma("unroll") for (int kk = 0; kk < 4; ++kk) kf_[kk] = *(const bf16x8*)((kptr) + kk * 32); \
        _Pragma("unroll") for (int r = 0; r < 16; ++r) { SA[r] = 0.f; SB[r] = 0.f; } \
        __builtin_amdgcn_s_setprio(1); \
        _Pragma("unroll") for (int kk = 0; kk < 4; ++kk) { SA = MFMA32(kf_[kk], qfA[kk], SA); SB = MFMA32(kf_[kk], qfB[kk], SB); } \
        __builtin_amdgcn_s_setprio(0); } while (0)
#define SMPV2(SA, SB, vptr, first) do { bf16x8 vf_[4], p0_, p1_; \
        _Pragma("unroll") for (int q = 0; q < 4; ++q) vf_[q] = *(const bf16x8*)((vptr) + (q >> 1) * 32 * 144 + (q & 1) * 32); \
        softmax1<2>(SA, OA, mA, lA, (first), p0_, p1_); \
        __builtin_amdgcn_s_setprio(1); \
        OA[0] = MFMA32(vf_[0], p0_, OA[0]); OA[1] = MFMA32(vf_[2], p0_, OA[1]); OA[0] = MFMA32(vf_[1], p1_, OA[0]); OA[1] = MFMA32(vf_[3], p1_, OA[1]); \
        __builtin_amdgcn_s_setprio(0); \
        softmax1<2>(SB, OB, mB, lB, (first), p0_, p1_); \
        __builtin_amdgcn_s_setprio(1); \
        OB[0] = MFMA32(vf_[0], p0_, OB[0]); OB[1] = MFMA32(vf_[2], p0_, OB[1]); OB[0] = MFMA32(vf_[1], p1_, OB[0]); OB[1] = MFMA32(vf_[3], p1_, OB[1]); \
        __builtin_amdgcn_s_setprio(0); } while (0)
    LOADT2(0); STORET2(0);
    { const int t1 = T > 1 ? 1 : T - 1; LOADT2(t1); } STORET2(BUFB);
    { const int t2 = T > 2 ? 2 : T - 1; LOADT2(t2); }
    asm volatile("s_waitcnt lgkmcnt(0)\n\ts_barrier" ::: "memory");
    unsigned o_cur = 0, o_nxt = BUFB, o_nn = 2 * BUFB;
    f32x16 sXA, sXB, sYA, sYB;
    QK2(sXA, sXB, lds + o_cur + rdK);
    for (int t = 0; t < T; ++t) {
        QK2(sYA, sYB, lds + o_cur + rdK + 32 * 144);
        __builtin_amdgcn_sched_barrier(0);
        SMPV2(sXA, sXB, lds + o_cur + rdV, t == 0);
        __builtin_amdgcn_sched_barrier(0);
        if (t + 1 < T) {
            asm volatile("s_waitcnt lgkmcnt(0)\n\ts_barrier" ::: "memory");
            STORET2(o_nn);
            { const int t3 = (t + 3 < T) ? t + 3 : T - 1; LOADT2(t3); }
            QK2(sXA, sXB, lds + o_nxt + rdK);
        }
        __builtin_amdgcn_sched_barrier(0);
        SMPV2(sYA, sYB, lds + o_cur + rdV + 64, false);
        __builtin_amdgcn_sched_barrier(0);
        { const unsigned tmp = o_cur; o_cur = o_nxt; o_nxt = o_nn; o_nn = tmp; }
    }
    asm volatile("s_waitcnt lgkmcnt(0)\n\ts_barrier" ::: "memory");
#undef LOADT2
#undef STORET2
#undef QK2
#undef SMPV2
}

__device__ __forceinline__ void attn_pass_w2(const bf16x8 (&qfA)[4], const bf16x8 (&qfB)[4], const bf16_t* __restrict__ Kg, const bf16_t* __restrict__ Vg, const int NK,
                                             const int lt_lo, const int lt_hi, const int qpos, const int wq0,
                                             f32x16 (&OA)[2], f32x16 (&OB)[2], float& mA, float& lA, float& mB, float& lB, unsigned char* lds, const int tid) {
    constexpr int BUFB = 9216 + 64 * 144;
    const int lane = tid & 63, i = lane & 31, hi = lane >> 5;
    const int pi = (i & 0x13) | ((i & 4) << 1) | ((i & 8) >> 1);
    const int krow = tid >> 3, kch = tid & 7;
    const int T = 4 + (lt_hi - lt_lo);
    const unsigned stK = krow * 144 + kch * 16;
    const unsigned rdK = pi * 144 + hi * 16, rdV = 9216 + i * 144 + hi * 16;
    const unsigned kgo = (unsigned)(krow * 64 + kch * 8) * 2u, vgo = (unsigned)(krow * NK + kch * 8) * 2u;
    u32x4 kregA, vregA;
    mA = 0.f; mB = 0.f;
#define TILE_W(it) ((it) < 4 ? (it) : lt_lo + ((it) - 4))
#define LOADW(KR, VR, kt) do { KR = *(const u32x4*)((const char*)Kg + (size_t)(kt) * 8192 + kgo); VR = *(const u32x4*)((const char*)Vg + (size_t)(kt) * 128 + vgo); } while (0)
#define STOREW(KR, VR, buf) do { *(u32x4*)(lds + (buf) * BUFB + stK) = KR; *(u32x4*)(lds + (buf) * BUFB + 9216 + stK) = VR; } while (0)
#define STEPW(it, KR, VR) do { \
        STOREW(KR, VR, ((it) + 1) & 1); \
        { const int i3_ = ((it) + 2 < T) ? (it) + 2 : T - 1; const int kt3_ = TILE_W(i3_); LOADW(KR, VR, kt3_); } \
        const int kt_ = TILE_W(it); \
        const bool mtile_ = (it) >= 4; \
        const int j0_ = kt_ * 64 - 256; \
        const bool active_ = !mtile_ || ((j0_ + 63 >= wq0 - 128) && (j0_ <= wq0 + 31 + 128)); \
        if (active_) { \
            const unsigned char* base = lds + ((it) & 1) * BUFB; \
            _Pragma("unroll") for (int kb = 0; kb < 2; ++kb) { \
                bf16x8 kf[4], vf[4]; \
                _Pragma("unroll") for (int kk = 0; kk < 4; ++kk) kf[kk] = *(const bf16x8*)(base + rdK + kb * 32 * 144 + kk * 32); \
                _Pragma("unroll") for (int q = 0; q < 4; ++q) vf[q] = *(const bf16x8*)(base + rdV + (q >> 1) * 32 * 144 + kb * 64 + (q & 1) * 32); \
                bf16x8 p0, p1; \
                { f32x16 sA; \
                  _Pragma("unroll") for (int r = 0; r < 16; ++r) sA[r] = 0.f; \
                  _Pragma("unroll") for (int kk = 0; kk < 4; ++kk) sA = MFMA32(kf[kk], qfA[kk], sA); \
                  if (mtile_) { int qd_ = qpos - j0_ - 32 * kb - 8 * hi; asm volatile("" : "+v"(qd_));     \
                      _Pragma("unroll") for (int r = 0; r < 16; ++r) { \
                          const int d0_ = qd_ - (16 * (r >> 3) + (r & 7)); \
                          if (d0_ > 128 || d0_ < -128) sA[r] = -1e30f; } } \
                  softmax1<2>(sA, OA, mA, lA, (it) == 0 && kb == 0, p0, p1); } \
                OA[0] = MFMA32(vf[0], p0, OA[0]); OA[1] = MFMA32(vf[2], p0, OA[1]); OA[0] = MFMA32(vf[1], p1, OA[0]); OA[1] = MFMA32(vf[3], p1, OA[1]); \
                { f32x16 sB; \
                  _Pragma("unroll") for (int r = 0; r < 16; ++r) sB[r] = 0.f; \
                  _Pragma("unroll") for (int kk = 0; kk < 4; ++kk) sB = MFMA32(kf[kk], qfB[kk], sB); \
                  if (mtile_) { int qd_ = qpos - j0_ - 32 * kb - 8 * hi; asm volatile("" : "+v"(qd_));     \
                      _Pragma("unroll") for (int r = 0; r < 16; ++r) { \
                          const int d0_ = qd_ - (16 * (r >> 3) + (r & 7)); \
                          if (d0_ > 128 || d0_ < -128) sB[r] = -1e30f; } } \
                  softmax1<2>(sB, OB, mB, lB, (it) == 0 && kb == 0, p0, p1); } \
                OB[0] = MFMA32(vf[0], p0, OB[0]); OB[1] = MFMA32(vf[2], p0, OB[1]); OB[0] = MFMA32(vf[1], p1, OB[0]); OB[1] = MFMA32(vf[3], p1, OB[1]); \
            } } \
        asm volatile("s_waitcnt lgkmcnt(0)\n\ts_barrier" ::: "memory"); } while (0)
    LOADW(kregA, vregA, 0);
    STOREW(kregA, vregA, 0);
    { const int kt1 = TILE_W(1); LOADW(kregA, vregA, kt1); }
    asm volatile("s_waitcnt lgkmcnt(0)\n\ts_barrier" ::: "memory");
    for (int it = 0; it < T; ++it) STEPW(it, kregA, vregA);
#undef TILE_W
#undef LOADW
#undef STOREW
#undef STEPW
}

__device__ __forceinline__ void unit_A2(const Params& p, int u, unsigned char* lds, int tid) {
    unsigned char* ws = p.ws;
    const bf16_t* Z = (const bf16_t*)(ws + WS_Z); bf16_t* Y = (bf16_t*)(ws + WS_XN);
    const int qb = u & 31, kv = (u >> 5) & 1, b = u >> 6;
    const int q0 = qb * 128;
    f32x16 OA[2], OB[2];
    float mA, lA = 0.f, mB, lB = 0.f;
    {
        const float* cosT = (const float*)(ws + WS_ROPE); const float* sinT = cosT + 1024;
        const int wave = tid >> 6, lane = tid & 63, i = lane & 31, hi = lane >> 5;
        const int hA = kv * 4 + 2 * (wave >> 2);
        const int wq0 = q0 + (wave & 3) * 32, qloc = wq0 + i;
        const bf16_t* zrow = Z + ((size_t)NCTXTOK + (size_t)b * 4096 + qloc) * PZ;
        bf16x8 qfA[4], qfB[4];
        load_q<false, true>(zrow + hA * 64, hi, nullptr, qloc, cosT, sinT, qfA);
        load_q<false, true>(zrow + hA * 64 + 64, hi, nullptr, qloc, cosT, sinT, qfB);
        const bf16_t* Kg = (const bf16_t*)(ws + L0_KA_LAT) + (size_t)(b * 2 + kv) * NKL * 64;
        const bf16_t* Vg = (const bf16_t*)(ws + L0_VTA_LAT) + (size_t)(b * 2 + kv) * 64 * NKL;
#pragma unroll
        for (int db = 0; db < 2; ++db)
#pragma unroll
            for (int r = 0; r < 16; ++r) { OA[db][r] = 0.f; OB[db][r] = 0.f; }
        const int tq = q0 >> 6;
        const int lo = 4 + (tq - 2 > 0 ? tq - 2 : 0), hiT = 4 + (tq + 4 < 64 ? tq + 4 : 64);
        attn_pass_w2(qfA, qfB, Kg, Vg, NKL, lo, hiT, qloc, wq0, OA, OB, mA, lA, mB, lB, lds, tid);
    }
    int t2 = threadIdx.x; asm volatile("" : "+v"(t2));
    const int wave = t2 >> 6, lane = t2 & 63, i = lane & 31, hi = lane >> 5;
    const int hA = kv * 4 + 2 * (wave >> 2), hB = hA + 1;
    const int qloc = q0 + (wave & 3) * 32 + i;
    const size_t tok = (size_t)NCTXTOK + (size_t)b * 4096 + qloc;
    const bf16_t* zrow = Z + tok * PZ;
    lA += __shfl_xor(lA, 32); lB += __shfl_xor(lB, 32);
    lA += fexp2(p.in[I_SINK][hA] * LOG2E - mA); lB += fexp2(p.in[I_SINK][hB] * LOG2E - mB);
    const float iA = 1.0f / lA, iB = 1.0f / lB;
#pragma unroll
    for (int db = 0; db < 2; ++db)
#pragma unroll
        for (int r = 0; r < 16; ++r) { OA[db][r] *= iA; OB[db][r] *= iB; }
    write_y<2>(OA, zrow + 2304 + hA * 64, Y + tok * DM + hA * 64, hi);
    write_y<2>(OB, zrow + 2304 + hB * 64, Y + tok * DM + hB * 64, hi);
}

__device__ __forceinline__ void unit_D2(const Params& p, int u, unsigned char* lds, int tid) {
    unsigned char* ws = p.ws;
    const bf16_t* Z = (const bf16_t*)(ws + WS_Z); bf16_t* Y = (bf16_t*)(ws + WS_XN);
    const float* cosT = (const float*)(ws + WS_ROPE); const float* sinT = cosT + 1024;
    const int qb = u & 7, hq = (u >> 3) & 7, b = u >> 6;
    const int kvh = hq >> 2, wave = tid >> 6, lane = tid & 63, i = lane & 31, hi = lane >> 5;
    const int qA = qb * 512 + wave * 64 + i, qB = qA + 32;
    const size_t tokA = (size_t)NCTXTOK + (size_t)b * 4096 + qA, tokB = tokA + 32;
    bf16x8 qfA[4], qfB[4];
    load_q<true, true>(Z + tokA * PZ + 1536 + hq * 64, hi, p.in[I_DQG], qA, cosT, sinT, qfA);
    load_q<true, true>(Z + tokB * PZ + 1536 + hq * 64, hi, p.in[I_DQG], qB, cosT, sinT, qfB);
    const bf16_t* Kg = (const bf16_t*)(ws + L1_KD_LAT) + (size_t)(b * 2 + kvh) * NKL * 64;
    const bf16_t* Vg = (const bf16_t*)(ws + L1_VTD_LAT) + (size_t)(b * 2 + kvh) * 64 * NKL;
    f32x16 OA[2], OB[2];
#pragma unroll
    for (int db = 0; db < 2; ++db)
#pragma unroll
        for (int r = 0; r < 16; ++r) { OA[db][r] = 0.f; OB[db][r] = 0.f; }
    float mA, lA = 0.f, mB, lB = 0.f;
    attn_pass_q2(qfA, qfB, Kg, Vg, NKL, NKL / 64, OA, OB, mA, lA, mB, lB, lds, tid);
    lA += __shfl_xor(lA, 32); lB += __shfl_xor(lB, 32);
    const float iA = 1.0f / lA, iB = 1.0f / lB;
#pragma unroll
    for (int db = 0; db < 2; ++db)
#pragma unroll
        for (int r = 0; r < 16; ++r) { OA[db][r] *= iA; OB[db][r] *= iB; }
    write_y<2>(OA, Z + tokA * PZ + 2816 + hq * 64, Y + tokA * DM + 512 + hq * 64, hi);
    write_y<2>(OB, Z + tokB * PZ + 2816 + hq * 64, Y + tokB * DM + 512 + hq * 64, hi);
}

template <bool LAT>
__device__ __forceinline__ void unit_A(const Params& p, int u, unsigned char* lds, int tid) {
    unsigned char* ws = p.ws;
    const bf16_t* Z = (const bf16_t*)(ws + WS_Z); bf16_t* Y = (bf16_t*)(ws + WS_XN);
    const float* cosT = (const float*)(ws + WS_ROPE); const float* sinT = cosT + 1024;
    int qb, hq, b;
    if (LAT) { qb = u & 15; hq = (u >> 4) & 7; b = u >> 7; } else { qb = 0; hq = u & 7; b = u >> 3; }
    const int kvh = hq >> 2, wave = tid >> 6, lane = tid & 63, i = lane & 31, hi = lane >> 5;
    const int q0 = qb * 256, qloc = q0 + wave * 32 + i;
    const size_t tok = LAT ? (size_t)NCTXTOK + (size_t)b * 4096 + qloc : (size_t)b * 256 + qloc;
    const bf16_t* zrow = Z + tok * PZ;
    bf16x8 qf[4];
    load_q<false, LAT>(zrow + hq * 64, hi, nullptr, qloc, cosT, sinT, qf);
    const int NK = LAT ? NKL : 256;
    const bf16_t* Kg = (const bf16_t*)(ws + (LAT ? L0_KA_LAT : L0_KA_CTX)) + (size_t)(b * 2 + kvh) * NK * 64;
    const bf16_t* Vg = (const bf16_t*)(ws + (LAT ? L0_VTA_LAT : L0_VTA_CTX)) + (size_t)(b * 2 + kvh) * 64 * NK;
    f32x16 O[2];
#pragma unroll
    for (int db = 0; db < 2; ++db)
#pragma unroll
        for (int r = 0; r < 16; ++r) O[db][r] = 0.f;
    float m = -1e30f, l = 0.f;
    if (LAT) {
        const int tq = q0 >> 6;
        const int lo = 4 + (tq - 2 > 0 ? tq - 2 : 0), hiT = 4 + (tq + 6 < 64 ? tq + 6 : 64);
        attn_pass<64, true>(qf, Kg, Vg, NK, 4, lo, hiT, qloc, q0 + wave * 32, O, m, l, lds, tid);
    } else {
        attn_pass<64, false>(qf, Kg, Vg, NK, 4, 0, 0, 0, 0, O, m, l, lds, tid);
    }
    l += __shfl_xor(l, 32);
    l += fexp2(p.in[I_SINK][hq] * LOG2E - m);
    const float inv = 1.0f / l;
#pragma unroll
    for (int db = 0; db < 2; ++db)
#pragma unroll
        for (int r = 0; r < 16; ++r) O[db][r] *= inv;
    write_y<2>(O, zrow + 2304 + hq * 64, Y + tok * DM + hq * 64, hi);
}

template <bool LAT>
__device__ __forceinline__ void unit_B(const Params& p, int u, unsigned char* lds, int tid) {
    unsigned char* ws = p.ws;
    const bf16_t* Z = (const bf16_t*)(ws + WS_Z); bf16_t* Y = (bf16_t*)(ws + WS_XN);
    const float* cosT = (const float*)(ws + WS_ROPE); const float* sinT = cosT + 1024;
    int qb, h, b;
    if (LAT) { qb = u & 15; h = (u >> 4) & 3; b = u >> 6; } else { qb = 0; h = u & 3; b = u >> 2; }
    const int wave = tid >> 6, lane = tid & 63, i = lane & 31, hi = lane >> 5;
    const int q0 = qb * 256, qloc = q0 + wave * 32 + i;
    const size_t tok = LAT ? (size_t)NCTXTOK + (size_t)b * 4096 + qloc : (size_t)b * 256 + qloc;
    const bf16_t* zrow = Z + tok * PZ;
    const int NK = LAT ? NKL : 256;
    const float lam = *(const float*)(ws + WS_LAM);
    const bf16_t* Vg = (const bf16_t*)(ws + (LAT ? L0_VTB_LAT : L0_VTB_CTX)) + (size_t)(b * 4 + h) * 128 * NK;
    f32x16 R[4];
#pragma unroll 1
    for (int pass = 0; pass < 2; ++pass) {
        bf16x8 qf[4];
        load_q<false, LAT>(zrow + 768 + h * 128 + pass * 64, hi, nullptr, qloc, cosT, sinT, qf);
        const size_t kb = LAT ? (pass ? L0_KB2_LAT : L0_KB1_LAT) : (pass ? L0_KB2_CTX : L0_KB1_CTX);
        const bf16_t* Kg = (const bf16_t*)(ws + kb) + (size_t)(b * 4 + h) * NK * 64;
#pragma unroll
        for (int db = 0; db < 4; ++db)
#pragma unroll
            for (int r = 0; r < 16; ++r) R[db][r] = 0.f;
        float m = -1e30f, l = 0.f;
        attn_pass<128, false>(qf, Kg, Vg, NK, NK / 64, 0, 0, 0, 0, R, m, l, lds, tid);
        l += __shfl_xor(l, 32);
        const float inv = 1.0f / l;
        unsigned* stash = (unsigned*)(lds + 55296 + wave * 8192) + lane;
        if (pass == 0) {
#pragma unroll
            for (int db = 0; db < 4; ++db)
#pragma unroll
                for (int r = 0; r < 8; ++r) stash[(db * 8 + r) * 64] = cvtpk(R[db][2 * r] * inv, R[db][2 * r + 1] * inv);
        } else {
            const float f = lam * inv;
#pragma unroll
            for (int db = 0; db < 4; ++db)
#pragma unroll
                for (int r = 0; r < 8; ++r) { const unsigned w = stash[(db * 8 + r) * 64]; R[db][2 * r] = bflo(w) - f * R[db][2 * r]; R[db][2 * r + 1] = bfhi(w) - f * R[db][2 * r + 1]; }
        }
    }
    float ss = 0.f;
#pragma unroll
    for (int db = 0; db < 4; ++db)
#pragma unroll
        for (int r = 0; r < 16; ++r) ss += R[db][r] * R[db][r];
    ss += __shfl_xor(ss, 32);
    const float rinv = rsqrtf(ss * (1.0f / 128.0f) + EPS) * 0.8f;
    const float* bng = p.in[I_BNG];
#pragma unroll
    for (int db = 0; db < 4; ++db)
#pragma unroll
        for (int g = 0; g < 4; ++g) {
            const f32x4 gg = *(const f32x4*)(bng + 32 * db + 8 * g + 4 * hi);
            R[db][4 * g] *= rinv * gg.x; R[db][4 * g + 1] *= rinv * gg.y; R[db][4 * g + 2] *= rinv * gg.z; R[db][4 * g + 3] *= rinv * gg.w;
        }
    write_y<4>(R, zrow + 2816 + h * 128, Y + tok * DM + 512 + h * 128, hi);
}

template <bool LAT>
__device__ __forceinline__ void unit_D(const Params& p, int u, unsigned char* lds, int tid) {
    unsigned char* ws = p.ws;
    const bf16_t* Z = (const bf16_t*)(ws + WS_Z); bf16_t* Y = (bf16_t*)(ws + WS_XN);
    const float* cosT = (const float*)(ws + WS_ROPE); const float* sinT = cosT + 1024;
    int qb, hq, b;
    if (LAT) { qb = u & 15; hq = (u >> 4) & 7; b = u >> 7; } else { qb = 0; hq = u & 7; b = u >> 3; }
    const int kvh = hq >> 2, wave = tid >> 6, lane = tid & 63, i = lane & 31, hi = lane >> 5;
    const int q0 = qb * 256, qloc = q0 + wave * 32 + i;
    const size_t tok = LAT ? (size_t)NCTXTOK + (size_t)b * 4096 + qloc : (size_t)b * 256 + qloc;
    const bf16_t* zrow = Z + tok * PZ;
    bf16x8 qf[4];
    load_q<true, LAT>(zrow + 1536 + hq * 64, hi, p.in[I_DQG], qloc, cosT, sinT, qf);
    const int NK = LAT ? NKL : 256;
    const bf16_t* Kg = (const bf16_t*)(ws + (LAT ? L1_KD_LAT : L1_KD_CTX)) + (size_t)(b * 2 + kvh) * NK * 64;
    const bf16_t* Vg = (const bf16_t*)(ws + (LAT ? L1_VTD_LAT : L1_VTD_CTX)) + (size_t)(b * 2 + kvh) * 64 * NK;
    f32x16 O[2];
#pragma unroll
    for (int db = 0; db < 2; ++db)
#pragma unroll
        for (int r = 0; r < 16; ++r) O[db][r] = 0.f;
    float m = -1e30f, l = 0.f;
    attn_pass<64, false>(qf, Kg, Vg, NK, NK / 64, 0, 0, 0, 0, O, m, l, lds, tid);
    l += __shfl_xor(l, 32);
    const float inv = 1.0f / l;
#pragma unroll
    for (int db = 0; db < 2; ++db)
#pragma unroll
        for (int r = 0; r < 16; ++r) O[db][r] *= inv;
    write_y<2>(O, zrow + 2816 + hq * 64, Y + tok * DM + 512 + hq * 64, hi);
}

template <bool LAT>
__device__ __forceinline__ void scan_unit(const Params& p, int u, int lane) {
    unsigned char* ws = p.ws;
    constexpr int NS = LAT ? 4096 : 256, NCH = LAT ? 32 : 2;
    const int db = u & 3, eb = (u >> 2) & 3, dir = (u >> 4) & 1, sh = u >> 5, h = sh & 3;
    const int i = lane & 31, hi = lane >> 5;
    const bf16_t* Kt = (const bf16_t*)(ws + (LAT ? L1_KTL : L1_KTC)) + (size_t)sh * 128 * NS + (size_t)(db * 8 * 64 + lane) * 8;
    const bf16_t* Vt = (const bf16_t*)(ws + (LAT ? L1_VTL : L1_VTC)) + (size_t)sh * 128 * NS + (size_t)(eb * 8 * 64 + lane) * 8;
    bf16_t* St = (bf16_t*)(ws + (LAT ? (dir ? L1_STB_L : L1_STF_L) : (dir ? L1_STB_C : L1_STF_C))) + (size_t)sh * NCH * 16384;
    const float lg2 = -expf(p.in[dir ? I_DECB : I_DECF][h]) * LOG2E;
    f32x16 acc;
    if (LAT) {
        const float* s0 = p.in[dir ? I_SCB : I_SCF] + (size_t)sh * 16384;
#pragma unroll
        for (int r = 0; r < 16; ++r) acc[r] = s0[(size_t)(db * 32 + i) * 128 + eb * 32 + crow(r, hi)];
    } else {
#pragma unroll
        for (int r = 0; r < 16; ++r) acc[r] = 0.f;
    }
    float base[8];
#pragma unroll
    for (int jj = 0; jj < 8; ++jj) base[jj] = KSCALE_C * (dir ? fexp2(lg2 * (float)(8 * hi + jj)) : fexp2(lg2 * (float)(127 - 8 * hi - jj)));
    const float step = dir ? fexp2(16.0f * lg2) : fexp2(-16.0f * lg2);
    const float cdec = fexp2(128.0f * lg2);
    u32x4 va[8], kb[8];
    {
        const int c0 = dir ? NCH - 1 : 0;
#pragma unroll
        for (int ks = 0; ks < 8; ++ks) { va[ks] = *(const u32x4*)(Vt + (size_t)c0 * 16384 + ks * 512); kb[ks] = *(const u32x4*)(Kt + (size_t)c0 * 16384 + ks * 512); }
    }
#pragma unroll 1
    for (int cc = 0; cc < NCH; ++cc) {
        const int c = dir ? NCH - 1 - cc : cc;
        const int cn = dir ? c - 1 : c + 1;
        const bool more = cc + 1 < NCH;
        bf16_t* So = St + (size_t)c * 16384;
#pragma unroll
        for (int r = 0; r < 16; ++r) So[(size_t)(((eb * 8 + 2 * db + (i >> 4)) * 64 + ((i >> 3) & 1) * 32 + crow(r, hi)) * 8 + (i & 7))] = (bf16_t)(cvtpk(acc[r], 0.f) & 0xffffu);
#pragma unroll
        for (int r = 0; r < 16; ++r) acc[r] *= cdec;
        float f[8];
#pragma unroll
        for (int jj = 0; jj < 8; ++jj) f[jj] = base[jj];
#pragma unroll
        for (int ks = 0; ks < 8; ++ks) {
            float v[8]; unpack8(va[ks], v);
#pragma unroll
            for (int jj = 0; jj < 8; ++jj) { v[jj] *= f[jj]; f[jj] *= step; }
            const bf16x8 a = __builtin_bit_cast(bf16x8, pack8(v));
            const bf16x8 bq = __builtin_bit_cast(bf16x8, kb[ks]);
            if (more) { va[ks] = *(const u32x4*)(Vt + (size_t)cn * 16384 + ks * 512); kb[ks] = *(const u32x4*)(Kt + (size_t)cn * 16384 + ks * 512); }
            acc = MFMA32(a, bq, acc);
        }
    }
    if (!LAT) {
        float* o = p.out + (dir ? O_CB : O_CF) + (size_t)sh * 16384;
#pragma unroll
        for (int r = 0; r < 16; ++r) o[(size_t)(db * 32 + i) * 128 + eb * 32 + crow(r, hi)] = acc[r];
    }
}

template <bool LAT>
__device__ __forceinline__ void retout_unit(const Params& p, int u, int lane) {
    unsigned char* ws = p.ws;
    constexpr int NS = LAT ? 4096 : 256, NCH = LAT ? 32 : 2;
    const bf16_t* Z = (const bf16_t*)(ws + WS_Z); bf16_t* Y = (bf16_t*)(ws + WS_XN);
    const int ib = u & 3, c = (u >> 2) % NCH, sh = (u >> 2) / NCH, h = sh & 3, seq = sh >> 2;
    const int i = lane & 31, hi = lane >> 5;
    const int pi = (i & 0x13) | ((i & 4) << 1) | ((i & 8) >> 1);
    const size_t tok0 = LAT ? (size_t)NCTXTOK + (size_t)seq * 4096 + c * 128 : (size_t)seq * 256 + c * 128;
    const int iloc = ib * 32 + i;
    const bf16_t* zq = Z + (tok0 + iloc) * PZ + h * 128;
    bf16x8 qf[8];
#pragma unroll
    for (int kk = 0; kk < 8; ++kk) qf[kk] = *(const bf16x8*)(zq + 16 * kk + 8 * hi);
    const float lgf2 = -expf(p.in[I_DECF][h]) * LOG2E, lgb2 = -expf(p.in[I_DECB][h]) * LOG2E;
    const bf16_t* Vt = (const bf16_t*)(ws + (LAT ? L1_VTL : L1_VTC)) + (size_t)sh * 128 * NS + (size_t)c * 16384;
    const bf16_t* SF = (const bf16_t*)(ws + (LAT ? L1_STF_L : L1_STF_C)) + ((size_t)sh * NCH + c) * 16384;
    const bf16_t* SB = (const bf16_t*)(ws + (LAT ? L1_STB_L : L1_STB_C)) + ((size_t)sh * NCH + c) * 16384;
    const char* zkU = LAT ? (const char*)(ws + kf_base(sh)) + (size_t)c * 32768 : (const char*)(Z + tok0 * PZ + 512 + h * 128);
    const unsigned zkL = LAT ? (unsigned)lane * 16u : (unsigned)(pi * PZ + 8 * hi) * 2u;
    constexpr unsigned kjs = LAT ? 8192u : (unsigned)(32 * PZ * 2), kks = LAT ? 1024u : 32u;
    const char* vtU = (const char*)Vt;
    const unsigned vtL = (unsigned)lane * 16u;
    const char* sfU = (const char*)SF; const char* sbU = (const char*)SB;
    const unsigned sL = (unsigned)lane * 16u;
    f32x16 O[4];
#pragma unroll
    for (int eb = 0; eb < 4; ++eb)
#pragma unroll
        for (int r = 0; r < 16; ++r) O[eb][r] = 0.f;
    bf16x8 fa[8], fb[8];
#pragma unroll
    for (int kk = 0; kk < 8; ++kk) fa[kk] = *(const bf16x8*)(zkU + kk * kks + zkL);
#pragma unroll
    for (int q = 0; q < 8; ++q) fb[q] = *(const bf16x8*)(vtU + (size_t)((q >> 1) * 8192 + (q & 1) * 1024) + vtL);
#pragma unroll 1
    for (int jb = 0; jb < 4; ++jb) {
        const bool lastj = (jb == 3);
        const char* nA = lastj ? sfU : zkU + (size_t)(jb + 1) * kjs;
        const unsigned nAL = lastj ? sL : zkL;
        const char* nB = lastj ? sbU : vtU + (size_t)2048 * (jb + 1);
        const unsigned nBL = lastj ? sL : vtL;
        const unsigned qs1 = 1024u, qs2 = lastj ? 2048u : 8192u;
        const unsigned kst = lastj ? 1024u : kks;
        f32x16 s;
#pragma unroll
        for (int r = 0; r < 16; ++r) s[r] = 0.f;
#pragma unroll
        for (int kk = 0; kk < 8; ++kk) {
            s = MFMA32(fa[kk], qf[kk], s);
            fa[kk] = *(const bf16x8*)(nA + (size_t)(kk * kst) + nAL);
        }
#pragma unroll
        for (int r = 0; r < 16; ++r) {
            const int j = 32 * jb + 16 * (r >> 3) + 8 * hi + (r & 7);
            const int dl = iloc - j;
            const float w = dl >= 0 ? fexp2(lgf2 * (float)dl) : fexp2(lgb2 * (float)(-dl - 1));
            s[r] *= w * KSCALE_C;
        }
        u32x4 w0, w1;
        w0.x = cvtpk(s[0], s[1]); w0.y = cvtpk(s[2], s[3]); w0.z = cvtpk(s[4], s[5]); w0.w = cvtpk(s[6], s[7]);
        w1.x = cvtpk(s[8], s[9]); w1.y = cvtpk(s[10], s[11]); w1.z = cvtpk(s[12], s[13]); w1.w = cvtpk(s[14], s[15]);
        const bf16x8 p0 = __builtin_bit_cast(bf16x8, w0), p1 = __builtin_bit_cast(bf16x8, w1);
#pragma unroll
        for (int q = 0; q < 8; ++q) {
            O[q >> 1] = MFMA32(fb[q], (q & 1) ? p1 : p0, O[q >> 1]);
            fb[q] = *(const bf16x8*)(nB + (size_t)((q & 1) * qs1 + (q >> 1) * qs2) + nBL);
        }
    }
    const float wf = fexp2(lgf2 * (float)(iloc + 1)), wb = fexp2(lgb2 * (float)(127 - iloc));
#pragma unroll 1
    for (int eb = 0; eb < 4; ++eb) {
        const int ebn = eb < 3 ? eb + 1 : 3;
        const char* nA = sfU + (size_t)ebn * 8192; const char* nB = sbU + (size_t)ebn * 8192;
        f32x16 xf, xb;
#pragma unroll
        for (int r = 0; r < 16; ++r) { xf[r] = 0.f; xb[r] = 0.f; }
#pragma unroll
        for (int kk = 0; kk < 8; ++kk) {
            xf = MFMA32(fa[kk], qf[kk], xf);
            fa[kk] = *(const bf16x8*)(nA + 1024 * kk + sL);
            xb = MFMA32(fb[kk], qf[kk], xb);
            fb[kk] = *(const bf16x8*)(nB + 1024 * kk + sL);
        }
#pragma unroll
        for (int e2 = 0; e2 < 4; ++e2)
            if (e2 == eb) {
#pragma unroll
                for (int r = 0; r < 16; ++r) O[e2][r] += wf * xf[r] + wb * xb[r];
            }
    }
    float sum = 0.f;
#pragma unroll
    for (int eb = 0; eb < 4; ++eb)
#pragma unroll
        for (int r = 0; r < 16; ++r) sum += O[eb][r];
    sum += __shfl_xor(sum, 32);
    const float mu = sum * (1.0f / 128.0f);
    float var = 0.f;
#pragma unroll
    for (int eb = 0; eb < 4; ++eb)
#pragma unroll
        for (int r = 0; r < 16; ++r) { O[eb][r] -= mu; var += O[eb][r] * O[eb][r]; }
    var += __shfl_xor(var, 32);
    const float rinv = rsqrtf(var * (1.0f / 128.0f) + EPS);
    const float* cng = p.in[I_CNG] + h * 128;
#pragma unroll
    for (int eb = 0; eb < 4; ++eb)
#pragma unroll
        for (int g = 0; g < 4; ++g) {
            const f32x4 gg = *(const f32x4*)(cng + 32 * eb + 8 * g + 4 * hi);
            O[eb][4 * g] *= rinv * gg.x; O[eb][4 * g + 1] *= rinv * gg.y; O[eb][4 * g + 2] *= rinv * gg.z; O[eb][4 * g + 3] *= rinv * gg.w;
        }
    const size_t tok = tok0 + iloc;
    write_y<4>(O, Z + tok * PZ + 2304 + h * 128, Y + tok * DM + h * 128, hi);
}

template <bool LAT>
__device__ __forceinline__ void retout_block(const Params& p, int sh, int c, unsigned char* lds, int tid) {
    unsigned char* ws = p.ws;
    constexpr int NS = LAT ? 4096 : 256, NCH = LAT ? 32 : 2;
    constexpr int KL = 0, VL = 34816, SFL = VL + 32768, SBL = SFL + 32768, RED = SBL + 32768;
    const bf16_t* Z = (const bf16_t*)(ws + WS_Z); bf16_t* Y = (bf16_t*)(ws + WS_XN);
    const int h = sh & 3, seq = sh >> 2;
    const int lane = tid & 63, wave = tid >> 6, i = lane & 31, hi = lane >> 5, ib = wave & 3, eh = wave >> 2;
    const int pi = (i & 0x13) | ((i & 4) << 1) | ((i & 8) >> 1);
    const size_t tok0 = LAT ? (size_t)NCTXTOK + (size_t)seq * 4096 + c * 128 : (size_t)seq * 256 + c * 128;
    const int iloc = ib * 32 + i;
    {
        const bf16_t* ksrc = Z + (tok0 + (tid >> 2)) * PZ + 512 + h * 128 + (tid & 3) * 32;
        const char* vsrc = (const char*)((const bf16_t*)(ws + (LAT ? L1_VTL : L1_VTC)) + (size_t)sh * 128 * NS + (size_t)c * 16384);
        const char* fsrc = (const char*)((const bf16_t*)(ws + (LAT ? L1_STF_L : L1_STF_C)) + ((size_t)sh * NCH + c) * 16384);
        const char* bsrc = (const char*)((const bf16_t*)(ws + (LAT ? L1_STB_L : L1_STB_C)) + ((size_t)sh * NCH + c) * 16384);
        u32x4 kr[4], vr[4], fr[4], br[4];
#pragma unroll
        for (int q = 0; q < 4; ++q) {
            kr[q] = *(const u32x4*)(ksrc + q * 8);
            vr[q] = *(const u32x4*)(vsrc + (size_t)(tid + 512 * q) * 16);
            fr[q] = *(const u32x4*)(fsrc + (size_t)(tid + 512 * q) * 16);
            br[q] = *(const u32x4*)(bsrc + (size_t)(tid + 512 * q) * 16);
        }
        __syncthreads();
#pragma unroll
        for (int q = 0; q < 4; ++q) {
            *(u32x4*)(lds + KL + (tid >> 2) * 272 + (tid & 3) * 64 + q * 16) = kr[q];
            *(u32x4*)(lds + VL + (tid + 512 * q) * 16) = vr[q];
            *(u32x4*)(lds + SFL + (tid + 512 * q) * 16) = fr[q];
            *(u32x4*)(lds + SBL + (tid + 512 * q) * 16) = br[q];
        }
    }
    bf16x8 qf[8];
    {
        const bf16_t* zq = Z + (tok0 + iloc) * PZ + h * 128;
#pragma unroll
        for (int kk = 0; kk < 8; ++kk) qf[kk] = *(const bf16x8*)(zq + 16 * kk + 8 * hi);
    }
    const float lgf2 = -expf(p.in[I_DECF][h]) * LOG2E, lgb2 = -expf(p.in[I_DECB][h]) * LOG2E;
    __syncthreads();
    f32x16 O[2];
#pragma unroll
    for (int e2 = 0; e2 < 2; ++e2)
#pragma unroll
        for (int r = 0; r < 16; ++r) O[e2][r] = 0.f;
    const unsigned char* kbase = lds + KL + pi * 272 + hi * 16;
    const unsigned char* vbase = lds + VL + (2 * eh) * 8192 + lane * 16;
#pragma unroll 1
    for (int jb = 0; jb < 4; ++jb) {
        f32x16 s;
#pragma unroll
        for (int r = 0; r < 16; ++r) s[r] = 0.f;
#pragma unroll
        for (int kk = 0; kk < 8; ++kk) s = MFMA32(*(const bf16x8*)(kbase + jb * 32 * 272 + kk * 32), qf[kk], s);
#pragma unroll
        for (int r = 0; r < 16; ++r) {
            const int j = 32 * jb + 16 * (r >> 3) + 8 * hi + (r & 7);
            const int dl = iloc - j;
            const float w = dl >= 0 ? fexp2(lgf2 * (float)dl) : fexp2(lgb2 * (float)(-dl - 1));
            s[r] *= w * KSCALE_C;
        }
        u32x4 w0, w1;
        w0.x = cvtpk(s[0], s[1]); w0.y = cvtpk(s[2], s[3]); w0.z = cvtpk(s[4], s[5]); w0.w = cvtpk(s[6], s[7]);
        w1.x = cvtpk(s[8], s[9]); w1.y = cvtpk(s[10], s[11]); w1.z = cvtpk(s[12], s[13]); w1.w = cvtpk(s[14], s[15]);
        const bf16x8 p0 = __builtin_bit_cast(bf16x8, w0), p1 = __builtin_bit_cast(bf16x8, w1);
#pragma unroll
        for (int e2 = 0; e2 < 2; ++e2) {
            O[e2] = MFMA32(*(const bf16x8*)(vbase + e2 * 8192 + jb * 2048), p0, O[e2]);
            O[e2] = MFMA32(*(const bf16x8*)(vbase + e2 * 8192 + jb * 2048 + 1024), p1, O[e2]);
        }
    }
    const float wf = fexp2(lgf2 * (float)(iloc + 1)), wb = fexp2(lgb2 * (float)(127 - iloc));
#pragma unroll
    for (int e2 = 0; e2 < 2; ++e2) {
        f32x16 xf, xb;
#pragma unroll
        for (int r = 0; r < 16; ++r) { xf[r] = 0.f; xb[r] = 0.f; }
        const unsigned char* sf = lds + SFL + (2 * eh + e2) * 8192 + lane * 16;
        const unsigned char* sb = lds + SBL + (2 * eh + e2) * 8192 + lane * 16;
#pragma unroll
        for (int kk = 0; kk < 8; ++kk) {
            xf = MFMA32(*(const bf16x8*)(sf + kk * 1024), qf[kk], xf);
            xb = MFMA32(*(const bf16x8*)(sb + kk * 1024), qf[kk], xb);
        }
#pragma unroll
        for (int r = 0; r < 16; ++r) O[e2][r] += wf * xf[r] + wb * xb[r];
    }
    float s1 = 0.f, s2 = 0.f;
#pragma unroll
    for (int e2 = 0; e2 < 2; ++e2)
#pragma unroll
        for (int r = 0; r < 16; ++r) { s1 += O[e2][r]; s2 += O[e2][r] * O[e2][r]; }
    s1 += __shfl_xor(s1, 32); s2 += __shfl_xor(s2, 32);
    float* red = (float*)(lds + RED);
    if (hi == 0) { red[(eh * 128 + iloc) * 2] = s1; red[(eh * 128 + iloc) * 2 + 1] = s2; }
    __syncthreads();
    {
        const float o1 = red[((1 - eh) * 128 + iloc) * 2], o2 = red[((1 - eh) * 128 + iloc) * 2 + 1];
        s1 += o1; s2 += o2;
    }
    const float mu = s1 * (1.0f / 128.0f);
    const float var = fmaxf(s2 * (1.0f / 128.0f) - mu * mu, 0.f);
    const float rinv = rsqrtf(var + EPS);
    const float* cng = p.in[I_CNG] + h * 128 + 64 * eh;
#pragma unroll
    for (int e2 = 0; e2 < 2; ++e2)
#pragma unroll
        for (int g = 0; g < 4; ++g) {
            const f32x4 gg = *(const f32x4*)(cng + 32 * e2 + 8 * g + 4 * hi);
            O[e2][4 * g] = (O[e2][4 * g] - mu) * rinv * gg.x; O[e2][4 * g + 1] = (O[e2][4 * g + 1] - mu) * rinv * gg.y;
            O[e2][4 * g + 2] = (O[e2][4 * g + 2] - mu) * rinv * gg.z; O[e2][4 * g + 3] = (O[e2][4 * g + 3] - mu) * rinv * gg.w;
        }
    const size_t tok = tok0 + iloc;
    write_y<2>(O, Z + tok * PZ + 2304 + h * 128 + 64 * eh, Y + tok * DM + h * 128 + 64 * eh, hi);
}

__global__ void __launch_bounds__(512) mega_fwd(Params p) {
    extern __shared__ __attribute__((aligned(16))) unsigned char lds[];
    cg::grid_group grid = cg::this_grid();
    const int blk = blockIdx.x, G = gridDim.x;
    const int vb = (G % 8 == 0) ? (blk % 8) * (G / 8) + blk / 8 : blk;
    const int NGW = G * 8;
    unsigned char* ws = p.ws;
    bf16_t* XN = (bf16_t*)(ws + WS_XN); bf16_t* Zb = (bf16_t*)(ws + WS_Z);
    const float* mod0 = (const float*)(ws + WS_MOD); const float* mod1 = mod0 + 9 * 3072;
    LAS unsigned char* lds3 = (LAS unsigned char*)lds;
#define FRESH() int tid = threadIdx.x; asm volatile("" : "+v"(tid)); const int lane = tid & 63, wave = __builtin_amdgcn_readfirstlane(tid >> 6), gw = blk * 8 + wave; (void)lane; (void)gw;

    unsigned* barw = (unsigned*)(ws + WS_BAR);
    volatile LAS unsigned* bst = (volatile LAS unsigned*)(lds3 + LDS_BAR);
    if (threadIdx.x < 2) bst[threadIdx.x] = 0u;
    if (blk == 0) for (int w = threadIdx.x; w < XCD_BAR_WORDS; w += 512) barw[w] = 0u;
    __syncthreads();
    for (int rs_ = 0; rs_ < REP_SM; ++rs_) { FRESH(); phase0(p, lds, tid, blk, G); __syncthreads(); }
    grid.sync();
    XcdBarrier bar = xcd_barrier_post(barw, bst);
#define GSYNC() xcd_barrier(bar)
    for (int rs_ = 0; rs_ < REP_SM; ++rs_) { FRESH(); adaln_rows(p.in[I_XP], p.in[I_XS], p.in[I_NORMG], mod0, XN, gw, NGW, lane); }
    GSYNC();
    for (int rg_ = 0; rg_ < REP_G2; ++rg_) {
        pg8::Gemm g{XN, (const bf16_t*)(ws + WS_WIN_AB), MTOT, PZ, DM}; pg8::StaticOrder S; S.init(MTOT, PZ, G, blk);
        pg8::EpiBf16<0> E{Zb, PZ, nullptr, 0, 0, 1.f};
        pg8::gemm_phase<pg8::EpiBf16<0>, pg8::StaticOrder, true, true>(lds3, g, S, E);
    }
    GSYNC();
    for (int rs_ = 0; rs_ < REP_PREP; ++rs_) { FRESH(); prep_layer0(p, lds, tid, blk, G); }
    GSYNC();
    for (int rep_ = 0; rep_ < REP_P4; ++rep_) {
        if (PHM & 16) { FRESH(); for (int u = vb; u < 512; u += G) unit_B<true>(p, u, lds, tid); }
        for (int ra_ = 0; ra_ < REP_A; ++ra_) { FRESH(); for (int u = vb; u < 512; u += G) unit_A2(p, u, lds, tid); }
        if (PHM & 64) { FRESH(); for (int u = vb; u < 128; u += G) unit_A<false>(p, u, lds, tid); }
        if (PHM & 128) { FRESH(); for (int u = (vb + 8 * G - 128) % G; u < 64; u += G) unit_B<false>(p, u, lds, tid); }
    }
    GSYNC();
    if (PHM & 256) {
        pg8::Gemm g{XN, (const bf16_t*)(ws + WS_WOUT_AB), MTOT, DM, DM}; pg8::StaticOrder S; S.init(MTOT, DM, G, blk);
        EpiResid E{p.in[I_XP], p.in[I_XS], p.out, mod0};
        pg8::gemm_phase<EpiResid, pg8::StaticOrder, true, true>(lds3, g, S, E);
    }
    GSYNC();
    for (int rs_ = 0; rs_ < REP_SM; ++rs_) { FRESH(); adaln_rows(p.out, p.out + (size_t)NCTXTOK * DM, p.in[I_NORMG] + DM, mod1, XN, gw, NGW, lane); }
    GSYNC();
    {
        pg8::Gemm g{XN, (const bf16_t*)(ws + WS_WIN_CD), MTOT, PZ, DM}; pg8::StaticOrder S; S.init(MTOT, PZ, G, blk);
        pg8::EpiBf16<0> E{Zb, PZ, nullptr, 0, 0, 1.f};
        pg8::gemm_phase<pg8::EpiBf16<0>, pg8::StaticOrder, true, true>(lds3, g, S, E);
    }
    GSYNC();
    for (int rs_ = 0; rs_ < REP_PREP; ++rs_) { FRESH(); prep_layer1(p, lds, tid, blk, G); }
    GSYNC();
    for (int rs_ = 0; rs_ < REP_SCAN; ++rs_) {
        FRESH(); const int sw = wave * G + blk;
        for (int u = sw; u < 1024 + 2048; u += NGW) { if (u < 1024) scan_unit<true>(p, u, lane); else scan_unit<false>(p, u - 1024, lane); }
    }
    GSYNC();
    for (int rep_ = 0; rep_ < REP_P10; ++rep_) {
        if (PHM & 2048) { FRESH(); for (int u = vb; u < 512; u += G) unit_D2(p, u, lds, tid); }
        if (PHM & 2048) { FRESH(); for (int u = (vb + 8 * G - 128) % G; u < 128; u += G) unit_D<false>(p, u, lds, tid); }
        for (int rr_ = 0; rr_ < REP_RET; ++rr_) { FRESH();
            for (int u = vb; u < 1152; u += G) { if (u < 1024) retout_block<true>(p, u >> 5, u & 31, lds, tid); else retout_block<false>(p, (u - 1024) >> 1, (u - 1024) & 1, lds, tid); }
            __syncthreads(); }
    }
    GSYNC();
    {
        pg8::Gemm g{XN, (const bf16_t*)(ws + WS_WOUT_CD), MTOT, DM, DM}; pg8::StaticOrder S; S.init(MTOT, DM, G, blk);
        EpiResid E{p.out, p.out + (size_t)NCTXTOK * DM, p.out, mod1};
        pg8::gemm_phase<EpiResid, pg8::StaticOrder, true, true>(lds3, g, S, E);
    }
    GSYNC();
    { FRESH(); final_rows(p.out, p.in[I_FING], gw, NGW, lane); }
}

extern "C" void kernel_launch(void* const* d_in, const int* in_sizes, int n_in, void* d_out, int out_size, void* d_ws, size_t ws_size, hipStream_t stream) {
    static int grid = 0;
    if (grid == 0) {
        if (n_in != 31 || (size_t)out_size != O_END || ws_size < WS_NEED) {
            fprintf(stderr, "kernel_launch: unexpected problem: n_in %d out %d ws %zu (need %zu)\n", n_in, out_size, ws_size, (size_t)WS_NEED); grid = -1; return; }
        int dev = 0, cus = 0, per_cu = 0;
        hipGetDevice(&dev);
        hipDeviceGetAttribute(&cus, hipDeviceAttributeMultiprocessorCount, dev);
        if (hipFuncSetAttribute((const void*)mega_fwd, hipFuncAttributeMaxDynamicSharedMemorySize, LDS_BYTES) != hipSuccess) { fprintf(stderr, "kernel_launch: hipFuncSetAttribute failed\n"); }
        if (hipOccupancyMaxActiveBlocksPerMultiprocessor(&per_cu, (const void*)mega_fwd, 512, LDS_BYTES) != hipSuccess || per_cu < 1) { fprintf(stderr, "kernel_launch: occupancy query gave %d\n", per_cu); per_cu = 1; }
        (void)hipGetLastError();
        if (per_cu > 1) per_cu = 1;
        grid = cus * per_cu;
    }
    if (grid < 0) return;
    Params p{};
    for (int i = 0; i < 31; ++i) p.in[i] = (const float*)d_in[i];
    p.out = (float*)d_out; p.ws = (unsigned char*)d_ws;
    void* args[] = {&p};
    hipError_t e = hipLaunchCooperativeKernel((const void*)mega_fwd, dim3(grid), dim3(512), args, LDS_BYTES, stream);
    if (e != hipSuccess) fprintf(stderr, "kernel_launch: cooperative launch failed: %s (grid %d)\n", hipGetErrorString(e), grid);
}
```

```cpp
#include <hip/hip_runtime.h>
#include <hip/hip_cooperative_groups.h>
#include <cstdio>
#include <cstdint>
namespace cg = cooperative_groups;
namespace pg8 {
#define PG8_LAS __attribute__((address_space(3)))
typedef unsigned short bf16_t;
typedef short bf16x8 __attribute__((ext_vector_type(8)));
typedef float f32x4 __attribute__((ext_vector_type(4)));
typedef unsigned u32x4 __attribute__((ext_vector_type(4)));
constexpr int BM = 256, BK = 64, HALF = 128, HTB = HALF * BK * 2  , STAGE_BYTES = 8 * HTB, NXCD = 8, WGM = 8;

__host__ __device__ __forceinline__ int lds_byte(int r, int c) { const int st = (r >> 4) * 2 + (c >> 5), rr = r & 15, cc = c & 31, ob = rr * 64 + cc * 2; return st * 1024 + (ob ^ (((ob >> 9) & 1) << 5)); }
__host__ __device__ __forceinline__ void stage_rc(int b, int& R, int& C) { const int st = b / 1024, sb = b % 1024, swz = sb ^ (((sb >> 9) & 1) << 5); R = (st >> 1) * 16 + swz / 64; C = (st & 1) * 32 + (swz % 64) / 2; }
__host__ __device__ __forceinline__ int perm32(int rho) { const int n = rho >> 4, i = rho & 15; return 8 * (i >> 2) + 4 * n + (i & 3); }

struct Unit { int pm, pn; };
struct Gemm { const bf16_t* A; const bf16_t* Bt; int M, N, K; };

struct StaticOrder {
    int nM, nN, nwg, G, c;
    __host__ __device__ void init(int M, int N, int G_, int c_) { nM = M / BM; nN = N / BM; nwg = nM * nN; G = G_; c = c_; }
    __host__ __device__ bool next(int i, Unit& u) const {
        const long L = (long)i * G + c; if (L >= nwg) return false;
        int wgid = (int)L; { const int q = nwg / NXCD, r = nwg % NXCD, xcd = wgid % NXCD, off = wgid / NXCD; wgid = (xcd < r ? xcd * (q + 1) : r * (q + 1) + (xcd - r) * q) + off; }
        const int nig = WGM * nN, gid = wgid / nig, fm = gid * WGM, gsz = (nM - fm) < WGM ? (nM - fm) : WGM;
        u.pm = fm + ((wgid % nig) % gsz); u.pn = (wgid % nig) / gsz; return true;
    }
    __device__ __forceinline__ void a_ready(const Unit&) const {}
    __device__ __forceinline__ void done(const Unit&) const {}
};

__device__ __forceinline__ unsigned cvt_pk_bf16(float lo, float hi) { unsigned r; asm volatile("v_cvt_pk_bf16_f32 %0, %1, %2" : "=v"(r) : "v"(lo), "v"(hi)); return r; }
typedef float f32x2 __attribute__((ext_vector_type(2)));
__device__ __forceinline__ f32x2 gelu_pk(f32x2 v) {
    const f32x2 av = __builtin_elementwise_abs(v), d = av * 0.2316418882f + 1.0f;
    f32x2 t; t.x = __builtin_amdgcn_rcpf(d.x); t.y = __builtin_amdgcn_rcpf(d.y);
    f32x2 q = t * 0.5307027145f + (-0.7265760135f); q = q * t + 0.7107068705f; q = q * t + (-0.142248368f); q = q * t + 0.127414796f; q = q * t;
    const f32x2 s = (v * v) * (-0.72134752044f);
    f32x2 e; e.x = __builtin_amdgcn_exp2f(s.x); e.y = __builtin_amdgcn_exp2f(s.y);
    const f32x2 m = v * (q * e), r = v - m;
    f32x2 o; o.x = v.x < 0.f ? m.x : r.x; o.y = v.y < 0.f ? m.y : r.y; return o;
}

template <int ACT  > struct EpiBf16 {
    static constexpr bool PERM = true, AFTER_DRAIN = false; static_assert(ACT == 0 || ACT == 1, "EpiBf16: ACT is 0 (none) or 1 (gelu_pk)");
    bf16_t* O; int ldc; const float* bias; int split_cols; size_t split_stride; float scale0;
    __device__ __forceinline__ void operator()(const f32x4 (&acc)[2][2][4][2], const Unit& u, int wr, int wc, int fr, int fq) const {
        const int row0 = u.pm * BM + wr * 64 + fr; int colt = u.pn * BM; bf16_t* base = O;
        float sc = 1.f; if (split_cols) { const int t = colt / split_cols; base += (size_t)t * split_stride; colt -= t * split_cols; if (t == 0) sc = scale0; }
        const int col0 = colt + wc * 32 + 8 * fq, bcol0 = u.pn * BM + wc * 32 + 8 * fq;
        f32x4 bv[2][2];
#pragma unroll
        for (int bj = 0; bj < 2; ++bj)
#pragma unroll
            for (int n = 0; n < 2; ++n) bv[bj][n] = bias ? *(const f32x4*)(bias + bcol0 + bj * HALF + 4 * n) : (f32x4){0.f, 0.f, 0.f, 0.f};
#pragma unroll
        for (int ai = 0; ai < 2; ++ai)
#pragma unroll
            for (int m = 0; m < 4; ++m) { bf16_t* rowp = base + (size_t)(row0 + ai * HALF + m * 16) * ldc + col0;
#pragma unroll
                for (int bj = 0; bj < 2; ++bj) { f32x4 v0 = acc[ai][bj][m][0] + bv[bj][0], v1 = acc[ai][bj][m][1] + bv[bj][1];
                    if (ACT == 1) { f32x2 a = gelu_pk((f32x2){v0[0], v0[1]}), b = gelu_pk((f32x2){v0[2], v0[3]}), c = gelu_pk((f32x2){v1[0], v1[1]}), d = gelu_pk((f32x2){v1[2], v1[3]});
                        v0 = (f32x4){a.x, a.y, b.x, b.y}; v1 = (f32x4){c.x, c.y, d.x, d.y}; }
                    v0 = v0 * sc; v1 = v1 * sc; u32x4 w; w.x = cvt_pk_bf16(v0[0], v0[1]); w.y = cvt_pk_bf16(v0[2], v0[3]); w.z = cvt_pk_bf16(v1[0], v1[1]); w.w = cvt_pk_bf16(v1[2], v1[3]);
                    __builtin_nontemporal_store(w, (u32x4*)(rowp + bj * HALF)); } }
    }
};
template <class Epi, class Sched, bool ALIGN_EPI = false, bool SP2 = false>
__device__ __forceinline__ void gemm_phase(PG8_LAS unsigned char* lds, const Gemm g, const Sched& S, const Epi& E) {
    int tid_l = threadIdx.x; asm volatile("" : "+v"(tid_l));
    const int tid = tid_l, wid = __builtin_amdgcn_readfirstlane(tid >> 6), lane = tid & 63, wr = wid >> 2, wc = wid & 3, fr = lane & 15, fq = lane >> 4;
    const int K = g.K, nt = K / BK;
    unsigned voffA[2], voffB[2];
#pragma unroll
    for (int i = 0; i < 2; ++i) { int R, C; stage_rc(tid * 16 + i * 8192, R, C); const int Rb = Epi::PERM ? ((R & ~31) + perm32(R & 31)) : R;
        voffA[i] = (unsigned)(R * K + C) * 2u; voffB[i] = (unsigned)(Rb * K + C) * 2u; }
    const size_t kstep = (size_t)(BK * 2);
    const size_t hstep = (size_t)HALF * K * 2;
    const size_t tstep = 2 * hstep;
    const unsigned ldsw = (unsigned)wid * 1024u;
    const int aoff = lds_byte(wr * 64 + fr, fq * 8), boff = lds_byte(wc * 32 + fr, fq * 8);
#define PG8_SA(b, h) (((b) * 2 + (h)) * HTB)
#define PG8_SB(b, h) ((4 + (b) * 2 + (h)) * HTB)
#define PG8_STAGE(bufoff, gbase, voff) do { _Pragma("unroll") for (int _i = 0; _i < 2; ++_i) \
        __builtin_amdgcn_global_load_lds((const unsigned*)((const char*)(gbase) + (voff)[_i]), (PG8_LAS unsigned*)(lds + (bufoff) + ldsw + _i * 8192), 16, 0, 0); } while (0)
#define PG8_LDA(dst, b, h) do { _Pragma("unroll") for (int m = 0; m < 4; ++m) _Pragma("unroll") for (int k = 0; k < 2; ++k) dst[m][k] = *(const PG8_LAS bf16x8*)(lds + PG8_SA(b, h) + aoff + m * 2048 + k * 1024); } while (0)
#define PG8_LDB(dst, b, h) do { _Pragma("unroll") for (int n = 0; n < 2; ++n) _Pragma("unroll") for (int k = 0; k < 2; ++k) dst[n][k] = *(const PG8_LAS bf16x8*)(lds + PG8_SB(b, h) + boff + n * 2048 + k * 1024); } while (0)
#define PG8_MMA(ai, bj, At, Bt) do { __builtin_amdgcn_s_setprio(1); _Pragma("unroll") for (int m = 0; m < 4; ++m) _Pragma("unroll") for (int n = 0; n < 2; ++n) _Pragma("unroll") for (int k = 0; k < 2; ++k) \
        acc[ai][bj][m][n] = __builtin_amdgcn_mfma_f32_16x16x32_bf16(Bt[n][k], At[m][k], acc[ai][bj][m][n], 0, 0, 0); __builtin_amdgcn_s_setprio(0); } while (0)
#define PG8_WAIT_V(n) asm volatile("s_waitcnt vmcnt(" #n ")" ::: "memory")
#define PG8_WAIT_L(n) asm volatile("s_waitcnt lgkmcnt(" #n ")" ::: "memory")
#define PG8_BAR __builtin_amdgcn_s_barrier()
#define PG8_SCHED __builtin_amdgcn_sched_barrier(0)
    Unit cur, nxt; int ui = 0;
    if (!S.next(0, cur)) return;
    f32x4 acc[2][2][4][2];
#pragma unroll
    for (int a = 0; a < 2; ++a)
#pragma unroll
        for (int b = 0; b < 2; ++b)
#pragma unroll
            for (int m = 0; m < 4; ++m)
#pragma unroll
                for (int n = 0; n < 2; ++n) acc[a][b][m][n] = (f32x4){0.f, 0.f, 0.f, 0.f};
    bf16x8 At[4][2], B0[2][2], B1[2][2];
    const char* cA = (const char*)g.A + (size_t)cur.pm * tstep; const char* cB = (const char*)g.Bt + (size_t)cur.pn * tstep;
    S.a_ready(cur);
    if constexpr (SP2) {
        PG8_STAGE(PG8_SB(0, 0), cB, voffB); PG8_STAGE(PG8_SB(0, 1), cB + hstep, voffB); PG8_STAGE(PG8_SA(0, 0), cA, voffA); PG8_STAGE(PG8_SA(0, 1), cA + hstep, voffA);
        if (wr == 1) PG8_BAR;
        PG8_WAIT_V(2); PG8_BAR;
        PG8_STAGE(PG8_SB(1, 0), cB + kstep, voffB); PG8_STAGE(PG8_SA(1, 0), cA + kstep, voffA); PG8_STAGE(PG8_SB(1, 1), cB + hstep + kstep, voffB);
        PG8_WAIT_V(6); PG8_BAR;
    } else {
        PG8_STAGE(PG8_SB(0, 0), cB, voffB); PG8_STAGE(PG8_SA(0, 0), cA, voffA); PG8_STAGE(PG8_SB(0, 1), cB + hstep, voffB); PG8_STAGE(PG8_SA(0, 1), cA + hstep, voffA);
        if (wr == 1) PG8_BAR;
        PG8_WAIT_V(4); PG8_BAR;
        PG8_STAGE(PG8_SB(1, 0), cB + kstep, voffB); PG8_STAGE(PG8_SA(1, 0), cA + kstep, voffA); PG8_STAGE(PG8_SB(1, 1), cB + hstep + kstep, voffB);
        PG8_WAIT_V(6); PG8_BAR;
    }
    for (;;) {
        const bool has_next = S.next(ui + 1, nxt);
        const char* nA = has_next ? (const char*)g.A + (size_t)nxt.pm * tstep : cA; const char* nB = has_next ? (const char*)g.Bt + (size_t)nxt.pn * tstep : cB;
        for (int t = 0; t < nt; t += 2) {
            const bool last = (t == nt - 2);
            const char* a1 = cA + (size_t)(t + 1) * kstep;
            const char* a2 = last ? nA : cA + (size_t)(t + 2) * kstep; const char* b2 = last ? nB : cB + (size_t)(t + 2) * kstep;
            const char* a3 = a2 + kstep; const char* b3 = b2 + kstep;
            if (last && has_next) S.a_ready(nxt);
            if constexpr (SP2) {
            PG8_LDB(B0, 0, 0); PG8_LDB(B1, 0, 1); PG8_SCHED; PG8_LDA(At, 0, 0); PG8_STAGE(PG8_SA(1, 1), a1 + hstep, voffA);
            PG8_WAIT_V(8); PG8_WAIT_L(0); PG8_BAR; PG8_MMA(0, 0, At, B0); PG8_MMA(0, 1, At, B1); PG8_BAR; PG8_SCHED;
            PG8_LDA(At, 0, 1); PG8_STAGE(PG8_SB(0, 0), b2, voffB); PG8_STAGE(PG8_SB(0, 1), b2 + hstep, voffB); PG8_STAGE(PG8_SA(0, 0), a2, voffA);
            PG8_WAIT_V(8); PG8_WAIT_L(0); PG8_BAR; PG8_MMA(1, 0, At, B0); PG8_MMA(1, 1, At, B1); PG8_BAR; PG8_SCHED;
            PG8_LDB(B0, 1, 0); PG8_LDB(B1, 1, 1); PG8_SCHED; PG8_LDA(At, 1, 0); PG8_STAGE(PG8_SA(0, 1), a2 + hstep, voffA);
            PG8_WAIT_V(8); PG8_WAIT_L(0); PG8_BAR; PG8_MMA(0, 0, At, B0); PG8_MMA(0, 1, At, B1); PG8_BAR; PG8_SCHED;
            PG8_LDA(At, 1, 1); PG8_STAGE(PG8_SB(1, 0), b3, voffB); PG8_STAGE(PG8_SB(1, 1), b3 + hstep, voffB); PG8_STAGE(PG8_SA(1, 0), a3, voffA);
            PG8_WAIT_V(8); PG8_WAIT_L(0); PG8_BAR; PG8_MMA(1, 0, At, B0); PG8_MMA(1, 1, At, B1); PG8_BAR; PG8_SCHED;
            } else {
            PG8_LDB(B0, 0, 0); PG8_SCHED; PG8_LDA(At, 0, 0); PG8_STAGE(PG8_SA(1, 1), a1 + hstep, voffA);
            PG8_WAIT_L(8); PG8_BAR; PG8_WAIT_L(0); PG8_MMA(0, 0, At, B0); PG8_BAR; PG8_SCHED;
            PG8_LDB(B1, 0, 1); PG8_STAGE(PG8_SB(0, 0), b2, voffB);
            PG8_BAR; PG8_WAIT_L(0); PG8_MMA(0, 1, At, B1); PG8_BAR;
            PG8_LDA(At, 0, 1); PG8_STAGE(PG8_SA(0, 0), a2, voffA);
            PG8_BAR; PG8_WAIT_L(0); PG8_MMA(1, 0, At, B0); PG8_BAR; PG8_SCHED;
            PG8_STAGE(PG8_SB(0, 1), b2 + hstep, voffB);
            PG8_WAIT_V(6); PG8_BAR; PG8_MMA(1, 1, At, B1); PG8_BAR;
            PG8_LDB(B0, 1, 0); PG8_SCHED; PG8_LDA(At, 1, 0); PG8_STAGE(PG8_SA(0, 1), a2 + hstep, voffA);
            PG8_WAIT_L(8); PG8_BAR; PG8_WAIT_L(0); PG8_MMA(0, 0, At, B0); PG8_BAR; PG8_SCHED;
            PG8_LDB(B1, 1, 1); PG8_STAGE(PG8_SB(1, 0), b3, voffB);
            PG8_BAR; PG8_WAIT_L(0); PG8_MMA(0, 1, At, B1); PG8_BAR;
            PG8_LDA(At, 1, 1); PG8_STAGE(PG8_SA(1, 0), a3, voffA);
            PG8_BAR; PG8_WAIT_L(0); PG8_MMA(1, 0, At, B0); PG8_BAR; PG8_SCHED;
            PG8_STAGE(PG8_SB(1, 1), b3 + hstep, voffB);
            PG8_WAIT_V(6); PG8_BAR; PG8_MMA(1, 1, At, B1); PG8_BAR;
            }
        }
        if constexpr (ALIGN_EPI) { if (wr == 0) PG8_BAR; }
        if constexpr (!Epi::AFTER_DRAIN) { E(acc, cur, wr, wc, fr, fq); S.done(cur); }
        if (!has_next) break;
#pragma unroll
        for (int a = 0; a < 2; ++a)
#pragma unroll
            for (int b = 0; b < 2; ++b)
#pragma unroll
                for (int m = 0; m < 4; ++m)
#pragma unroll
                    for (int n = 0; n < 2; ++n) acc[a][b][m][n] = (f32x4){0.f, 0.f, 0.f, 0.f};
        cur = nxt; cA = nA; cB = nB; ++ui;
        if constexpr (ALIGN_EPI) { if (wr == 1) PG8_BAR; }
    }
    PG8_WAIT_V(0);
    if constexpr (!ALIGN_EPI) { if (wr == 0) PG8_BAR; }
    PG8_BAR;
    if constexpr (Epi::AFTER_DRAIN) { E.fused(acc, cur, wr, wc, fr, fq, lds, wid, lane); S.done(cur); }
#undef PG8_SA
#undef PG8_SB
#undef PG8_STAGE
#undef PG8_LDA
#undef PG8_LDB
#undef PG8_MMA
#undef PG8_WAIT_V
#undef PG8_WAIT_L
#undef PG8_BAR
#undef PG8_SCHED
}
}
#ifndef LAS
#define LAS __attribute__((address_space(3)))
#endif
#define XB_TMO      128
#define XB_XCNT(j)  (256  + 64 * (j))
#define XB_XSUB(j)  (1280 + 64 * (j))
#define XB_XGEN(j)  (2304 + 64 * (j))
#define XB_TOP      3328
#define XB_TOPGEN   3392
#define XCD_BAR_WORDS 3456
#define XB_SPIN_CAP (1u << 18)

__device__ __forceinline__ unsigned xb_ld(unsigned* p)              { return __hip_atomic_load(p, __ATOMIC_RELAXED, __HIP_MEMORY_SCOPE_AGENT); }
__device__ __forceinline__ unsigned xb_add(unsigned* p, unsigned v) { return __hip_atomic_fetch_add(p, v, __ATOMIC_RELAXED, __HIP_MEMORY_SCOPE_AGENT); }
__device__ __forceinline__ unsigned xb_xcc_id() { return (unsigned)__builtin_amdgcn_s_getreg((3 << 11) | 20) & 0xFu; }
#define XB_SPIN(cond, bar) do { unsigned _sp = 0; while (cond) { __builtin_amdgcn_s_sleep(1); \
    if ((++_sp & 255u) == 0u) { if (xb_ld(&(bar)[XB_TMO])) break; if (_sp > XB_SPIN_CAP) { atomicAdd(&(bar)[XB_TMO], 1u); break; } } } } while (0)

struct XcdBarrier {
    unsigned* bar; unsigned x;
    volatile LAS unsigned* st;
};

__device__ __forceinline__ XcdBarrier xcd_barrier_post(unsigned* bar, volatile LAS unsigned* st) {
    XcdBarrier b; b.bar = bar; b.x = xb_xcc_id(); b.st = st;
    if (threadIdx.x == 0) (void)xb_add(&bar[XB_XCNT(b.x)], 1u);
    return b;
}
__device__ __forceinline__ void xcd_barrier_complete(unsigned* bar, unsigned x, unsigned& nloc, unsigned& nx) {
    const unsigned G = gridDim.x * gridDim.y * gridDim.z;
    unsigned sum, cnt, mine, sp = 0u;
    for (;;) {
        sum = 0u; cnt = 0u; mine = 0u;
#pragma unroll
        for (unsigned j = 0; j < 16; ++j) { const unsigned c = xb_ld(&bar[XB_XCNT(j)]); sum += c; cnt += (c > 0u) ? 1u : 0u; mine = (j == x) ? c : mine; }
        if (sum == G) break;
        __builtin_amdgcn_s_sleep(1);
        if ((++sp & 255u) == 0u) { if (xb_ld(&bar[XB_TMO])) break; if (sp > XB_SPIN_CAP) { atomicAdd(&bar[XB_TMO], 1u); break; } }
    }
    nloc = mine > 0u ? mine : 1u; nx = cnt > 0u ? cnt : 1u;
}

__device__ __forceinline__ void xcd_barrier(const XcdBarrier& b) {
    asm volatile("s_waitcnt vmcnt(0)" ::: "memory");
    __syncthreads();
    if (threadIdx.x == 0) {
        unsigned* bar = b.bar;
        __builtin_amdgcn_s_waitcnt(0);
        unsigned nloc = b.st[0], nx = b.st[1];
        if (nloc == 0u) { xcd_barrier_complete(bar, b.x, nloc, nx); b.st[0] = nloc; b.st[1] = nx; }
        const unsigned old = xb_add(&bar[XB_XSUB(b.x)], 1u);
        const unsigned gen = old / nloc;
        if (old + 1u == (gen + 1u) * nloc) {
            __builtin_amdgcn_fence(__ATOMIC_RELEASE, "agent");
            asm volatile("s_waitcnt vmcnt(0)" ::: "memory");
            const unsigned og = xb_add(&bar[XB_TOP], 1u);
            const unsigned tg = og / nx;
            if (og + 1u == (tg + 1u) * nx) xb_add(&bar[XB_TOPGEN], 1u);
            else XB_SPIN(xb_ld(&bar[XB_TOPGEN]) == tg, bar);
            __builtin_amdgcn_fence(__ATOMIC_ACQUIRE, "agent");
            xb_add(&bar[XB_XGEN(b.x)], 1u);
            asm volatile("s_waitcnt vmcnt(0)" ::: "memory");
        } else {
            XB_SPIN(xb_ld(&bar[XB_XGEN(b.x)]) == gen, bar);
            __builtin_amdgcn_fence(__ATOMIC_ACQUIRE, "agent");
            asm volatile("s_waitcnt vmcnt(0)" ::: "memory");
        }
    }
    __syncthreads();
}

typedef unsigned short bf16_t;
typedef short bf16x8 __attribute__((ext_vector_type(8)));
typedef float f32x4 __attribute__((ext_vector_type(4)));
typedef float f32x16 __attribute__((ext_vector_type(16)));
typedef unsigned u32x4 __attribute__((ext_vector_type(4)));
typedef unsigned u32x2 __attribute__((ext_vector_type(2)));
#define LAS __attribute__((address_space(3)))

constexpr int DM = 1024, MTOT = 36864, NCTXTOK = 4096, PZ = 3328;
constexpr int NKL = 4352;
constexpr float LOG2E = 1.4426950408889634f;
constexpr float QSCALE = 0.125f * LOG2E;
constexpr float EPS = 1e-6f;
constexpr float KSCALE_C = 0.08838834764831845f;

constexpr size_t O_YP = 0, O_YS = 4194304, O_AK = 37748736, O_AV = 38273024, O_BK = 38797312, O_BV = 40894464,
                 O_CF = 42991616, O_CB = 44040192, O_DK = 45088768, O_DV = 45613056, O_END = 46137344;

constexpr size_t MiB = 1u << 20;
constexpr size_t WS_MOD = 0;
constexpr size_t WS_ROPE = 256 * 1024;
constexpr size_t WS_LAM = 300 * 1024;
constexpr size_t WS_BAR = 512 * 1024;
constexpr size_t WS_WIN_AB = 1 * MiB, WS_WOUT_AB = 8 * MiB, WS_WIN_CD = 10 * MiB, WS_WOUT_CD = 17 * MiB;
constexpr size_t WS_XN = 20 * MiB;
constexpr size_t WS_Z = 92 * MiB;
constexpr size_t WS_KV = 326 * MiB;
constexpr size_t L0_KA_LAT = WS_KV;
constexpr size_t L0_VTA_LAT = L0_KA_LAT + 8912896;
constexpr size_t L0_KB1_LAT = L0_VTA_LAT + 8912896;
constexpr size_t L0_KB2_LAT = L0_KB1_LAT + 17825792;
constexpr size_t L0_VTB_LAT = L0_KB2_LAT + 17825792;
constexpr size_t L0_KA_CTX = L0_VTB_LAT + 35651584;
constexpr size_t L0_VTA_CTX = L0_KA_CTX + 1 * MiB;
constexpr size_t L0_KB1_CTX = L0_VTA_CTX + 1 * MiB;
constexpr size_t L0_KB2_CTX = L0_KB1_CTX + 2 * MiB;
constexpr size_t L0_VTB_CTX = L0_KB2_CTX + 2 * MiB;
constexpr size_t L0_END = L0_VTB_CTX + 4 * MiB;
constexpr size_t L1_KTL = WS_KV;
constexpr size_t L1_VTL = L1_KTL + 32 * MiB;
constexpr size_t L1_KTC = L1_VTL + 32 * MiB;
constexpr size_t L1_VTC = L1_KTC + 4 * MiB;
constexpr size_t L1_KD_LAT = L1_VTC + 4 * MiB;
constexpr size_t L1_VTD_LAT = L1_KD_LAT + 8912896;
constexpr size_t L1_KD_CTX = L1_VTD_LAT + 8912896;
constexpr size_t L1_VTD_CTX = L1_KD_CTX + 1 * MiB;
constexpr size_t L1_STF_L = L1_VTD_CTX + 1 * MiB;
constexpr size_t L1_STB_L = L1_STF_L + 32 * MiB;
constexpr size_t L1_STF_C = L1_STB_L + 32 * MiB;
constexpr size_t L1_STB_C = L1_STF_C + 4 * MiB;
constexpr size_t L1_END = L1_STB_C + 4 * MiB;
constexpr size_t L1_KF_HI = L1_END;
constexpr size_t L1_KF_LO = 1 * MiB;
constexpr size_t WS_NEED = (L0_END > L1_END ? L0_END : L1_END);
static_assert(L1_KF_LO + 9 * MiB <= WS_WIN_CD, "Kf low part must not reach the layer-1 weight copies");
static_assert(WS_NEED <= 512 * MiB, "workspace map");

constexpr int LDS_BYTES = 136192;
constexpr int LDS_BAR = 135680;
#ifndef PHM
#define PHM 0xFFFFF
#endif
#ifndef REP_A
#define REP_A 1
#endif
#ifndef REP_G2
#define REP_G2 1
#endif
#ifndef REP_PREP
#define REP_PREP 1
#endif
#ifndef REP_SCAN
#define REP_SCAN 1
#endif
#ifndef REP_RET
#define REP_RET 1
#endif
#ifndef REP_SM
#define REP_SM 1
#endif
#ifndef REP_P4
#define REP_P4 1
#endif
#ifndef REP_P10
#define REP_P10 1
#endif

struct Params { const float* in[31]; float* out; unsigned char* ws; };
enum { I_XP = 0, I_XS, I_CAK, I_CAV, I_CBK, I_CBV, I_SCF, I_SCB, I_CDK, I_CDV, I_C, I_CCTX, I_NORMG, I_MODW, I_MODB,
       I_ABWIN, I_ABWOUT, I_SINK, I_LQ1, I_LK1, I_LQ2, I_LK2, I_BNG, I_CDWIN, I_CDWOUT, I_DECF, I_DECB, I_CNG, I_DQG, I_DKG, I_FING };

__device__ __forceinline__ unsigned cvtpk(float lo, float hi) {
    typedef float f2_t __attribute__((ext_vector_type(2))); typedef __bf16 b2_t __attribute__((ext_vector_type(2)));
    f2_t v = {lo, hi}; b2_t b = __builtin_convertvector(v, b2_t); return __builtin_bit_cast(unsigned, b);
}
__device__ __forceinline__ float bflo(unsigned w) { return __uint_as_float(w << 16); }
__device__ __forceinline__ float bfhi(unsigned w) { return __uint_as_float(w & 0xffff0000u); }
__device__ __forceinline__ void unpack8(const u32x4 w, float (&v)[8]) {
    v[0] = bflo(w.x); v[1] = bfhi(w.x); v[2] = bflo(w.y); v[3] = bfhi(w.y); v[4] = bflo(w.z); v[5] = bfhi(w.z); v[6] = bflo(w.w); v[7] = bfhi(w.w);
}
__device__ __forceinline__ u32x4 pack8(const float (&v)[8]) {
    u32x4 w; w.x = cvtpk(v[0], v[1]); w.y = cvtpk(v[2], v[3]); w.z = cvtpk(v[4], v[5]); w.w = cvtpk(v[6], v[7]); return w;
}
__device__ __forceinline__ float fexp2(float x) { return __builtin_amdgcn_exp2f(x); }
__device__ __forceinline__ float siluf(float g) { return g * __builtin_amdgcn_rcpf(1.0f + fexp2(-g * LOG2E)); }
__device__ __forceinline__ float wave_sum(float v) {
#pragma unroll
    for (int o = 1; o < 64; o <<= 1) v += __shfl_xor(v, o);
    return v;
}
__device__ __forceinline__ int crow(int r, int hi) { return (r & 3) + 8 * (r >> 2) + 4 * hi; }
__device__ __forceinline__ size_t kf_base(int sh) { return sh < 23 ? L1_KF_HI + (size_t)sh * MiB : L1_KF_LO + (size_t)(sh - 23) * MiB; }
#define MFMA32(a, b, c) __builtin_amdgcn_mfma_f32_32x32x16_bf16((a), (b), (c), 0, 0, 0)

struct EpiResid {
    static constexpr bool PERM = false, AFTER_DRAIN = false;
    const float* xp; const float* xs; float* out; const float* mod;
    __device__ __forceinline__ void operator()(const pg8::f32x4 (&acc)[2][2][4][2], const pg8::Unit& u, int wr, int wc, int fr, int fq) const {
        const int pm = u.pm;
        const float* xin = pm < 16 ? xp + (size_t)pm * 256 * DM : xs + (size_t)(pm - 16) * 256 * DM;
        float* xo = out + (size_t)pm * 256 * DM;
        const int mrow = pm < 16 ? 0 : 1 + ((pm - 16) >> 4);
        const float* gate = mod + mrow * 3072 + 2048;
        const int col0 = u.pn * 256 + wc * 32 + 4 * fq;
#pragma unroll
        for (int bj = 0; bj < 2; ++bj)
#pragma unroll
            for (int n = 0; n < 2; ++n) {
                const pg8::f32x4 g = *(const pg8::f32x4*)(gate + col0 + bj * 128 + n * 16);
                pg8::f32x4 xv[2][4];
#pragma unroll
                for (int ai = 0; ai < 2; ++ai)
#pragma unroll
                    for (int m = 0; m < 4; ++m) xv[ai][m] = *(const pg8::f32x4*)(xin + (size_t)(ai * 128 + wr * 64 + m * 16 + fr) * DM + col0 + bj * 128 + n * 16);
#pragma unroll
                for (int ai = 0; ai < 2; ++ai)
#pragma unroll
                    for (int m = 0; m < 4; ++m)
                        *(pg8::f32x4*)(xo + (size_t)(ai * 128 + wr * 64 + m * 16 + fr) * DM + col0 + bj * 128 + n * 16) = xv[ai][m] + g * acc[ai][bj][m][n];
            }
    }
};

__device__ __forceinline__ void transpose_item(const float* __restrict__ W, int K, int N, bf16_t* __restrict__ WT, float* scr, int item, int lane) {
    const int nblk = N / 32, kb = item / nblk, nb = item % nblk, k0 = 64 * kb, n0 = 32 * nb;
#pragma unroll 8
    for (int i = 0; i < 32; ++i) { const int kk = 2 * i + (lane >> 5); scr[kk * 33 + (lane & 31)] = W[(size_t)(k0 + kk) * N + n0 + (lane & 31)]; }
    asm volatile("s_waitcnt lgkmcnt(0)" ::: "memory");
    const int c = lane & 7;
#pragma unroll
    for (int j = 0; j < 4; ++j) {
        const int n = (lane >> 3) + 8 * j; const float* s = scr + (8 * c) * 33 + n;
        u32x4 o; o.x = cvtpk(s[0 * 33], s[1 * 33]); o.y = cvtpk(s[2 * 33], s[3 * 33]); o.z = cvtpk(s[4 * 33], s[5 * 33]); o.w = cvtpk(s[6 * 33], s[7 * 33]);
        *(u32x4*)(WT + (size_t)(n0 + n) * K + k0 + 8 * c) = o;
    }
    asm volatile("s_waitcnt lgkmcnt(0)" ::: "memory");
}

__device__ __forceinline__ void phase0(const Params& p, unsigned char* lds, int tid, int blk, int G) {
    const int lane = tid & 63, wave = tid >> 6;
    unsigned char* ws = p.ws;
    {
        float* scr = (float*)(lds + wave * 16384);
        const int gw = blk * 8 + wave, NGW = G * 8;
        constexpr int I_IN = 16 * 104, I_OUT = 16 * 32, NIT = 2 * (I_IN + I_OUT);
        for (int it = gw; it < NIT; it += NGW) {
            int r = it;
            if (r < I_IN) { transpose_item(p.in[I_ABWIN], 1024, PZ, (bf16_t*)(ws + WS_WIN_AB), scr, r, lane); continue; } r -= I_IN;
            if (r < I_OUT) { transpose_item(p.in[I_ABWOUT], 1024, 1024, (bf16_t*)(ws + WS_WOUT_AB), scr, r, lane); continue; } r -= I_OUT;
            if (r < I_IN) { transpose_item(p.in[I_CDWIN], 1024, PZ, (bf16_t*)(ws + WS_WIN_CD), scr, r, lane); continue; } r -= I_IN;
            transpose_item(p.in[I_CDWOUT], 1024, 1024, (bf16_t*)(ws + WS_WOUT_CD), scr, r, lane);
        }
    }
    __syncthreads();
    {
        float* red = (float*)lds;
        const int c = tid & 31, kp = tid >> 5;
        for (int cgp = blk; cgp < 256; cgp += G) {
            const int layer = cgp >> 7, colb = (cgp & 127) * 24;
            const float* W = p.in[I_MODW] + (size_t)layer * 1024 * 3072;
            float acc[9];
#pragma unroll
            for (int r = 0; r < 9; ++r) acc[r] = 0.f;
            if (c < 24) {
                for (int k = kp * 64; k < kp * 64 + 64; ++k) {
                    const float w = W[(size_t)k * 3072 + colb + c];
                    acc[0] += siluf(p.in[I_CCTX][k]) * w;
#pragma unroll
                    for (int b = 0; b < 8; ++b) acc[1 + b] += siluf(p.in[I_C][b * 1024 + k]) * w;
                }
#pragma unroll
                for (int r = 0; r < 9; ++r) red[(kp * 9 + r) * 24 + c] = acc[r];
            }
            __syncthreads();
            if (tid < 216) {
                const int r = tid / 24, cc = tid % 24; float s = 0.f;
                for (int q = 0; q < 16; ++q) s += red[(q * 9 + r) * 24 + cc];
                ((float*)(ws + WS_MOD))[(size_t)(layer * 9 + r) * 3072 + colb + cc] = s + p.in[I_MODB][layer * 3072 + colb + cc];
            }
            __syncthreads();
        }
    }
    {
        const int gt = blk * 512 + tid;
        if (gt < 1024) {
            const int pos = gt >> 4, f = gt & 15;
            const float inv = exp2f(-(float)f * (13.287712379549449f / 16.0f));
            const float ang = (float)pos * inv;
            ((float*)(ws + WS_ROPE))[gt] = cosf(ang);
            ((float*)(ws + WS_ROPE))[1024 + gt] = sinf(ang);
        }
        if (blk == 0 && tid == 0) {
            float s1 = 0.f, s2 = 0.f;
            for (int i = 0; i < 64; ++i) { s1 += p.in[I_LQ1][i] * p.in[I_LK1][i]; s2 += p.in[I_LQ2][i] * p.in[I_LK2][i]; }
            *(float*)(ws + WS_LAM) = expf(s1) - expf(s2) + 0.2f;
        }
    }
}

__device__ __forceinline__ void adaln_rows(const float* xp, const float* xs, const float* __restrict__ g, const float* __restrict__ mod,
                                           bf16_t* __restrict__ XN, int gw, int NGW, int lane) {
    for (int row = gw; row < MTOT; row += 2 * NGW) {
        const int rowB = (row + NGW < MTOT) ? row + NGW : row;
        const float* xa = row < NCTXTOK ? xp + (size_t)row * DM : xs + (size_t)(row - NCTXTOK) * DM;
        const float* xb = rowB < NCTXTOK ? xp + (size_t)rowB * DM : xs + (size_t)(rowB - NCTXTOK) * DM;
        f32x4 va[4], vb[4];
#pragma unroll
        for (int j = 0; j < 4; ++j) va[j] = __builtin_nontemporal_load((const f32x4*)(xa + 4 * (lane + 64 * j)));
#pragma unroll
        for (int j = 0; j < 4; ++j) vb[j] = __builtin_nontemporal_load((const f32x4*)(xb + 4 * (lane + 64 * j)));
        float sa = 0.f, sb = 0.f;
#pragma unroll
        for (int j = 0; j < 4; ++j) { sa += (va[j].x * va[j].x + va[j].y * va[j].y) + (va[j].z * va[j].z + va[j].w * va[j].w); sb += (vb[j].x * vb[j].x + vb[j].y * vb[j].y) + (vb[j].z * vb[j].z + vb[j].w * vb[j].w); }
        const float ra = rsqrtf(wave_sum(sa) * (1.0f / DM) + EPS), rb = rsqrtf(wave_sum(sb) * (1.0f / DM) + EPS);
        const int ma = row < NCTXTOK ? 0 : 1 + ((row - NCTXTOK) >> 12), mb = rowB < NCTXTOK ? 0 : 1 + ((rowB - NCTXTOK) >> 12);
        const float* sha = mod + ma * 3072; const float* shb = mod + mb * 3072;
#pragma unroll
        for (int j = 0; j < 4; ++j) {
            const int col = 4 * (lane + 64 * j);
            const f32x4 gg = *(const f32x4*)(g + col);
            const f32x4 ha = va[j] * ra * gg * (*(const f32x4*)(sha + 1024 + col) + 1.0f) + *(const f32x4*)(sha + col);
            const f32x4 hb = vb[j] * rb * gg * (*(const f32x4*)(shb + 1024 + col) + 1.0f) + *(const f32x4*)(shb + col);
            u32x2 wa; wa.x = cvtpk(ha.x, ha.y); wa.y = cvtpk(ha.z, ha.w);
            u32x2 wb; wb.x = cvtpk(hb.x, hb.y); wb.y = cvtpk(hb.z, hb.w);
            *(u32x2*)(XN + (size_t)row * DM + col) = wa;
            *(u32x2*)(XN + (size_t)rowB * DM + col) = wb;
        }
    }
}
__device__ __forceinline__ void final_rows(float* x, const float* __restrict__ g, int gw, int NGW, int lane) {
    for (int row = gw; row < MTOT; row += 2 * NGW) {
        const int rowB = (row + NGW < MTOT) ? row + NGW : row;
        float* xa = x + (size_t)row * DM; float* xb = x + (size_t)rowB * DM;
        f32x4 va[4], vb[4];
#pragma unroll
        for (int j = 0; j < 4; ++j) va[j] = __builtin_nontemporal_load((const f32x4*)(xa + 4 * (lane + 64 * j)));
#pragma unroll
        for (int j = 0; j < 4; ++j) vb[j] = __builtin_nontemporal_load((const f32x4*)(xb + 4 * (lane + 64 * j)));
        float sa = 0.f, sb = 0.f;
#pragma unroll
        for (int j = 0; j < 4; ++j) { sa += (va[j].x * va[j].x + va[j].y * va[j].y) + (va[j].z * va[j].z + va[j].w * va[j].w); sb += (vb[j].x * vb[j].x + vb[j].y * vb[j].y) + (vb[j].z * vb[j].z + vb[j].w * vb[j].w); }
        const float ra = rsqrtf(wave_sum(sa) * (1.0f / DM) + EPS), rb = rsqrtf(wave_sum(sb) * (1.0f / DM) + EPS);
#pragma unroll
        for (int j = 0; j < 4; ++j) {
            const int col = 4 * (lane + 64 * j);
            const f32x4 gg = *(const f32x4*)(g + col);
            __builtin_nontemporal_store(va[j] * ra * gg, (f32x4*)(xa + col));
            if (rowB != row) __builtin_nontemporal_store(vb[j] * rb * gg, (f32x4*)(xb + col));
        }
    }
}

template <bool F32SRC>
__device__ __forceinline__ void tile64(const void* src, size_t sp, bool rms, bool rope, const float* __restrict__ gain, int pos0,
                                       const float* __restrict__ cosT, const float* __restrict__ sinT,
                                       float* df, size_t dfp, bf16_t* dk, size_t dkp, bf16_t* dt, size_t dtp, unsigned char* ldsw, int lane,
                                       const int fragmode = 0, const int fraghalf = 0, const int fragtq = 0, bf16_t* dkf = nullptr) {
    const int tr = lane >> 3, ch = lane & 7;
    unsigned short* T = (unsigned short*)ldsw;
#pragma unroll
    for (int g8 = 0; g8 < 8; ++g8) {
        const int tok = g8 * 8 + tr;
        float v[8];
        if (F32SRC) {
            const float* s = (const float*)src + (size_t)tok * sp + ch * 8;
            const f32x4 a = *(const f32x4*)s, b = *(const f32x4*)(s + 4);
            v[0] = a.x; v[1] = a.y; v[2] = a.z; v[3] = a.w; v[4] = b.x; v[5] = b.y; v[6] = b.z; v[7] = b.w;
        } else {
            const bf16_t* s = (const bf16_t*)src + (size_t)tok * sp + ch * 8;
            unpack8(*(const u32x4*)s, v);
        }
        if (rms) {
            float ss = 0.f;
#pragma unroll
            for (int e = 0; e < 8; ++e) ss += v[e] * v[e];
            ss += __shfl_xor(ss, 1); ss += __shfl_xor(ss, 2); ss += __shfl_xor(ss, 4);
            const float rinv = rsqrtf(ss * (1.0f / 64.0f) + EPS);
#pragma unroll
            for (int e = 0; e < 8; ++e) v[e] *= rinv * gain[ch * 8 + e];
        }
        if (df) {
            float* o = df + (size_t)tok * dfp + ch * 8;
            __builtin_nontemporal_store((f32x4){v[0], v[1], v[2], v[3]}, (f32x4*)o); __builtin_nontemporal_store((f32x4){v[4], v[5], v[6], v[7]}, (f32x4*)(o + 4));
        }
        if (rope) {
            const int pos = pos0 + tok, c4 = ch & 3;
            const int trow = c4 < 2 ? (pos >> 6) : (pos & 63), f0 = 8 * (c4 & 1);
#pragma unroll
            for (int e = 0; e < 8; ++e) {
                const float other = __shfl_xor(v[e], 4);
                const float cs = cosT[trow * 16 + f0 + e], sn = sinT[trow * 16 + f0 + e];
                v[e] = ch < 4 ? v[e] * cs - other * sn : v[e] * cs + other * sn;
            }
        }
        if (dk) *(u32x4*)(dk + (size_t)tok * dkp + ch * 8) = pack8(v);
        if (dkf) {
            const int tl = 64 * fragtq + tok, t5 = tl & 31, pit = (t5 & 0x13) | ((t5 & 4) << 1) | ((t5 & 8) >> 1);
            *(u32x4*)(dkf + (size_t)((((tl >> 5) * 8 + 4 * fraghalf + (ch >> 1)) * 64 + (ch & 1) * 32 + pit) * 8)) = pack8(v);
        }
        if (dt) {
#pragma unroll
            for (int e = 0; e < 8; ++e) T[(ch * 8 + e) * 72 + tok] = (unsigned short)(cvtpk(v[e], 0.f) & 0xffffu);
        }
    }
    if (dt) {
        asm volatile("s_waitcnt lgkmcnt(0)" ::: "memory");
#pragma unroll
        for (int k = 0; k < 8; ++k) {
            const int d = tr + 8 * k, c8 = ch;
            const u32x4 w = *(const u32x4*)(T + d * 72 + c8 * 8);
            if (fragmode) {
                const int e = 64 * fraghalf + d, tl = 64 * fragtq + 8 * c8;
                *(u32x4*)(dt + (size_t)((((e >> 5) * 8 + (tl >> 4)) * 64 + ((tl >> 3) & 1) * 32 + (e & 31)) * 8)) = w;
            } else *(u32x4*)(dt + (size_t)d * dtp + c8 * 8) = w;
        }
        asm volatile("s_waitcnt lgkmcnt(0)" ::: "memory");
    }
}

__device__ __forceinline__ void prep_layer0(const Params& p, unsigned char* lds, int tid, int blk, int G) {
    unsigned char* ws = p.ws; float* out = p.out;
    const int lane = tid & 63, wave = __builtin_amdgcn_readfirstlane(tid >> 6); unsigned char* ldsw = lds + wave * 9216; const int gwp = wave * G + blk, NGWp = G * 8;
    const bf16_t* Z = (const bf16_t*)(ws + WS_Z);
    const float* cosT = (const float*)(ws + WS_ROPE); const float* sinT = cosT + 1024;
    for (int u = gwp; u < 12160; u += NGWp) {
        if (u < 11520) {
            const int tt = u / 20, g = u % 20;
            const bool ctx = tt < 64;
            const int b = ctx ? (tt >> 2) : ((tt - 64) >> 6);
            const int t0 = ctx ? (tt & 3) * 64 : ((tt - 64) & 63) * 64;
            const size_t row0 = (size_t)tt * 64;
            const int NK = ctx ? 256 : NKL, koff = ctx ? t0 : 256 + t0;
            float* df = nullptr; size_t dfp = 0; bf16_t* dk = nullptr; bf16_t* dt = nullptr; size_t dtp = NK; int zcol; bool rope = false;
            if (g < 2) {
                zcol = 512 + 64 * g; rope = !ctx;
                dk = (bf16_t*)(ws + (ctx ? L0_KA_CTX : L0_KA_LAT)) + ((size_t)(b * 2 + g) * NK + koff) * 64;
                if (ctx) { df = out + O_AK + ((size_t)(b * 2 + g) * 256 + t0) * 64; dfp = 64; }
            } else if (g < 4) {
                const int hd = g - 2; zcol = 640 + 64 * hd;
                dt = (bf16_t*)(ws + (ctx ? L0_VTA_CTX : L0_VTA_LAT)) + (size_t)(b * 2 + hd) * 64 * NK + koff;
                if (ctx) { df = out + O_AV + ((size_t)(b * 2 + hd) * 256 + t0) * 64; dfp = 64; }
            } else if (g < 12) {
                const int idx = g - 4, hd = idx >> 1, half = idx & 1; zcol = 1280 + 128 * hd + 64 * half; rope = !ctx;
                const size_t base = ctx ? (half ? L0_KB2_CTX : L0_KB1_CTX) : (half ? L0_KB2_LAT : L0_KB1_LAT);
                dk = (bf16_t*)(ws + base) + ((size_t)(b * 4 + hd) * NK + koff) * 64;
                if (ctx) { df = out + O_BK + ((size_t)(b * 4 + hd) * 256 + t0) * 128 + 64 * half; dfp = 128; }
            } else {
                const int idx = g - 12, hd = idx >> 1, half = idx & 1; zcol = 1792 + 128 * hd + 64 * half;
                dt = (bf16_t*)(ws + (ctx ? L0_VTB_CTX : L0_VTB_LAT)) + ((size_t)(b * 4 + hd) * 128 + 64 * half) * NK + koff;
                if (ctx) { df = out + O_BV + ((size_t)(b * 4 + hd) * 256 + t0) * 128 + 64 * half; dfp = 128; }
            }
            tile64<false>(Z + row0 * PZ + zcol, PZ, false, rope, nullptr, t0, cosT, sinT, df, dfp, dk, 64, dt, dtp, ldsw, lane);
        } else {
            const int cu = u - 11520, g = cu % 20, r = cu / 20, b = r >> 2, t0 = (r & 3) * 64;
            const float* src; size_t sp; bf16_t* dk = nullptr; bf16_t* dt = nullptr;
            if (g < 2) {
                src = p.in[I_CAK] + ((size_t)(b * 2 + g) * 256 + t0) * 64; sp = 64;
                dk = (bf16_t*)(ws + L0_KA_LAT) + ((size_t)(b * 2 + g) * NKL + t0) * 64;
            } else if (g < 4) {
                const int hd = g - 2; src = p.in[I_CAV] + ((size_t)(b * 2 + hd) * 256 + t0) * 64; sp = 64;
                dt = (bf16_t*)(ws + L0_VTA_LAT) + (size_t)(b * 2 + hd) * 64 * NKL + t0;
            } else if (g < 12) {
                const int idx = g - 4, hd = idx >> 1, half = idx & 1;
                src = p.in[I_CBK] + ((size_t)(b * 4 + hd) * 256 + t0) * 128 + 64 * half; sp = 128;
                dk = (bf16_t*)(ws + (half ? L0_KB2_LAT : L0_KB1_LAT)) + ((size_t)(b * 4 + hd) * NKL + t0) * 64;
            } else {
                const int idx = g - 12, hd = idx >> 1, half = idx & 1;
                src = p.in[I_CBV] + ((size_t)(b * 4 + hd) * 256 + t0) * 128 + 64 * half; sp = 128;
                dt = (bf16_t*)(ws + L0_VTB_LAT) + ((size_t)(b * 4 + hd) * 128 + 64 * half) * NKL + t0;
            }
            tile64<true>(src, sp, false, false, nullptr, 0, cosT, sinT, nullptr, 0, dk, 64, dt, NKL, ldsw, lane);
        }
    }
}

__device__ __forceinline__ void prep_layer1(const Params& p, unsigned char* lds, int tid, int blk, int G) {
    unsigned char* ws = p.ws; float* out = p.out;
    const int lane = tid & 63, wave = __builtin_amdgcn_readfirstlane(tid >> 6); unsigned char* ldsw = lds + wave * 9216; const int gwp = wave * G + blk, NGWp = G * 8;
    const bf16_t* Z = (const bf16_t*)(ws + WS_Z);
    const float* cosT = (const float*)(ws + WS_ROPE); const float* sinT = cosT + 1024;
    for (int u = gwp; u < 11520 + 128; u += NGWp) {
        if (u < 11520) {
            const int tt = u / 20, g = u % 20;
            const bool ctx = tt < 64;
            const int b = ctx ? (tt >> 2) : ((tt - 64) >> 6);
            const int t0 = ctx ? (tt & 3) * 64 : ((tt - 64) & 63) * 64;
            const size_t row0 = (size_t)tt * 64;
            float* df = nullptr; bf16_t* dk = nullptr; bf16_t* dt = nullptr; size_t dtp = 0; int zcol; bool rope = false, rms = false;
            int fragmode = 0, fraghalf = 0, fragtq = 0; bf16_t* dkf = nullptr;
            if (g < 16) {
                const int idx = g & 7, hd = idx >> 1, half = idx & 1; const bool isv = g >= 8;
                zcol = (isv ? 1024 : 512) + 128 * hd + 64 * half;
                const int NS = ctx ? 256 : 4096; dtp = NS;
                const size_t base = ctx ? (isv ? L1_VTC : L1_KTC) : (isv ? L1_VTL : L1_KTL);
                dt = (bf16_t*)(ws + base) + (size_t)(b * 4 + hd) * 128 * NS + (size_t)(t0 >> 7) * 16384;
                fragmode = 1; fraghalf = half; fragtq = (t0 >> 6) & 1;
            } else if (g < 18) {
                const int hd = g - 16; zcol = 2048 + 64 * hd; rms = true; rope = !ctx;
                const int NK = ctx ? 256 : NKL, koff = ctx ? t0 : 256 + t0;
                dk = (bf16_t*)(ws + (ctx ? L1_KD_CTX : L1_KD_LAT)) + ((size_t)(b * 2 + hd) * NK + koff) * 64;
                if (ctx) df = out + O_DK + ((size_t)(b * 2 + hd) * 256 + t0) * 64;
            } else {
                const int hd = g - 18; zcol = 2176 + 64 * hd;
                const int NK = ctx ? 256 : NKL, koff = ctx ? t0 : 256 + t0; dtp = NK;
                dt = (bf16_t*)(ws + (ctx ? L1_VTD_CTX : L1_VTD_LAT)) + (size_t)(b * 2 + hd) * 64 * NK + koff;
                if (ctx) df = out + O_DV + ((size_t)(b * 2 + hd) * 256 + t0) * 64;
            }
            tile64<false>(Z + row0 * PZ + zcol, PZ, rms, rope, p.in[I_DKG], t0, cosT, sinT, df, 64, dk, 64, dt, dtp, ldsw, lane, fragmode, fraghalf, fragtq, dkf);
        } else {
            const int cu = u - 11520, g = cu & 3, r = cu >> 2, b = r >> 2, t0 = (r & 3) * 64;
            const float* src; bf16_t* dk = nullptr; bf16_t* dt = nullptr;
            if (g < 2) {
                src = p.in[I_CDK] + ((size_t)(b * 2 + g) * 256 + t0) * 64;
                dk = (bf16_t*)(ws + L1_KD_LAT) + ((size_t)(b * 2 + g) * NKL + t0) * 64;
            } else {
                const int hd = g - 2; src = p.in[I_CDV] + ((size_t)(b * 2 + hd) * 256 + t0) * 64;
                dt = (bf16_t*)(ws + L1_VTD_LAT) + (size_t)(b * 2 + hd) * 64 * NKL + t0;
            }
            tile64<true>(src, 64, false, false, nullptr, 0, cosT, sinT, nullptr, 0, dk, 64, dt, NKL, ldsw, lane);
        }
    }
}

template <bool RMS, bool ROPE>
__device__ __forceinline__ void load_q(const bf16_t* zq, int hi, const float* __restrict__ gain, int pos,
                                       const float* __restrict__ cosT, const float* __restrict__ sinT, bf16x8 (&qf)[4]) {
    float v[4][8];
#pragma unroll
    for (int kk = 0; kk < 4; ++kk) unpack8(*(const u32x4*)(zq + 16 * kk + 8 * hi), v[kk]);
    if (RMS) {
        float ss = 0.f;
#pragma unroll
        for (int kk = 0; kk < 4; ++kk)
#pragma unroll
            for (int e = 0; e < 8; ++e) ss += v[kk][e] * v[kk][e];
        ss += __shfl_xor(ss, 32);
        const float rinv = rsqrtf(ss * (1.0f / 64.0f) + EPS);
#pragma unroll
        for (int kk = 0; kk < 4; ++kk)
#pragma unroll
            for (int e = 0; e < 8; ++e) v[kk][e] *= rinv * gain[16 * kk + 8 * hi + e];
    }
    if (ROPE) {
        const int prow = pos >> 6, pcol = pos & 63;
#pragma unroll
        for (int kk = 0; kk < 2; ++kk) {
            const int trow = kk == 0 ? prow : pcol;
#pragma unroll
            for (int e = 0; e < 8; ++e) {
                const float cs = cosT[trow * 16 + 8 * hi + e], sn = sinT[trow * 16 + 8 * hi + e];
                const float x1 = v[kk][e], x2 = v[kk + 2][e];
                v[kk][e] = x1 * cs - x2 * sn; v[kk + 2][e] = x2 * cs + x1 * sn;
            }
        }
    }
#pragma unroll
    for (int kk = 0; kk < 4; ++kk) {
#pragma unroll
        for (int e = 0; e < 8; ++e) v[kk][e] *= QSCALE;
        qf[kk] = __builtin_bit_cast(bf16x8, pack8(v[kk]));
    }
}

template <int DV, bool WINDOW>
__device__ __forceinline__ void compute_tile(const unsigned char* base, const unsigned rdK, const unsigned rdV, const bf16x8 (&qf)[4], f32x16& negm,
                                             f32x16 (&O)[DV / 32], float& m_run, float& l_run, const bool mtile, const int j0, const int qpos, const int hi, const bool first) {
    constexpr int NDB = DV / 32;
    constexpr float THR = 8.0f;
    f32x16 s0, s1;
    bf16x8 kf0[4], kf1[4], vf[NDB][4];
#pragma unroll
    for (int kk = 0; kk < 4; ++kk) { kf0[kk] = *(const bf16x8*)(base + rdK + kk * 32); kf1[kk] = *(const bf16x8*)(base + rdK + 32 * 144 + kk * 32); }
#pragma unroll
    for (int db = 0; db < NDB; ++db)
#pragma unroll
        for (int q = 0; q < 4; ++q) vf[db][q] = *(const bf16x8*)(base + rdV + db * 32 * 144 + q * 32);
    __builtin_amdgcn_sched_barrier(0);
    __builtin_amdgcn_s_setprio(1);
    s0 = MFMA32(kf0[0], qf[0], negm); s1 = MFMA32(kf1[0], qf[0], negm);
#pragma unroll
    for (int kk = 1; kk < 4; ++kk) { s0 = MFMA32(kf0[kk], qf[kk], s0); s1 = MFMA32(kf1[kk], qf[kk], s1); }
    __builtin_amdgcn_s_setprio(0);
    if (WINDOW && mtile) {
#pragma unroll
        for (int r = 0; r < 16; ++r) {
            const int j = j0 + 16 * (r >> 3) + 8 * hi + (r & 7);
            const int d0 = qpos - j, d1 = d0 - 32;
            if (d0 > 128 || d0 < -128) s0[r] = -1e30f;
            if (d1 > 128 || d1 < -128) s1[r] = -1e30f;
        }
    }
    float mx = fmaxf(s0[0], s1[0]);
#pragma unroll
    for (int r = 1; r < 16; ++r) mx = fmaxf(mx, fmaxf(s0[r], s1[r]));
    {
        auto rr = __builtin_amdgcn_permlane32_swap(__float_as_uint(mx), __float_as_uint(mx), false, false);
        mx = fmaxf(__uint_as_float(rr[0]), __uint_as_float(rr[1]));
    }
    if (first || __any(mx > THR)) {
        const float dl = first ? mx : fmaxf(mx, 0.f);
        m_run += dl;
#pragma unroll
        for (int r = 0; r < 16; ++r) { s0[r] -= dl; s1[r] -= dl; negm[r] = -m_run; }
        const float alpha = fexp2(-dl);
        l_run *= alpha;
#pragma unroll
        for (int db = 0; db < NDB; ++db)
#pragma unroll
            for (int r = 0; r < 16; ++r) O[db][r] *= alpha;
    }
    float rs = 0.f;
#pragma unroll
    for (int r = 0; r < 16; ++r) { s0[r] = fexp2(s0[r]); s1[r] = fexp2(s1[r]); rs += s0[r] + s1[r]; }
    l_run += rs;
    u32x4 w00, w01, w10, w11;
    w00.x = cvtpk(s0[0], s0[1]); w00.y = cvtpk(s0[2], s0[3]); w00.z = cvtpk(s0[4], s0[5]); w00.w = cvtpk(s0[6], s0[7]);
    w01.x = cvtpk(s0[8], s0[9]); w01.y = cvtpk(s0[10], s0[11]); w01.z = cvtpk(s0[12], s0[13]); w01.w = cvtpk(s0[14], s0[15]);
    w10.x = cvtpk(s1[0], s1[1]); w10.y = cvtpk(s1[2], s1[3]); w10.z = cvtpk(s1[4], s1[5]); w10.w = cvtpk(s1[6], s1[7]);
    w11.x = cvtpk(s1[8], s1[9]); w11.y = cvtpk(s1[10], s1[11]); w11.z = cvtpk(s1[12], s1[13]); w11.w = cvtpk(s1[14], s1[15]);
    const bf16x8 p00 = __builtin_bit_cast(bf16x8, w00), p01 = __builtin_bit_cast(bf16x8, w01), p10 = __builtin_bit_cast(bf16x8, w10), p11 = __builtin_bit_cast(bf16x8, w11);
    __builtin_amdgcn_s_setprio(1);
#pragma unroll
    for (int db = 0; db < NDB; ++db) {
        O[db] = MFMA32(vf[db][0], p00, O[db]);
        O[db] = MFMA32(vf[db][1], p01, O[db]);
        O[db] = MFMA32(vf[db][2], p10, O[db]);
        O[db] = MFMA32(vf[db][3], p11, O[db]);
    }
    __builtin_amdgcn_s_setprio(0);
}

template <int DV, bool WINDOW>
__device__ __forceinline__ void compute_block32(const unsigned char* kb, const unsigned char* vb0, const bf16x8 (&qf)[4], f32x16& negm,
                                                f32x16 (&O)[DV / 32], float& m_run, float& l_run, const bool mtile, const int jb0, const int qpos, const int hi, const bool first) {
    constexpr int NDB = DV / 32;
    constexpr float THR = 8.0f;
    f32x16 s;
    bf16x8 kf[4], vf[NDB][2];
#pragma unroll
    for (int kk = 0; kk < 4; ++kk) kf[kk] = *(const bf16x8*)(kb + kk * 32);
#pragma unroll
    for (int db = 0; db < NDB; ++db) { vf[db][0] = *(const bf16x8*)(vb0 + db * 32 * 144); vf[db][1] = *(const bf16x8*)(vb0 + db * 32 * 144 + 32); }
    __builtin_amdgcn_sched_barrier(0);
#pragma unroll
    for (int r = 0; r < 16; ++r) s[r] = 0.f;
    __builtin_amdgcn_s_setprio(1);
#pragma unroll
    for (int kk = 0; kk < 4; ++kk) s = MFMA32(kf[kk], qf[kk], s);
    __builtin_amdgcn_s_setprio(0);
    if (WINDOW && mtile) {
#pragma unroll
        for (int r = 0; r < 16; ++r) {
            const int j = jb0 + 16 * (r >> 3) + 8 * hi + (r & 7);
            const int d0 = qpos - j;
            if (d0 > 128 || d0 < -128) s[r] = -1e30f;
        }
    }
    float mx = s[0];
#pragma unroll
    for (int r = 1; r < 16; ++r) mx = fmaxf(mx, s[r]);
    {
        auto rr = __builtin_amdgcn_permlane32_swap(__float_as_uint(mx), __float_as_uint(mx), false, false);
        mx = fmaxf(__uint_as_float(rr[0]), __uint_as_float(rr[1]));
    }
    mx -= m_run;
    if (first || __any(mx > THR)) {
        const float dl = first ? mx : fmaxf(mx, 0.f);
        m_run += dl;
        const float alpha = fexp2(-dl);
        l_run *= alpha;
#pragma unroll
        for (int db = 0; db < NDB; ++db)
#pragma unroll
            for (int r = 0; r < 16; ++r) O[db][r] *= alpha;
    }
    float rs = 0.f;
#pragma unroll
    for (int r = 0; r < 16; ++r) { s[r] = fexp2(s[r] - m_run); rs += s[r]; }
    l_run += rs;
    u32x4 w0, w1;
    w0.x = cvtpk(s[0], s[1]); w0.y = cvtpk(s[2], s[3]); w0.z = cvtpk(s[4], s[5]); w0.w = cvtpk(s[6], s[7]);
    w1.x = cvtpk(s[8], s[9]); w1.y = cvtpk(s[10], s[11]); w1.z = cvtpk(s[12], s[13]); w1.w = cvtpk(s[14], s[15]);
    const bf16x8 p0 = __builtin_bit_cast(bf16x8, w0), p1 = __builtin_bit_cast(bf16x8, w1);
    __builtin_amdgcn_s_setprio(1);
#pragma unroll
    for (int db = 0; db < NDB; ++db) {
        O[db] = MFMA32(vf[db][0], p0, O[db]);
        O[db] = MFMA32(vf[db][1], p1, O[db]);
    }
    __builtin_amdgcn_s_setprio(0);
}

template <int DV, bool WINDOW>
__device__ __forceinline__ void attn_pass(const bf16x8 (&qf)[4], const bf16_t* __restrict__ Kg, const bf16_t* __restrict__ Vg, const int NK,
                                          const int nt_lead, const int lt_lo, const int lt_hi, const int qpos, const int wq0,
                                          f32x16 (&O)[DV / 32], float& m_run, float& l_run, unsigned char* lds, const int tid) {
    constexpr int NDB = DV / 32, NVH = DV / 64, BUFB = 9216 + DV * 144;
    constexpr float THR = 8.0f;
    const int lane = tid & 63, i = lane & 31, hi = lane >> 5;
    const int pi = (i & 0x13) | ((i & 4) << 1) | ((i & 8) >> 1);
    const int krow = tid >> 3, kch = tid & 7;
    const int T = nt_lead + (lt_hi - lt_lo);
    const unsigned stK = krow * 144 + kch * 16;
    const unsigned rdK = pi * 144 + hi * 16, rdV = 9216 + i * 144 + hi * 16;
    u32x4 kregA, vregA[NVH], kregB, vregB[NVH];
    f32x16 negm;
#pragma unroll
    for (int r = 0; r < 16; ++r) negm[r] = 0.f;
    m_run = 0.f;
#define TILE_OF(it) ((it) < nt_lead ? (it) : lt_lo + ((it) - nt_lead))
#define LOADT(KR, VR, kt) do { KR = *(const u32x4*)(Kg + (size_t)((kt) * 64 + krow) * 64 + kch * 8); \
        _Pragma("unroll") for (int h_ = 0; h_ < NVH; ++h_) VR[h_] = *(const u32x4*)(Vg + (size_t)(h_ * 64 + krow) * NK + (kt) * 64 + kch * 8); } while (0)
#define STORET(KR, VR, buf) do { *(u32x4*)(lds + (buf) * BUFB + stK) = KR; \
        _Pragma("unroll") for (int h_ = 0; h_ < NVH; ++h_) *(u32x4*)(lds + (buf) * BUFB + 9216 + (h_ * 64 + krow) * 144 + kch * 16) = VR[h_]; } while (0)
#define STEP(it, KR, VR) do { \
        STORET(KR, VR, ((it) + 1) & 1); \
        { const int i3_ = ((it) + 3 < T) ? (it) + 3 : T - 1; const int kt3 = TILE_OF(i3_); LOADT(KR, VR, kt3); } \
        const int kt = TILE_OF(it); \
        const bool mtile = WINDOW && ((it) >= nt_lead); \
        const int j0 = kt * 64 - 256; \
        bool active = true; \
        if (mtile) active = (j0 + 63 >= wq0 - 128) && (j0 <= wq0 + 31 + 128); \
        if (active) { if (DV == 128) { const unsigned char* b_ = lds + ((it) & 1) * BUFB; \
                compute_block32<DV, WINDOW>(b_ + rdK, b_ + rdV, qf, negm, O, m_run, l_run, mtile, j0, qpos, hi, (it) == 0); \
                compute_block32<DV, WINDOW>(b_ + rdK + 32 * 144, b_ + rdV + 64, qf, negm, O, m_run, l_run, mtile, j0 + 32, qpos, hi, false); } \
            else compute_tile<DV, WINDOW>(lds + ((it) & 1) * BUFB, rdK, rdV, qf, negm, O, m_run, l_run, mtile, j0, qpos, hi, (it) == 0); } \
        asm volatile("s_waitcnt lgkmcnt(0)\n\ts_barrier" ::: "memory"); } while (0)
    { const int kt0 = TILE_OF(0); LOADT(kregA, vregA, kt0); }
    { const int i1_ = T > 1 ? 1 : T - 1; const int kt1 = TILE_OF(i1_); LOADT(kregB, vregB, kt1); }
    STORET(kregA, vregA, 0);
    { const int i2_ = T > 2 ? 2 : T - 1; const int kt2 = TILE_OF(i2_); LOADT(kregA, vregA, kt2); }
    asm volatile("s_waitcnt lgkmcnt(0)\n\ts_barrier" ::: "memory");
    for (int it = 0; it < T; it += 2) {
        STEP(it, kregB, vregB);
        if (it + 1 < T) STEP(it + 1, kregA, vregA);
    }
#undef TILE_OF
#undef LOADT
#undef STORET
#undef STEP
}

template <int NDB>
__device__ __forceinline__ void write_y(const f32x16 (&R)[NDB], const bf16_t* zgate, bf16_t* yout, int hi) {
#pragma unroll
    for (int db = 0; db < NDB; ++db)
#pragma unroll
        for (int g = 0; g < 4; g += 2) {
            float v[8];
#pragma unroll
            for (int k = 0; k < 4; ++k) {
                auto rr = __builtin_amdgcn_permlane32_swap(__float_as_uint(R[db][4 * g + k]), __float_as_uint(R[db][4 * (g + 1) + k]), false, false);
                v[k] = __uint_as_float(rr[0]); v[4 + k] = __uint_as_float(rr[1]);
            }
            const int d0 = 32 * db + 8 * (g + hi);
            const u32x4 gw = *(const u32x4*)(zgate + d0);
            u32x4 o;
            o.x = cvtpk(v[0] * siluf(bflo(gw.x)), v[1] * siluf(bfhi(gw.x))); o.y = cvtpk(v[2] * siluf(bflo(gw.y)), v[3] * siluf(bfhi(gw.y)));
            o.z = cvtpk(v[4] * siluf(bflo(gw.z)), v[5] * siluf(bfhi(gw.z))); o.w = cvtpk(v[6] * siluf(bflo(gw.w)), v[7] * siluf(bfhi(gw.w)));
            *(u32x4*)(yout + d0) = o;
        }
}

template <int NDB>
__device__ __forceinline__ void softmax1(f32x16& s, f32x16 (&O)[NDB], float& m_run, float& l_run, const bool first, bf16x8& p0, bf16x8& p1) {
    constexpr float THR = 8.0f;
    float mx = s[0];
#pragma unroll
    for (int r = 1; r < 16; ++r) mx = fmaxf(mx, s[r]);
    {
        auto rr = __builtin_amdgcn_permlane32_swap(__float_as_uint(mx), __float_as_uint(mx), false, false);
        mx = fmaxf(__uint_as_float(rr[0]), __uint_as_float(rr[1]));
    }
    mx -= m_run;
    if (first || __any(mx > THR)) {
        const float dl = first ? mx : fmaxf(mx, 0.f);
        m_run += dl;
        const float alpha = fexp2(-dl);
        l_run *= alpha;
#pragma unroll
        for (int db = 0; db < NDB; ++db)
#pragma unroll
            for (int r = 0; r < 16; ++r) O[db][r] *= alpha;
    }
    float rs = 0.f;
#pragma unroll
    for (int r = 0; r < 16; ++r) { s[r] = fexp2(s[r] - m_run); rs += s[r]; }
    l_run += rs;
    u32x4 w0, w1;
    w0.x = cvtpk(s[0], s[1]); w0.y = cvtpk(s[2], s[3]); w0.z = cvtpk(s[4], s[5]); w0.w = cvtpk(s[6], s[7]);
    w1.x = cvtpk(s[8], s[9]); w1.y = cvtpk(s[10], s[11]); w1.z = cvtpk(s[12], s[13]); w1.w = cvtpk(s[14], s[15]);
    p0 = __builtin_bit_cast(bf16x8, w0); p1 = __builtin_bit_cast(bf16x8, w1);
}
__device__ __forceinline__ void attn_pass_q2(const bf16x8 (&qfA)[4], const bf16x8 (&qfB)[4], const bf16_t* __restrict__ Kg, const bf16_t* __restrict__ Vg, const int NK, const int T,
                                             f32x16 (&OA)[2], f32x16 (&OB)[2], float& mA, float& lA, float& mB, float& lB, unsigned char* lds, const int tid) {
    constexpr int BUFB = 9216 + 64 * 144;
    const int lane = tid & 63, i = lane & 31, hi = lane >> 5;
    const int pi = (i & 0x13) | ((i & 4) << 1) | ((i & 8) >> 1);
    const int krow = tid >> 3, kch = tid & 7;
    const unsigned stK = krow * 144 + kch * 16;
    const unsigned rdK = pi * 144 + hi * 16, rdV = 9216 + i * 144 + hi * 16;
    u32x4 kreg, vreg;
    mA = 0.f; mB = 0.f;
    const unsigned kgo = (unsigned)(krow * 64 + kch * 8) * 2u, vgo = (unsigned)(krow * NK + kch * 8) * 2u;
#define LOADT2(kt) do { kreg = *(const u32x4*)((const char*)Kg + (size_t)(kt) * 8192 + kgo); vreg = *(const u32x4*)((const char*)Vg + (size_t)(kt) * 128 + vgo); } while (0)
#define STORET2(off) do { *(u32x4*)(lds + (off) + stK) = kreg; *(u32x4*)(lds + (off) + 9216 + stK) = vreg; } while (0)
#define QK2(SA, SB, kptr) do { bf16x8 kf_[4]; \
        _Pragma("unroll") for (int kk = 0; kk < 4; ++kk) kf_[kk] = *(const bf16x8*)((kptr) + kk * 32); \
        _Pragma("unroll") for (int r = 0; r < 16; ++r) { SA[r] = 0.f; SB[r] = 0.f; } \
        __builtin_amdgcn_s_setprio(1); \
        _Pragma("unroll") for (int kk = 0; kk < 4; ++kk) { SA = MFMA32(kf_[kk], qfA[kk], SA); SB = MFMA32(kf_[kk], qfB[kk], SB); } \
        __builtin_amdgcn_s_setprio(0); } while (0)
#define SMPV2(SA, SB, vptr, first) do { bf16x8 vf_[4], p0_, p1_; \
        _Pragma("unroll") for (int q = 0; q < 4; ++q) vf_[q] = *(const bf16x8*)((vptr) + (q >> 1) * 32 * 144 + (q & 1) * 32); \
        softmax1<2>(SA, OA, mA, lA, (first), p0_, p1_); \
        __builtin_amdgcn_s_setprio(1); \
        OA[0] = MFMA32(vf_[0], p0_, OA[0]); OA[1] = MFMA32(vf_[2], p0_, OA[1]); OA[0] = MFMA32(vf_[1], p1_, OA[0]); OA[1] = MFMA32(vf_[3], p1_, OA[1]); \
        __builtin_amdgcn_s_setprio(0); \
        softmax1<2>(SB, OB, mB, lB, (first), p0_, p1_); \
        __builtin_amdgcn_s_setprio(1); \
        OB[0] = MFMA32(vf_[0], p0_, OB[0]); OB[1] = MFMA32(vf_[2], p0_, OB[1]); OB[0] = MFMA32(vf_[1], p1_, OB[0]); OB[1] = MFMA32(vf_[3], p1_, OB[1]); \
        __builtin_amdgcn_s_setprio(0); } while (0)
    LOADT2(0); STORET2(0);
    { const int t1 = T > 1 ? 1 : T - 1; LOADT2(t1); } STORET2(BUFB);
    { const int t2 = T > 2 ? 2 : T - 1; LOADT2(t2); }
    asm volatile("s_waitcnt lgkmcnt(0)\n\ts_barrier" ::: "memory");
    unsigned o_cur = 0, o_nxt = BUFB, o_nn = 2 * BUFB;
    f32x16 sXA, sXB, sYA, sYB;
    QK2(sXA, sXB, lds + o_cur + rdK);
    for (int t = 0; t < T; ++t) {
        QK2(sYA, sYB, lds + o_cur + rdK + 32 * 144);
        __builtin_amdgcn_sched_barrier(0);
        SMPV2(sXA, sXB, lds + o_cur + rdV, t == 0);
        __builtin_amdgcn_sched_barrier(0);
        if (t + 1 < T) {
            asm volatile("s_waitcnt lgkmcnt(0)\n\ts_barrier" ::: "memory");
            STORET2(o_nn);
            { const int t3 = (t + 3 < T) ? t + 3 : T - 1; LOADT2(t3); }
            QK2(sXA, sXB, lds + o_nxt + rdK);
        }
        __builtin_amdgcn_sched_barrier(0);
        SMPV2(sYA, sYB, lds + o_cur + rdV + 64, false);
        __builtin_amdgcn_sched_barrier(0);
        { const unsigned tmp = o_cur; o_cur = o_nxt; o_nxt = o_nn; o_nn = tmp; }
    }
    asm volatile("s_waitcnt lgkmcnt(0)\n\ts_barrier" ::: "memory");
#undef LOADT2
#undef STORET2
#undef QK2
#undef SMPV2
}

__device__ __forceinline__ void attn_pass_w2(const bf16x8 (&qfA)[4], const bf16x8 (&qfB)[4], const bf16_t* __restrict__ Kg, const bf16_t* __restrict__ Vg, const int NK,
                                             const int lt_lo, const int lt_hi, const int qpos, const int wq0,
                                             f32x16 (&OA)[2], f32x16 (&OB)[2], float& mA, float& lA, float& mB, float& lB, unsigned char* lds, const int tid) {
    constexpr int BUFB = 9216 + 64 * 144;
    const int lane = tid & 63, i = lane & 31, hi = lane >> 5;
    const int pi = (i & 0x13) | ((i & 4) << 1) | ((i & 8) >> 1);
    const int krow = tid >> 3, kch = tid & 7;
    const int T = 4 + (lt_hi - lt_lo);
    const unsigned stK = krow * 144 + kch * 16;
    const unsigned rdK = pi * 144 + hi * 16, rdV = 9216 + i * 144 + hi * 16;
    const unsigned kgo = (unsigned)(krow * 64 + kch * 8) * 2u, vgo = (unsigned)(krow * NK + kch * 8) * 2u;
    u32x4 kregA, vregA;
    mA = 0.f; mB = 0.f;
#define TILE_W(it) ((it) < 4 ? (it) : lt_lo + ((it) - 4))
#define LOADW(KR, VR, kt) do { KR = *(const u32x4*)((const char*)Kg + (size_t)(kt) * 8192 + kgo); VR = *(const u32x4*)((const char*)Vg + (size_t)(kt) * 128 + vgo); } while (0)
#define STOREW(KR, VR, buf) do { *(u32x4*)(lds + (buf) * BUFB + stK) = KR; *(u32x4*)(lds + (buf) * BUFB + 9216 + stK) = VR; } while (0)
#define STEPW(it, KR, VR) do { \
        STOREW(KR, VR, ((it) + 1) & 1); \
        { const int i3_ = ((it) + 2 < T) ? (it) + 2 : T - 1; const int kt3_ = TILE_W(i3_); LOADW(KR, VR, kt3_); } \
        const int kt_ = TILE_W(it); \
        const bool mtile_ = (it) >= 4; \
        const int j0_ = kt_ * 64 - 256; \
        const bool active_ = !mtile_ || ((j0_ + 63 >= wq0 - 128) && (j0_ <= wq0 + 31 + 128)); \
        if (active_) { \
            const unsigned char* base = lds + ((it) & 1) * BUFB; \
            _Pragma("unroll") for (int kb = 0; kb < 2; ++kb) { \
                bf16x8 kf[4], vf[4]; \
                _Pragma("unroll") for (int kk = 0; kk < 4; ++kk) kf[kk] = *(const bf16x8*)(base + rdK + kb * 32 * 144 + kk * 32); \
                _Pragma("unroll") for (int q = 0; q < 4; ++q) vf[q] = *(const bf16x8*)(base + rdV + (q >> 1) * 32 * 144 + kb * 64 + (q & 1) * 32); \
                bf16x8 p0, p1; \
                { f32x16 sA; \
                  _Pragma("unroll") for (int r = 0; r < 16; ++r) sA[r] = 0.f; \
                  _Pragma("unroll") for (int kk = 0; kk < 4; ++kk) sA = MFMA32(kf[kk], qfA[kk], sA); \
                  if (mtile_) { int qd_ = qpos - j0_ - 32 * kb - 8 * hi; asm volatile("" : "+v"(qd_));     \
                      _Pragma("unroll") for (int r = 0; r < 16; ++r) { \
                          const int d0_ = qd_ - (16 * (r >> 3) + (r & 7)); \
                          if (d0_ > 128 || d0_ < -128) sA[r] = -1e30f; } } \
                  softmax1<2>(sA, OA, mA, lA, (it) == 0 && kb == 0, p0, p1); } \
                OA[0] = MFMA32(vf[0], p0, OA[0]); OA[1] = MFMA32(vf[2], p0, OA[1]); OA[0] = MFMA32(vf[1], p1, OA[0]); OA[1] = MFMA32(vf[3], p1, OA[1]); \
                { f32x16 sB; \
                  _Pragma("unroll") for (int r = 0; r < 16; ++r) sB[r] = 0.f; \
                  _Pragma("unroll") for (int kk = 0; kk < 4; ++kk) sB = MFMA32(kf[kk], qfB[kk], sB); \
                  if (mtile_) { int qd_ = qpos - j0_ - 32 * kb - 8 * hi; asm volatile("" : "+v"(qd_));     \
                      _Pragma("unroll") for (int r = 0; r < 16; ++r) { \
                          const int d0_ = qd_ - (16 * (r >> 3) + (r & 7)); \
                          if (d0_ > 128 || d0_ < -128) sB[r] = -1e30f; } } \
                  softmax1<2>(sB, OB, mB, lB, (it) == 0 && kb == 0, p0, p1); } \
                OB[0] = MFMA32(vf[0], p0, OB[0]); OB[1] = MFMA32(vf[2], p0, OB[1]); OB[0] = MFMA32(vf[1], p1, OB[0]); OB[1] = MFMA32(vf[3], p1, OB[1]); \
            } } \
        asm volatile("s_waitcnt lgkmcnt(0)\n\ts_barrier" ::: "memory"); } while (0)
    LOADW(kregA, vregA, 0);
    STOREW(kregA, vregA, 0);
    { const int kt1 = TILE_W(1); LOADW(kregA, vregA, kt1); }
    asm volatile("s_waitcnt lgkmcnt(0)\n\ts_barrier" ::: "memory");
    for (int it = 0; it < T; ++it) STEPW(it, kregA, vregA);
#undef TILE_W
#undef LOADW
#undef STOREW
#undef STEPW
}

__device__ __forceinline__ void unit_A2(const Params& p, int u, unsigned char* lds, int tid) {
    unsigned char* ws = p.ws;
    const bf16_t* Z = (const bf16_t*)(ws + WS_Z); bf16_t* Y = (bf16_t*)(ws + WS_XN);
    const int qb = u & 31, kv = (u >> 5) & 1, b = u >> 6;
    const int q0 = qb * 128;
    f32x16 OA[2], OB[2];
    float mA, lA = 0.f, mB, lB = 0.f;
    {
        const float* cosT = (const float*)(ws + WS_ROPE); const float* sinT = cosT + 1024;
        const int wave = tid >> 6, lane = tid & 63, i = lane & 31, hi = lane >> 5;
        const int hA = kv * 4 + 2 * (wave >> 2);
        const int wq0 = q0 + (wave & 3) * 32, qloc = wq0 + i;
        const bf16_t* zrow = Z + ((size_t)NCTXTOK + (size_t)b * 4096 + qloc) * PZ;
        bf16x8 qfA[4], qfB[4];
        load_q<false, true>(zrow + hA * 64, hi, nullptr, qloc, cosT, sinT, qfA);
        load_q<false, true>(zrow + hA * 64 + 64, hi, nullptr, qloc, cosT, sinT, qfB);
        const bf16_t* Kg = (const bf16_t*)(ws + L0_KA_LAT) + (size_t)(b * 2 + kv) * NKL * 64;
        const bf16_t* Vg = (const bf16_t*)(ws + L0_VTA_LAT) + (size_t)(b * 2 + kv) * 64 * NKL;
#pragma unroll
        for (int db = 0; db < 2; ++db)
#pragma unroll
            for (int r = 0; r < 16; ++r) { OA[db][r] = 0.f; OB[db][r] = 0.f; }
        const int tq = q0 >> 6;
        const int lo = 4 + (tq - 2 > 0 ? tq - 2 : 0), hiT = 4 + (tq + 4 < 64 ? tq + 4 : 64);
        attn_pass_w2(qfA, qfB, Kg, Vg, NKL, lo, hiT, qloc, wq0, OA, OB, mA, lA, mB, lB, lds, tid);
    }
    int t2 = threadIdx.x; asm volatile("" : "+v"(t2));
    const int wave = t2 >> 6, lane = t2 & 63, i = lane & 31, hi = lane >> 5;
    const int hA = kv * 4 + 2 * (wave >> 2), hB = hA + 1;
    const int qloc = q0 + (wave & 3) * 32 + i;
    const size_t tok = (size_t)NCTXTOK + (size_t)b * 4096 + qloc;
    const bf16_t* zrow = Z + tok * PZ;
    lA += __shfl_xor(lA, 32); lB += __shfl_xor(lB, 32);
    lA += fexp2(p.in[I_SINK][hA] * LOG2E - mA); lB += fexp2(p.in[I_SINK][hB] * LOG2E - mB);
    const float iA = 1.0f / lA, iB = 1.0f / lB;
#pragma unroll
    for (int db = 0; db < 2; ++db)
#pragma unroll
        for (int r = 0; r < 16; ++r) { OA[db][r] *= iA; OB[db][r] *= iB; }
    write_y<2>(OA, zrow + 2304 + hA * 64, Y + tok * DM + hA * 64, hi);
    write_y<2>(OB, zrow + 2304 + hB * 64, Y + tok * DM + hB * 64, hi);
}

__device__ __forceinline__ void unit_D2(const Params& p, int u, unsigned char* lds, int tid) {
    unsigned char* ws = p.ws;
    const bf16_t* Z = (const bf16_t*)(ws + WS_Z); bf16_t* Y = (bf16_t*)(ws + WS_XN);
    const float* cosT = (const float*)(ws + WS_ROPE); const float* sinT = cosT + 1024;
    const int qb = u & 7, hq = (u >> 3) & 7, b = u >> 6;
    const int kvh = hq >> 2, wave = tid >> 6, lane = tid & 63, i = lane & 31, hi = lane >> 5;
    const int qA = qb * 512 + wave * 64 + i, qB = qA + 32;
    const size_t tokA = (size_t)NCTXTOK + (size_t)b * 4096 + qA, tokB = tokA + 32;
    bf16x8 qfA[4], qfB[4];
    load_q<true, true>(Z + tokA * PZ + 1536 + hq * 64, hi, p.in[I_DQG], qA, cosT, sinT, qfA);
    load_q<true, true>(Z + tokB * PZ + 1536 + hq * 64, hi, p.in[I_DQG], qB, cosT, sinT, qfB);
    const bf16_t* Kg = (const bf16_t*)(ws + L1_KD_LAT) + (size_t)(b * 2 + kvh) * NKL * 64;
    const bf16_t* Vg = (const bf16_t*)(ws + L1_VTD_LAT) + (size_t)(b * 2 + kvh) * 64 * NKL;
    f32x16 OA[2], OB[2];
#pragma unroll
    for (int db = 0; db < 2; ++db)
#pragma unroll
        for (int r = 0; r < 16; ++r) { OA[db][r] = 0.f; OB[db][r] = 0.f; }
    float mA, lA = 0.f, mB, lB = 0.f;
    attn_pass_q2(qfA, qfB, Kg, Vg, NKL, NKL / 64, OA, OB, mA, lA, mB, lB, lds, tid);
    lA += __shfl_xor(lA, 32); lB += __shfl_xor(lB, 32);
    const float iA = 1.0f / lA, iB = 1.0f / lB;
#pragma unroll
    for (int db = 0; db < 2; ++db)
#pragma unroll
        for (int r = 0; r < 16; ++r) { OA[db][r] *= iA; OB[db][r] *= iB; }
    write_y<2>(OA, Z + tokA * PZ + 2816 + hq * 64, Y + tokA * DM + 512 + hq * 64, hi);
    write_y<2>(OB, Z + tokB * PZ + 2816 + hq * 64, Y + tokB * DM + 512 + hq * 64, hi);
}

template <bool LAT>
__device__ __forceinline__ void unit_A(const Params& p, int u, unsigned char* lds, int tid) {
    unsigned char* ws = p.ws;
    const bf16_t* Z = (const bf16_t*)(ws + WS_Z); bf16_t* Y = (bf16_t*)(ws + WS_XN);
    const float* cosT = (const float*)(ws + WS_ROPE); const float* sinT = cosT + 1024;
    int qb, hq, b;
    if (LAT) { qb = u & 15; hq = (u >> 4) & 7; b = u >> 7; } else { qb = 0; hq = u & 7; b = u >> 3; }
    const int kvh = hq >> 2, wave = tid >> 6, lane = tid & 63, i = lane & 31, hi = lane >> 5;
    const int q0 = qb * 256, qloc = q0 + wave * 32 + i;
    const size_t tok = LAT ? (size_t)NCTXTOK + (size_t)b * 4096 + qloc : (size_t)b * 256 + qloc;
    const bf16_t* zrow = Z + tok * PZ;
    bf16x8 qf[4];
    load_q<false, LAT>(zrow + hq * 64, hi, nullptr, qloc, cosT, sinT, qf);
    const int NK = LAT ? NKL : 256;
    const bf16_t* Kg = (const bf16_t*)(ws + (LAT ? L0_KA_LAT : L0_KA_CTX)) + (size_t)(b * 2 + kvh) * NK * 64;
    const bf16_t* Vg = (const bf16_t*)(ws + (LAT ? L0_VTA_LAT : L0_VTA_CTX)) + (size_t)(b * 2 + kvh) * 64 * NK;
    f32x16 O[2];
#pragma unroll
    for (int db = 0; db < 2; ++db)
#pragma unroll
        for (int r = 0; r < 16; ++r) O[db][r] = 0.f;
    float m = -1e30f, l = 0.f;
    if (LAT) {
        const int tq = q0 >> 6;
        const int lo = 4 + (tq - 2 > 0 ? tq - 2 : 0), hiT = 4 + (tq + 6 < 64 ? tq + 6 : 64);
        attn_pass<64, true>(qf, Kg, Vg, NK, 4, lo, hiT, qloc, q0 + wave * 32, O, m, l, lds, tid);
    } else {
        attn_pass<64, false>(qf, Kg, Vg, NK, 4, 0, 0, 0, 0, O, m, l, lds, tid);
    }
    l += __shfl_xor(l, 32);
    l += fexp2(p.in[I_SINK][hq] * LOG2E - m);
    const float inv = 1.0f / l;
#pragma unroll
    for (int db = 0; db < 2; ++db)
#pragma unroll
        for (int r = 0; r < 16; ++r) O[db][r] *= inv;
    write_y<2>(O, zrow + 2304 + hq * 64, Y + tok * DM + hq * 64, hi);
}

template <bool LAT>
__device__ __forceinline__ void unit_B(const Params& p, int u, unsigned char* lds, int tid) {
    unsigned char* ws = p.ws;
    const bf16_t* Z = (const bf16_t*)(ws + WS_Z); bf16_t* Y = (bf16_t*)(ws + WS_XN);
    const float* cosT = (const float*)(ws + WS_ROPE); const float* sinT = cosT + 1024;
    int qb, h, b;
    if (LAT) { qb = u & 15; h = (u >> 4) & 3; b = u >> 6; } else { qb = 0; h = u & 3; b = u >> 2; }
    const int wave = tid >> 6, lane = tid & 63, i = lane & 31, hi = lane >> 5;
    const int q0 = qb * 256, qloc = q0 + wave * 32 + i;
    const size_t tok = LAT ? (size_t)NCTXTOK + (size_t)b * 4096 + qloc : (size_t)b * 256 + qloc;
    const bf16_t* zrow = Z + tok * PZ;
    const int NK = LAT ? NKL : 256;
    const float lam = *(const float*)(ws + WS_LAM);
    const bf16_t* Vg = (const bf16_t*)(ws + (LAT ? L0_VTB_LAT : L0_VTB_CTX)) + (size_t)(b * 4 + h) * 128 * NK;
    f32x16 R[4];
#pragma unroll 1
    for (int pass = 0; pass < 2; ++pass) {
        bf16x8 qf[4];
        load_q<false, LAT>(zrow + 768 + h * 128 + pass * 64, hi, nullptr, qloc, cosT, sinT, qf);
        const size_t kb = LAT ? (pass ? L0_KB2_LAT : L0_KB1_LAT) : (pass ? L0_KB2_CTX : L0_KB1_CTX);
        const bf16_t* Kg = (const bf16_t*)(ws + kb) + (size_t)(b * 4 + h) * NK * 64;
#pragma unroll
        for (int db = 0; db < 4; ++db)
#pragma unroll
            for (int r = 0; r < 16; ++r) R[db][r] = 0.f;
        float m = -1e30f, l = 0.f;
        attn_pass<128, false>(qf, Kg, Vg, NK, NK / 64, 0, 0, 0, 0, R, m, l, lds, tid);
        l += __shfl_xor(l, 32);
        const float inv = 1.0f / l;
        unsigned* stash = (unsigned*)(lds + 55296 + wave * 8192) + lane;
        if (pass == 0) {
#pragma unroll
            for (int db = 0; db < 4; ++db)
#pragma unroll
                for (int r = 0; r < 8; ++r) stash[(db * 8 + r) * 64] = cvtpk(R[db][2 * r] * inv, R[db][2 * r + 1] * inv);
        } else {
            const float f = lam * inv;
#pragma unroll
            for (int db = 0; db < 4; ++db)
#pragma unroll
                for (int r = 0; r < 8; ++r) { const unsigned w = stash[(db * 8 + r) * 64]; R[db][2 * r] = bflo(w) - f * R[db][2 * r]; R[db][2 * r + 1] = bfhi(w) - f * R[db][2 * r + 1]; }
        }
    }
    float ss = 0.f;
#pragma unroll
    for (int db = 0; db < 4; ++db)
#pragma unroll
        for (int r = 0; r < 16; ++r) ss += R[db][r] * R[db][r];
    ss += __shfl_xor(ss, 32);
    const float rinv = rsqrtf(ss * (1.0f / 128.0f) + EPS) * 0.8f;
    const float* bng = p.in[I_BNG];
#pragma unroll
    for (int db = 0; db < 4; ++db)
#pragma unroll
        for (int g = 0; g < 4; ++g) {
            const f32x4 gg = *(const f32x4*)(bng + 32 * db + 8 * g + 4 * hi);
            R[db][4 * g] *= rinv * gg.x; R[db][4 * g + 1] *= rinv * gg.y; R[db][4 * g + 2] *= rinv * gg.z; R[db][4 * g + 3] *= rinv * gg.w;
        }
    write_y<4>(R, zrow + 2816 + h * 128, Y + tok * DM + 512 + h * 128, hi);
}

template <bool LAT>
__device__ __forceinline__ void unit_D(const Params& p, int u, unsigned char* lds, int tid) {
    unsigned char* ws = p.ws;
    const bf16_t* Z = (const bf16_t*)(ws + WS_Z); bf16_t* Y = (bf16_t*)(ws + WS_XN);
    const float* cosT = (const float*)(ws + WS_ROPE); const float* sinT = cosT + 1024;
    int qb, hq, b;
    if (LAT) { qb = u & 15; hq = (u >> 4) & 7; b = u >> 7; } else { qb = 0; hq = u & 7; b = u >> 3; }
    const int kvh = hq >> 2, wave = tid >> 6, lane = tid & 63, i = lane & 31, hi = lane >> 5;
    const int q0 = qb * 256, qloc = q0 + wave * 32 + i;
    const size_t tok = LAT ? (size_t)NCTXTOK + (size_t)b * 4096 + qloc : (size_t)b * 256 + qloc;
    const bf16_t* zrow = Z + tok * PZ;
    bf16x8 qf[4];
    load_q<true, LAT>(zrow + 1536 + hq * 64, hi, p.in[I_DQG], qloc, cosT, sinT, qf);
    const int NK = LAT ? NKL : 256;
    const bf16_t* Kg = (const bf16_t*)(ws + (LAT ? L1_KD_LAT : L1_KD_CTX)) + (size_t)(b * 2 + kvh) * NK * 64;
    const bf16_t* Vg = (const bf16_t*)(ws + (LAT ? L1_VTD_LAT : L1_VTD_CTX)) + (size_t)(b * 2 + kvh) * 64 * NK;
    f32x16 O[2];
#pragma unroll
    for (int db = 0; db < 2; ++db)
#pragma unroll
        for (int r = 0; r < 16; ++r) O[db][r] = 0.f;
    float m = -1e30f, l = 0.f;
    attn_pass<64, false>(qf, Kg, Vg, NK, NK / 64, 0, 0, 0, 0, O, m, l, lds, tid);
    l += __shfl_xor(l, 32);
    const float inv = 1.0f / l;
#pragma unroll
    for (int db = 0; db < 2; ++db)
#pragma unroll
        for (int r = 0; r < 16; ++r) O[db][r] *= inv;
    write_y<2>(O, zrow + 2816 + hq * 64, Y + tok * DM + 512 + hq * 64, hi);
}

template <bool LAT>
__device__ __forceinline__ void scan_unit(const Params& p, int u, int lane) {
    unsigned char* ws = p.ws;
    constexpr int NS = LAT ? 4096 : 256, NCH = LAT ? 32 : 2;
    const int db = u & 3, eb = (u >> 2) & 3, dir = (u >> 4) & 1, sh = u >> 5, h = sh & 3;
    const int i = lane & 31, hi = lane >> 5;
    const bf16_t* Kt = (const bf16_t*)(ws + (LAT ? L1_KTL : L1_KTC)) + (size_t)sh * 128 * NS + (size_t)(db * 8 * 64 + lane) * 8;
    const bf16_t* Vt = (const bf16_t*)(ws + (LAT ? L1_VTL : L1_VTC)) + (size_t)sh * 128 * NS + (size_t)(eb * 8 * 64 + lane) * 8;
    bf16_t* St = (bf16_t*)(ws + (LAT ? (dir ? L1_STB_L : L1_STF_L) : (dir ? L1_STB_C : L1_STF_C))) + (size_t)sh * NCH * 16384;
    const float lg2 = -expf(p.in[dir ? I_DECB : I_DECF][h]) * LOG2E;
    f32x16 acc;
    if (LAT) {
        const float* s0 = p.in[dir ? I_SCB : I_SCF] + (size_t)sh * 16384;
#pragma unroll
        for (int r = 0; r < 16; ++r) acc[r] = s0[(size_t)(db * 32 + i) * 128 + eb * 32 + crow(r, hi)];
    } else {
#pragma unroll
        for (int r = 0; r < 16; ++r) acc[r] = 0.f;
    }
    float base[8];
#pragma unroll
    for (int jj = 0; jj < 8; ++jj) base[jj] = KSCALE_C * (dir ? fexp2(lg2 * (float)(8 * hi + jj)) : fexp2(lg2 * (float)(127 - 8 * hi - jj)));
    const float step = dir ? fexp2(16.0f * lg2) : fexp2(-16.0f * lg2);
    const float cdec = fexp2(128.0f * lg2);
    u32x4 va[8], kb[8];
    {
        const int c0 = dir ? NCH - 1 : 0;
#pragma unroll
        for (int ks = 0; ks < 8; ++ks) { va[ks] = *(const u32x4*)(Vt + (size_t)c0 * 16384 + ks * 512); kb[ks] = *(const u32x4*)(Kt + (size_t)c0 * 16384 + ks * 512); }
    }
#pragma unroll 1
    for (int cc = 0; cc < NCH; ++cc) {
        const int c = dir ? NCH - 1 - cc : cc;
        const int cn = dir ? c - 1 : c + 1;
        const bool more = cc + 1 < NCH;
        bf16_t* So = St + (size_t)c * 16384;
#pragma unroll
        for (int r = 0; r < 16; ++r) So[(size_t)(((eb * 8 + 2 * db + (i >> 4)) * 64 + ((i >> 3) & 1) * 32 + crow(r, hi)) * 8 + (i & 7))] = (bf16_t)(cvtpk(acc[r], 0.f) & 0xffffu);
#pragma unroll
        for (int r = 0; r < 16; ++r) acc[r] *= cdec;
        float f[8];
#pragma unroll
        for (int jj = 0; jj < 8; ++jj) f[jj] = base[jj];
#pragma unroll
        for (int ks = 0; ks < 8; ++ks) {
            float v[8]; unpack8(va[ks], v);
#pragma unroll
            for (int jj = 0; jj < 8; ++jj) { v[jj] *= f[jj]; f[jj] *= step; }
            const bf16x8 a = __builtin_bit_cast(bf16x8, pack8(v));
            const bf16x8 bq = __builtin_bit_cast(bf16x8, kb[ks]);
            if (more) { va[ks] = *(const u32x4*)(Vt + (size_t)cn * 16384 + ks * 512); kb[ks] = *(const u32x4*)(Kt + (size_t)cn * 16384 + ks * 512); }
            acc = MFMA32(a, bq, acc);
        }
    }
    if (!LAT) {
        float* o = p.out + (dir ? O_CB : O_CF) + (size_t)sh * 16384;
#pragma unroll
        for (int r = 0; r < 16; ++r) o[(size_t)(db * 32 + i) * 128 + eb * 32 + crow(r, hi)] = acc[r];
    }
}

template <bool LAT>
__device__ __forceinline__ void retout_unit(const Params& p, int u, int lane) {
    unsigned char* ws = p.ws;
    constexpr int NS = LAT ? 4096 : 256, NCH = LAT ? 32 : 2;
    const bf16_t* Z = (const bf16_t*)(ws + WS_Z); bf16_t* Y = (bf16_t*)(ws + WS_XN);
    const int ib = u & 3, c = (u >> 2) % NCH, sh = (u >> 2) / NCH, h = sh & 3, seq = sh >> 2;
    const int i = lane & 31, hi = lane >> 5;
    const int pi = (i & 0x13) | ((i & 4) << 1) | ((i & 8) >> 1);
    const size_t tok0 = LAT ? (size_t)NCTXTOK + (size_t)seq * 4096 + c * 128 : (size_t)seq * 256 + c * 128;
    const int iloc = ib * 32 + i;
    const bf16_t* zq = Z + (tok0 + iloc) * PZ + h * 128;
    bf16x8 qf[8];
#pragma unroll
    for (int kk = 0; kk < 8; ++kk) qf[kk] = *(const bf16x8*)(zq + 16 * kk + 8 * hi);
    const float lgf2 = -expf(p.in[I_DECF][h]) * LOG2E, lgb2 = -expf(p.in[I_DECB][h]) * LOG2E;
    const bf16_t* Vt = (const bf16_t*)(ws + (LAT ? L1_VTL : L1_VTC)) + (size_t)sh * 128 * NS + (size_t)c * 16384;
    const bf16_t* SF = (const bf16_t*)(ws + (LAT ? L1_STF_L : L1_STF_C)) + ((size_t)sh * NCH + c) * 16384;
    const bf16_t* SB = (const bf16_t*)(ws + (LAT ? L1_STB_L : L1_STB_C)) + ((size_t)sh * NCH + c) * 16384;
    const char* zkU = LAT ? (const char*)(ws + kf_base(sh)) + (size_t)c * 32768 : (const char*)(Z + tok0 * PZ + 512 + h * 128);
    const unsigned zkL = LAT ? (unsigned)lane * 16u : (unsigned)(pi * PZ + 8 * hi) * 2u;
    constexpr unsigned kjs = LAT ? 8192u : (unsigned)(32 * PZ * 2), kks = LAT ? 1024u : 32u;
    const char* vtU = (const char*)Vt;
    const unsigned vtL = (unsigned)lane * 16u;
    const char* sfU = (const char*)SF; const char* sbU = (const char*)SB;
    const unsigned sL = (unsigned)lane * 16u;
    f32x16 O[4];
#pragma unroll
    for (int eb = 0; eb < 4; ++eb)
#pragma unroll
        for (int r = 0; r < 16; ++r) O[eb][r] = 0.f;
    bf16x8 fa[8], fb[8];
#pragma unroll
    for (int kk = 0; kk < 8; ++kk) fa[kk] = *(const bf16x8*)(zkU + kk * kks + zkL);
#pragma unroll
    for (int q = 0; q < 8; ++q) fb[q] = *(const bf16x8*)(vtU + (size_t)((q >> 1) * 8192 + (q & 1) * 1024) + vtL);
#pragma unroll 1
    for (int jb = 0; jb < 4; ++jb) {
        const bool lastj = (jb == 3);
        const char* nA = lastj ? sfU : zkU + (size_t)(jb + 1) * kjs;
        const unsigned nAL = lastj ? sL : zkL;
        const char* nB = lastj ? sbU : vtU + (size_t)2048 * (jb + 1);
        const unsigned nBL = lastj ? sL : vtL;
        const unsigned qs1 = 1024u, qs2 = lastj ? 2048u : 8192u;
        const unsigned kst = lastj ? 1024u : kks;
        f32x16 s;
#pragma unroll
        for (int r = 0; r < 16; ++r) s[r] = 0.f;
#pragma unroll
        for (int kk = 0; kk < 8; ++kk) {
            s = MFMA32(fa[kk], qf[kk], s);
            fa[kk] = *(const bf16x8*)(nA + (size_t)(kk * kst) + nAL);
        }
#pragma unroll
        for (int r = 0; r < 16; ++r) {
            const int j = 32 * jb + 16 * (r >> 3) + 8 * hi + (r & 7);
            const int dl = iloc - j;
            const float w = dl >= 0 ? fexp2(lgf2 * (float)dl) : fexp2(lgb2 * (float)(-dl - 1));
            s[r] *= w * KSCALE_C;
        }
        u32x4 w0, w1;
        w0.x = cvtpk(s[0], s[1]); w0.y = cvtpk(s[2], s[3]); w0.z = cvtpk(s[4], s[5]); w0.w = cvtpk(s[6], s[7]);
        w1.x = cvtpk(s[8], s[9]); w1.y = cvtpk(s[10], s[11]); w1.z = cvtpk(s[12], s[13]); w1.w = cvtpk(s[14], s[15]);
        const bf16x8 p0 = __builtin_bit_cast(bf16x8, w0), p1 = __builtin_bit_cast(bf16x8, w1);
#pragma unroll
        for (int q = 0; q < 8; ++q) {
            O[q >> 1] = MFMA32(fb[q], (q & 1) ? p1 : p0, O[q >> 1]);
            fb[q] = *(const bf16x8*)(nB + (size_t)((q & 1) * qs1 + (q >> 1) * qs2) + nBL);
        }
    }
    const float wf = fexp2(lgf2 * (float)(iloc + 1)), wb = fexp2(lgb2 * (float)(127 - iloc));
#pragma unroll 1
    for (int eb = 0; eb < 4; ++eb) {
        const int ebn = eb < 3 ? eb + 1 : 3;
        const char* nA = sfU + (size_t)ebn * 8192; const char* nB = sbU + (size_t)ebn * 8192;
        f32x16 xf, xb;
#pragma unroll
        for (int r = 0; r < 16; ++r) { xf[r] = 0.f; xb[r] = 0.f; }
#pragma unroll
        for (int kk = 0; kk < 8; ++kk) {
            xf = MFMA32(fa[kk], qf[kk], xf);
            fa[kk] = *(const bf16x8*)(nA + 1024 * kk + sL);
            xb = MFMA32(fb[kk], qf[kk], xb);
            fb[kk] = *(const bf16x8*)(nB + 1024 * kk + sL);
        }
#pragma unroll
        for (int e2 = 0; e2 < 4; ++e2)
            if (e2 == eb) {
#pragma unroll
                for (int r = 0; r < 16; ++r) O[e2][r] += wf * xf[r] + wb * xb[r];
            }
    }
    float sum = 0.f;
#pragma unroll
    for (int eb = 0; eb < 4; ++eb)
#pragma unroll
        for (int r = 0; r < 16; ++r) sum += O[eb][r];
    sum += __shfl_xor(sum, 32);
    const float mu = sum * (1.0f / 128.0f);
    float var = 0.f;
#pragma unroll
    for (int eb = 0; eb < 4; ++eb)
#pragma unroll
        for (int r = 0; r < 16; ++r) { O[eb][r] -= mu; var += O[eb][r] * O[eb][r]; }
    var += __shfl_xor(var, 32);
    const float rinv = rsqrtf(var * (1.0f / 128.0f) + EPS);
    const float* cng = p.in[I_CNG] + h * 128;
#pragma unroll
    for (int eb = 0; eb < 4; ++eb)
#pragma unroll
        for (int g = 0; g < 4; ++g) {
            const f32x4 gg = *(const f32x4*)(cng + 32 * eb + 8 * g + 4 * hi);
            O[eb][4 * g] *= rinv * gg.x; O[eb][4 * g + 1] *= rinv * gg.y; O[eb][4 * g + 2] *= rinv * gg.z; O[eb][4 * g + 3] *= rinv * gg.w;
        }
    const size_t tok = tok0 + iloc;
    write_y<4>(O, Z + tok * PZ + 2304 + h * 128, Y + tok * DM + h * 128, hi);
}

template <bool LAT>
__device__ __forceinline__ void retout_block(const Params& p, int sh, int c, unsigned char* lds, int tid) {
    unsigned char* ws = p.ws;
    constexpr int NS = LAT ? 4096 : 256, NCH = LAT ? 32 : 2;
    constexpr int KL = 0, VL = 34816, SFL = VL + 32768, SBL = SFL + 32768, RED = SBL + 32768;
    const bf16_t* Z = (const bf16_t*)(ws + WS_Z); bf16_t* Y = (bf16_t*)(ws + WS_XN);
    const int h = sh & 3, seq = sh >> 2;
    const int lane = tid & 63, wave = tid >> 6, i = lane & 31, hi = lane >> 5, ib = wave & 3, eh = wave >> 2;
    const int pi = (i & 0x13) | ((i & 4) << 1) | ((i & 8) >> 1);
    const size_t tok0 = LAT ? (size_t)NCTXTOK + (size_t)seq * 4096 + c * 128 : (size_t)seq * 256 + c * 128;
    const int iloc = ib * 32 + i;
    {
        const bf16_t* ksrc = Z + (tok0 + (tid >> 2)) * PZ + 512 + h * 128 + (tid & 3) * 32;
        const char* vsrc = (const char*)((const bf16_t*)(ws + (LAT ? L1_VTL : L1_VTC)) + (size_t)sh * 128 * NS + (size_t)c * 16384);
        const char* fsrc = (const char*)((const bf16_t*)(ws + (LAT ? L1_STF_L : L1_STF_C)) + ((size_t)sh * NCH + c) * 16384);
        const char* bsrc = (const char*)((const bf16_t*)(ws + (LAT ? L1_STB_L : L1_STB_C)) + ((size_t)sh * NCH + c) * 16384);
        u32x4 kr[4], vr[4], fr[4], br[4];
#pragma unroll
        for (int q = 0; q < 4; ++q) {
            kr[q] = *(const u32x4*)(ksrc + q * 8);
            vr[q] = *(const u32x4*)(vsrc + (size_t)(tid + 512 * q) * 16);
            fr[q] = *(const u32x4*)(fsrc + (size_t)(tid + 512 * q) * 16);
            br[q] = *(const u32x4*)(bsrc + (size_t)(tid + 512 * q) * 16);
        }
        __syncthreads();
#pragma unroll
        for (int q = 0; q < 4; ++q) {
            *(u32x4*)(lds + KL + (tid >> 2) * 272 + (tid & 3) * 64 + q * 16) = kr[q];
            *(u32x4*)(lds + VL + (tid + 512 * q) * 16) = vr[q];
            *(u32x4*)(lds + SFL + (tid + 512 * q) * 16) = fr[q];
            *(u32x4*)(lds + SBL + (tid + 512 * q) * 16) = br[q];
        }
    }
    bf16x8 qf[8];
    {
        const bf16_t* zq = Z + (tok0 + iloc) * PZ + h * 128;
#pragma unroll
        for (int kk = 0; kk < 8; ++kk) qf[kk] = *(const bf16x8*)(zq + 16 * kk + 8 * hi);
    }
    const float lgf2 = -expf(p.in[I_DECF][h]) * LOG2E, lgb2 = -expf(p.in[I_DECB][h]) * LOG2E;
    __syncthreads();
    f32x16 O[2];
#pragma unroll
    for (int e2 = 0; e2 < 2; ++e2)
#pragma unroll
        for (int r = 0; r < 16; ++r) O[e2][r] = 0.f;
    const unsigned char* kbase = lds + KL + pi * 272 + hi * 16;
    const unsigned char* vbase = lds + VL + (2 * eh) * 8192 + lane * 16;
#pragma unroll 1
    for (int jb = 0; jb < 4; ++jb) {
        f32x16 s;
#pragma unroll
        for (int r = 0; r < 16; ++r) s[r] = 0.f;
#pragma unroll
        for (int kk = 0; kk < 8; ++kk) s = MFMA32(*(const bf16x8*)(kbase + jb * 32 * 272 + kk * 32), qf[kk], s);
#pragma unroll
        for (int r = 0; r < 16; ++r) {
            const int j = 32 * jb + 16 * (r >> 3) + 8 * hi + (r & 7);
            const int dl = iloc - j;
            const float w = dl >= 0 ? fexp2(lgf2 * (float)dl) : fexp2(lgb2 * (float)(-dl - 1));
            s[r] *= w * KSCALE_C;
        }
        u32x4 w0, w1;
        w0.x = cvtpk(s[0], s[1]); w0.y = cvtpk(s[2], s[3]); w0.z = cvtpk(s[4], s[5]); w0.w = cvtpk(s[6], s[7]);
        w1.x = cvtpk(s[8], s[9]); w1.y = cvtpk(s[10], s[11]); w1.z = cvtpk(s[12], s[13]); w1.w = cvtpk(s[14], s[15]);
        const bf16x8 p0 = __builtin_bit_cast(bf16x8, w0), p1 = __builtin_bit_cast(bf16x8, w1);
#pragma unroll
        for (int e2 = 0; e2 < 2; ++e2) {
            O[e2] = MFMA32(*(const bf16x8*)(vbase + e2 * 8192 + jb * 2048), p0, O[e2]);
            O[e2] = MFMA32(*(const bf16x8*)(vbase + e2 * 8192 + jb * 2048 + 1024), p1, O[e2]);
        }
    }
    const float wf = fexp2(lgf2 * (float)(iloc + 1)), wb = fexp2(lgb2 * (float)(127 - iloc));
#pragma unroll
    for (int e2 = 0; e2 < 2; ++e2) {
        f32x16 xf, xb;
#pragma unroll
        for (int r = 0; r < 16; ++r) { xf[r] = 0.f; xb[r] = 0.f; }
        const unsigned char* sf = lds + SFL + (2 * eh + e2) * 8192 + lane * 16;
        const unsigned char* sb = lds + SBL + (2 * eh + e2) * 8192 + lane * 16;
#pragma unroll
        for (int kk = 0; kk < 8; ++kk) {
            xf = MFMA32(*(const bf16x8*)(sf + kk * 1024), qf[kk], xf);
            xb = MFMA32(*(const bf16x8*)(sb + kk * 1024), qf[kk], xb);
        }
#pragma unroll
        for (int r = 0; r < 16; ++r) O[e2][r] += wf * xf[r] + wb * xb[r];
    }
    float s1 = 0.f, s2 = 0.f;
#pragma unroll
    for (int e2 = 0; e2 < 2; ++e2)
#pragma unroll
        for (int r = 0; r < 16; ++r) { s1 += O[e2][r]; s2 += O[e2][r] * O[e2][r]; }
    s1 += __shfl_xor(s1, 32); s2 += __shfl_xor(s2, 32);
    float* red = (float*)(lds + RED);
    if (hi == 0) { red[(eh * 128 + iloc) * 2] = s1; red[(eh * 128 + iloc) * 2 + 1] = s2; }
    __syncthreads();
    {
        const float o1 = red[((1 - eh) * 128 + iloc) * 2], o2 = red[((1 - eh) * 128 + iloc) * 2 + 1];
        s1 += o1; s2 += o2;
    }
    const float mu = s1 * (1.0f / 128.0f);
    const float var = fmaxf(s2 * (1.0f / 128.0f) - mu * mu, 0.f);
    const float rinv = rsqrtf(var + EPS);
    const float* cng = p.in[I_CNG] + h * 128 + 64 * eh;
#pragma unroll
    for (int e2 = 0; e2 < 2; ++e2)
#pragma unroll
        for (int g = 0; g < 4; ++g) {
            const f32x4 gg = *(const f32x4*)(cng + 32 * e2 + 8 * g + 4 * hi);
            O[e2][4 * g] = (O[e2][4 * g] - mu) * rinv * gg.x; O[e2][4 * g + 1] = (O[e2][4 * g + 1] - mu) * rinv * gg.y;
            O[e2][4 * g + 2] = (O[e2][4 * g + 2] - mu) * rinv * gg.z; O[e2][4 * g + 3] = (O[e2][4 * g + 3] - mu) * rinv * gg.w;
        }
    const size_t tok = tok0 + iloc;
    write_y<2>(O, Z + tok * PZ + 2304 + h * 128 + 64 * eh, Y + tok * DM + h * 128 + 64 * eh, hi);
}

__global__ void __launch_bounds__(512) mega_fwd(Params p) {
    extern __shared__ __attribute__((aligned(16))) unsigned char lds[];
    cg::grid_group grid = cg::this_grid();
    const int blk = blockIdx.x, G = gridDim.x;
    const int vb = (G % 8 == 0) ? (blk % 8) * (G / 8) + blk / 8 : blk;
    const int NGW = G * 8;
    unsigned char* ws = p.ws;
    bf16_t* XN = (bf16_t*)(ws + WS_XN); bf16_t* Zb = (bf16_t*)(ws + WS_Z);
    const float* mod0 = (const float*)(ws + WS_MOD); const float* mod1 = mod0 + 9 * 3072;
    LAS unsigned char* lds3 = (LAS unsigned char*)lds;
#define FRESH() int tid = threadIdx.x; asm volatile("" : "+v"(tid)); const int lane = tid & 63, wave = __builtin_amdgcn_readfirstlane(tid >> 6), gw = blk * 8 + wave; (void)lane; (void)gw;

    unsigned* barw = (unsigned*)(ws + WS_BAR);
    volatile LAS unsigned* bst = (volatile LAS unsigned*)(lds3 + LDS_BAR);
    if (threadIdx.x < 2) bst[threadIdx.x] = 0u;
    if (blk == 0) for (int w = threadIdx.x; w < XCD_BAR_WORDS; w += 512) barw[w] = 0u;
    __syncthreads();
    for (int rs_ = 0; rs_ < REP_SM; ++rs_) { FRESH(); phase0(p, lds, tid, blk, G); __syncthreads(); }
    grid.sync();
    XcdBarrier bar = xcd_barrier_post(barw, bst);
#define GSYNC() xcd_barrier(bar)
    for (int rs_ = 0; rs_ < REP_SM; ++rs_) { FRESH(); adaln_rows(p.in[I_XP], p.in[I_XS], p.in[I_NORMG], mod0, XN, gw, NGW, lane); }
    GSYNC();
    for (int rg_ = 0; rg_ < REP_G2; ++rg_) {
        pg8::Gemm g{XN, (const bf16_t*)(ws + WS_WIN_AB), MTOT, PZ, DM}; pg8::StaticOrder S; S.init(MTOT, PZ, G, blk);
        pg8::EpiBf16<0> E{Zb, PZ, nullptr, 0, 0, 1.f};
        pg8::gemm_phase<pg8::EpiBf16<0>, pg8::StaticOrder, true, true>(lds3, g, S, E);
    }
    GSYNC();
    for (int rs_ = 0; rs_ < REP_PREP; ++rs_) { FRESH(); prep_layer0(p, lds, tid, blk, G); }
    GSYNC();
    for (int rep_ = 0; rep_ < REP_P4; ++rep_) {
        if (PHM & 16) { FRESH(); for (int u = vb; u < 512; u += G) unit_B<true>(p, u, lds, tid); }
        for (int ra_ = 0; ra_ < REP_A; ++ra_) { FRESH(); for (int u = vb; u < 512; u += G) unit_A2(p, u, lds, tid); }
        if (PHM & 64) { FRESH(); for (int u = vb; u < 128; u += G) unit_A<false>(p, u, lds, tid); }
        if (PHM & 128) { FRESH(); for (int u = (vb + 8 * G - 128) % G; u < 64; u += G) unit_B<false>(p, u, lds, tid); }
    }
    GSYNC();
    if (PHM & 256) {
        pg8::Gemm g{XN, (const bf16_t*)(ws + WS_WOUT_AB), MTOT, DM, DM}; pg8::StaticOrder S; S.init(MTOT, DM, G, blk);
        EpiResid E{p.in[I_XP], p.in[I_XS], p.out, mod0};
        pg8::gemm_phase<EpiResid, pg8::StaticOrder, true, true>(lds3, g, S, E);
    }
    GSYNC();
    for (int rs_ = 0; rs_ < REP_SM; ++rs_) { FRESH(); adaln_rows(p.out, p.out + (size_t)NCTXTOK * DM, p.in[I_NORMG] + DM, mod1, XN, gw, NGW, lane); }
    GSYNC();
    {
        pg8::Gemm g{XN, (const bf16_t*)(ws + WS_WIN_CD), MTOT, PZ, DM}; pg8::StaticOrder S; S.init(MTOT, PZ, G, blk);
        pg8::EpiBf16<0> E{Zb, PZ, nullptr, 0, 0, 1.f};
        pg8::gemm_phase<pg8::EpiBf16<0>, pg8::StaticOrder, true, true>(lds3, g, S, E);
    }
    GSYNC();
    for (int rs_ = 0; rs_ < REP_PREP; ++rs_) { FRESH(); prep_layer1(p, lds, tid, blk, G); }
    GSYNC();
    for (int rs_ = 0; rs_ < REP_SCAN; ++rs_) {
        FRESH(); const int sw = wave * G + blk;
        for (int u = sw; u < 1024 + 2048; u += NGW) { if (u < 1024) scan_unit<true>(p, u, lane); else scan_unit<false>(p, u - 1024, lane); }
    }
    GSYNC();
    for (int rep_ = 0; rep_ < REP_P10; ++rep_) {
        if (PHM & 2048) { FRESH(); for (int u = vb; u < 512; u += G) unit_D2(p, u, lds, tid); }
        if (PHM & 2048) { FRESH(); for (int u = (vb + 8 * G - 128) % G; u < 128; u += G) unit_D<false>(p, u, lds, tid); }
        for (int rr_ = 0; rr_ < REP_RET; ++rr_) { FRESH();
            for (int u = vb; u < 1152; u += G) { if (u < 1024) retout_block<true>(p, u >> 5, u & 31, lds, tid); else retout_block<false>(p, (u - 1024) >> 1, (u - 1024) & 1, lds, tid); }
            __syncthreads(); }
    }
    GSYNC();
    {
        pg8::Gemm g{XN, (const bf16_t*)(ws + WS_WOUT_CD), MTOT, DM, DM}; pg8::StaticOrder S; S.init(MTOT, DM, G, blk);
        EpiResid E{p.out, p.out + (size_t)NCTXTOK * DM, p.out, mod1};
        pg8::gemm_phase<EpiResid, pg8::StaticOrder, true, true>(lds3, g, S, E);
    }
    GSYNC();
    { FRESH(); final_rows(p.out, p.in[I_FING], gw, NGW, lane); }
}

extern "C" void kernel_launch(void* const* d_in, const int* in_sizes, int n_in, void* d_out, int out_size, void* d_ws, size_t ws_size, hipStream_t stream) {
    static int grid = 0;
    if (grid == 0) {
        if (n_in != 31 || (size_t)out_size != O_END || ws_size < WS_NEED) {
            fprintf(stderr, "kernel_launch: unexpected problem: n_in %d out %d ws %zu (need %zu)\n", n_in, out_size, ws_size, (size_t)WS_NEED); grid = -1; return; }
        int dev = 0, cus = 0, per_cu = 0;
        hipGetDevice(&dev);
        hipDeviceGetAttribute(&cus, hipDeviceAttributeMultiprocessorCount, dev);
        if (hipFuncSetAttribute((const void*)mega_fwd, hipFuncAttributeMaxDynamicSharedMemorySize, LDS_BYTES) != hipSuccess) { fprintf(stderr, "kernel_launch: hipFuncSetAttribute failed\n"); }
        if (hipOccupancyMaxActiveBlocksPerMultiprocessor(&per_cu, (const void*)mega_fwd, 512, LDS_BYTES) != hipSuccess || per_cu < 1) { fprintf(stderr, "kernel_launch: occupancy query gave %d\n", per_cu); per_cu = 1; }
        (void)hipGetLastError();
        if (per_cu > 1) per_cu = 1;
        grid = cus * per_cu;
    }
    if (grid < 0) return;
    Params p{};
    for (int i = 0; i < 31; ++i) p.in[i] = (const float*)d_in[i];
    p.out = (float*)d_out; p.ws = (unsigned char*)d_ws;
    void* args[] = {&p};
    hipError_t e = hipLaunchCooperativeKernel((const void*)mega_fwd, dim3(grid), dim3(512), args, LDS_BYTES, stream);
    if (e != hipSuccess) fprintf(stderr, "kernel_launch: cooperative launch failed: %s (grid %d)\n", hipGetErrorString(e), grid);
}
```

```cpp
#include <hip/hip_runtime.h>
#include <hip/hip_cooperative_groups.h>
#include <cstdio>
#include <cstdint>
namespace cg = cooperative_groups;
namespace pg8 {
#define PG8_LAS __attribute__((address_space(3)))
typedef unsigned short bf16_t;
typedef short bf16x8 __attribute__((ext_vector_type(8)));
typedef float f32x4 __attribute__((ext_vector_type(4)));
typedef unsigned u32x4 __attribute__((ext_vector_type(4)));
constexpr int BM = 256, BK = 64, HALF = 128, HTB = HALF * BK * 2  , STAGE_BYTES = 8 * HTB, NXCD = 8, WGM = 8;

__host__ __device__ __forceinline__ int lds_byte(int r, int c) { const int st = (r >> 4) * 2 + (c >> 5), rr = r & 15, cc = c & 31, ob = rr * 64 + cc * 2; return st * 1024 + (ob ^ (((ob >> 9) & 1) << 5)); }
__host__ __device__ __forceinline__ void stage_rc(int b, int& R, int& C) { const int st = b / 1024, sb = b % 1024, swz = sb ^ (((sb >> 9) & 1) << 5); R = (st >> 1) * 16 + swz / 64; C = (st & 1) * 32 + (swz % 64) / 2; }
__host__ __device__ __forceinline__ int perm32(int rho) { const int n = rho >> 4, i = rho & 15; return 8 * (i >> 2) + 4 * n + (i & 3); }

struct Unit { int pm, pn; };
struct Gemm { const bf16_t* A; const bf16_t* Bt; int M, N, K; };

struct StaticOrder {
    int nM, nN, nwg, G, c;
    __host__ __device__ void init(int M, int N, int G_, int c_) { nM = M / BM; nN = N / BM; nwg = nM * nN; G = G_; c = c_; }
    __host__ __device__ bool next(int i, Unit& u) const {
        const long L = (long)i * G + c; if (L >= nwg) return false;
        int wgid = (int)L; { const int q = nwg / NXCD, r = nwg % NXCD, xcd = wgid % NXCD, off = wgid / NXCD; wgid = (xcd < r ? xcd * (q + 1) : r * (q + 1) + (xcd - r) * q) + off; }
        const int nig = WGM * nN, gid = wgid / nig, fm = gid * WGM, gsz = (nM - fm) < WGM ? (nM - fm) : WGM;
        u.pm = fm + ((wgid % nig) % gsz); u.pn = (wgid % nig) / gsz; return true;
    }
    __device__ __forceinline__ void a_ready(const Unit&) const {}
    __device__ __forceinline__ void done(const Unit&) const {}
};

__device__ __forceinline__ unsigned cvt_pk_bf16(float lo, float hi) { unsigned r; asm volatile("v_cvt_pk_bf16_f32 %0, %1, %2" : "=v"(r) : "v"(lo), "v"(hi)); return r; }
typedef float f32x2 __attribute__((ext_vector_type(2)));
__device__ __forceinline__ f32x2 gelu_pk(f32x2 v) {
    const f32x2 av = __builtin_elementwise_abs(v), d = av * 0.2316418882f + 1.0f;
    f32x2 t; t.x = __builtin_amdgcn_rcpf(d.x); t.y = __builtin_amdgcn_rcpf(d.y);
    f32x2 q = t * 0.5307027145f + (-0.7265760135f); q = q * t + 0.7107068705f; q = q * t + (-0.142248368f); q = q * t + 0.127414796f; q = q * t;
    const f32x2 s = (v * v) * (-0.72134752044f);
    f32x2 e; e.x = __builtin_amdgcn_exp2f(s.x); e.y = __builtin_amdgcn_exp2f(s.y);
    const f32x2 m = v * (q * e), r = v - m;
    f32x2 o; o.x = v.x < 0.f ? m.x : r.x; o.y = v.y < 0.f ? m.y : r.y; return o;
}

template <int ACT  > struct EpiBf16 {
    static constexpr bool PERM = true, AFTER_DRAIN = false; static_assert(ACT == 0 || ACT == 1, "EpiBf16: ACT is 0 (none) or 1 (gelu_pk)");
    bf16_t* O; int ldc; const float* bias; int split_cols; size_t split_stride; float scale0;
    __device__ __forceinline__ void operator()(const f32x4 (&acc)[2][2][4][2], const Unit& u, int wr, int wc, int fr, int fq) const {
        const int row0 = u.pm * BM + wr * 64 + fr; int colt = u.pn * BM; bf16_t* base = O;
        float sc = 1.f; if (split_cols) { const int t = colt / split_cols; base += (size_t)t * split_stride; colt -= t * split_cols; if (t == 0) sc = scale0; }
        const int col0 = colt + wc * 32 + 8 * fq, bcol0 = u.pn * BM + wc * 32 + 8 * fq;
        f32x4 bv[2][2];
#pragma unroll
        for (int bj = 0; bj < 2; ++bj)
#pragma unroll
            for (int n = 0; n < 2; ++n) bv[bj][n] = bias ? *(const f32x4*)(bias + bcol0 + bj * HALF + 4 * n) : (f32x4){0.f, 0.f, 0.f, 0.f};
#pragma unroll
        for (int ai = 0; ai < 2; ++ai)
#pragma unroll
            for (int m = 0; m < 4; ++m) { bf16_t* rowp = base + (size_t)(row0 + ai * HALF + m * 16) * ldc + col0;
#pragma unroll
                for (int bj = 0; bj < 2; ++bj) { f32x4 v0 = acc[ai][bj][m][0] + bv[bj][0], v1 = acc[ai][bj][m][1] + bv[bj][1];
                    if (ACT == 1) { f32x2 a = gelu_pk((f32x2){v0[0], v0[1]}), b = gelu_pk((f32x2){v0[2], v0[3]}), c = gelu_pk((f32x2){v1[0], v1[1]}), d = gelu_pk((f32x2){v1[2], v1[3]});
                        v0 = (f32x4){a.x, a.y, b.x, b.y}; v1 = (f32x4){c.x, c.y, d.x, d.y}; }
                    v0 = v0 * sc; v1 = v1 * sc; u32x4 w; w.x = cvt_pk_bf16(v0[0], v0[1]); w.y = cvt_pk_bf16(v0[2], v0[3]); w.z = cvt_pk_bf16(v1[0], v1[1]); w.w = cvt_pk_bf16(v1[2], v1[3]);
                    __builtin_nontemporal_store(w, (u32x4*)(rowp + bj * HALF)); } }
    }
};
template <class Epi, class Sched, bool ALIGN_EPI = false, bool SP2 = false>
__device__ __forceinline__ void gemm_phase(PG8_LAS unsigned char* lds, const Gemm g, const Sched& S, const Epi& E) {
    int tid_l = threadIdx.x; asm volatile("" : "+v"(tid_l));
    const int tid = tid_l, wid = __builtin_amdgcn_readfirstlane(tid >> 6), lane = tid & 63, wr = wid >> 2, wc = wid & 3, fr = lane & 15, fq = lane >> 4;
    const int K = g.K, nt = K / BK;
    unsigned voffA[2], voffB[2];
#pragma unroll
    for (int i = 0; i < 2; ++i) { int R, C; stage_rc(tid * 16 + i * 8192, R, C); const int Rb = Epi::PERM ? ((R & ~31) + perm32(R & 31)) : R;
        voffA[i] = (unsigned)(R * K + C) * 2u; voffB[i] = (unsigned)(Rb * K + C) * 2u; }
    const size_t kstep = (size_t)(BK * 2);
    const size_t hstep = (size_t)HALF * K * 2;
    const size_t tstep = 2 * hstep;
    const unsigned ldsw = (unsigned)wid * 1024u;
    const int aoff = lds_byte(wr * 64 + fr, fq * 8), boff = lds_byte(wc * 32 + fr, fq * 8);
#define PG8_SA(b, h) (((b) * 2 + (h)) * HTB)
#define PG8_SB(b, h) ((4 + (b) * 2 + (h)) * HTB)
#define PG8_STAGE(bufoff, gbase, voff) do { _Pragma("unroll") for (int _i = 0; _i < 2; ++_i) \
        __builtin_amdgcn_global_load_lds((const unsigned*)((const char*)(gbase) + (voff)[_i]), (PG8_LAS unsigned*)(lds + (bufoff) + ldsw + _i * 8192), 16, 0, 0); } while (0)
#define PG8_LDA(dst, b, h) do { _Pragma("unroll") for (int m = 0; m < 4; ++m) _Pragma("unroll") for (int k = 0; k < 2; ++k) dst[m][k] = *(const PG8_LAS bf16x8*)(lds + PG8_SA(b, h) + aoff + m * 2048 + k * 1024); } while (0)
#define PG8_LDB(dst, b, h) do { _Pragma("unroll") for (int n = 0; n < 2; ++n) _Pragma("unroll") for (int k = 0; k < 2; ++k) dst[n][k] = *(const PG8_LAS bf16x8*)(lds + PG8_SB(b, h) + boff + n * 2048 + k * 1024); } while (0)
#define PG8_MMA(ai, bj, At, Bt) do { __builtin_amdgcn_s_setprio(1); _Pragma("unroll") for (int m = 0; m < 4; ++m) _Pragma("unroll") for (int n = 0; n < 2; ++n) _Pragma("unroll") for (int k = 0; k < 2; ++k) \
        acc[ai][bj][m][n] = __builtin_amdgcn_mfma_f32_16x16x32_bf16(Bt[n][k], At[m][k], acc[ai][bj][m][n], 0, 0, 0); __builtin_amdgcn_s_setprio(0); } while (0)
#define PG8_WAIT_V(n) asm volatile("s_waitcnt vmcnt(" #n ")" ::: "memory")
#define PG8_WAIT_L(n) asm volatile("s_waitcnt lgkmcnt(" #n ")" ::: "memory")
#define PG8_BAR __builtin_amdgcn_s_barrier()
#define PG8_SCHED __builtin_amdgcn_sched_barrier(0)
    Unit cur, nxt; int ui = 0;
    if (!S.next(0, cur)) return;
    f32x4 acc[2][2][4][2];
#pragma unroll
    for (int a = 0; a < 2; ++a)
#pragma unroll
        for (int b = 0; b < 2; ++b)
#pragma unroll
            for (int m = 0; m < 4; ++m)
#pragma unroll
                for (int n = 0; n < 2; ++n) acc[a][b][m][n] = (f32x4){0.f, 0.f, 0.f, 0.f};
    bf16x8 At[4][2], B0[2][2], B1[2][2];
    const char* cA = (const char*)g.A + (size_t)cur.pm * tstep; const char* cB = (const char*)g.Bt + (size_t)cur.pn * tstep;
    S.a_ready(cur);
    if constexpr (SP2) {
        PG8_STAGE(PG8_SB(0, 0), cB, voffB); PG8_STAGE(PG8_SB(0, 1), cB + hstep, voffB); PG8_STAGE(PG8_SA(0, 0), cA, voffA); PG8_STAGE(PG8_SA(0, 1), cA + hstep, voffA);
        if (wr == 1) PG8_BAR;
        PG8_WAIT_V(2); PG8_BAR;
        PG8_STAGE(PG8_SB(1, 0), cB + kstep, voffB); PG8_STAGE(PG8_SA(1, 0), cA + kstep, voffA); PG8_STAGE(PG8_SB(1, 1), cB + hstep + kstep, voffB);
        PG8_WAIT_V(6); PG8_BAR;
    } else {
        PG8_STAGE(PG8_SB(0, 0), cB, voffB); PG8_STAGE(PG8_SA(0, 0), cA, voffA); PG8_STAGE(PG8_SB(0, 1), cB + hstep, voffB); PG8_STAGE(PG8_SA(0, 1), cA + hstep, voffA);
        if (wr == 1) PG8_BAR;
        PG8_WAIT_V(4); PG8_BAR;
        PG8_STAGE(PG8_SB(1, 0), cB + kstep, voffB); PG8_STAGE(PG8_SA(1, 0), cA + kstep, voffA); PG8_STAGE(PG8_SB(1, 1), cB + hstep + kstep, voffB);
        PG8_WAIT_V(6); PG8_BAR;
    }
    for (;;) {
        const bool has_next = S.next(ui + 1, nxt);
        const char* nA = has_next ? (const char*)g.A + (size_t)nxt.pm * tstep : cA; const char* nB = has_next ? (const char*)g.Bt + (size_t)nxt.pn * tstep : cB;
        for (int t = 0; t < nt; t += 2) {
            const bool last = (t == nt - 2);
            const char* a1 = cA + (size_t)(t + 1) * kstep;
            const char* a2 = last ? nA : cA + (size_t)(t + 2) * kstep; const char* b2 = last ? nB : cB + (size_t)(t + 2) * kstep;
            const char* a3 = a2 + kstep; const char* b3 = b2 + kstep;
            if (last && has_next) S.a_ready(nxt);
            if constexpr (SP2) {
            PG8_LDB(B0, 0, 0); PG8_LDB(B1, 0, 1); PG8_SCHED; PG8_LDA(At, 0, 0); PG8_STAGE(PG8_SA(1, 1), a1 + hstep, voffA);
            PG8_WAIT_V(8); PG8_WAIT_L(0); PG8_BAR; PG8_MMA(0, 0, At, B0); PG8_MMA(0, 1, At, B1); PG8_BAR; PG8_SCHED;
            PG8_LDA(At, 0, 1); PG8_STAGE(PG8_SB(0, 0), b2, voffB); PG8_STAGE(PG8_SB(0, 1), b2 + hstep, voffB); PG8_STAGE(PG8_SA(0, 0), a2, voffA);
            PG8_WAIT_V(8); PG8_WAIT_L(0); PG8_BAR; PG8_MMA(1, 0, At, B0); PG8_MMA(1, 1, At, B1); PG8_BAR; PG8_SCHED;
            PG8_LDB(B0, 1, 0); PG8_LDB(B1, 1, 1); PG8_SCHED; PG8_LDA(At, 1, 0); PG8_STAGE(PG8_SA(0, 1), a2 + hstep, voffA);
            PG8_WAIT_V(8); PG8_WAIT_L(0); PG8_BAR; PG8_MMA(0, 0, At, B0); PG8_MMA(0, 1, At, B1); PG8_BAR; PG8_SCHED;
            PG8_LDA(At, 1, 1); PG8_STAGE(PG8_SB(1, 0), b3, voffB); PG8_STAGE(PG8_SB(1, 1), b3 + hstep, voffB); PG8_STAGE(PG8_SA(1, 0), a3, voffA);
            PG8_WAIT_V(8); PG8_WAIT_L(0); PG8_BAR; PG8_MMA(1, 0, At, B0); PG8_MMA(1, 1, At, B1); PG8_BAR; PG8_SCHED;
            } else {
            PG8_LDB(B0, 0, 0); PG8_SCHED; PG8_LDA(At, 0, 0); PG8_STAGE(PG8_SA(1, 1), a1 + hstep, voffA);
            PG8_WAIT_L(8); PG8_BAR; PG8_WAIT_L(0); PG8_MMA(0, 0, At, B0); PG8_BAR; PG8_SCHED;
            PG8_LDB(B1, 0, 1); PG8_STAGE(PG8_SB(0, 0), b2, voffB);
            PG8_BAR; PG8_WAIT_L(0); PG8_MMA(0, 1, At, B1); PG8_BAR;
            PG8_LDA(At, 0, 1); PG8_STAGE(PG8_SA(0, 0), a2, voffA);
            PG8_BAR; PG8_WAIT_L(0); PG8_MMA(1, 0, At, B0); PG8_BAR; PG8_SCHED;
            PG8_STAGE(PG8_SB(0, 1), b2 + hstep, voffB);
            PG8_WAIT_V(6); PG8_BAR; PG8_MMA(1, 1, At, B1); PG8_BAR;
            PG8_LDB(B0, 1, 0); PG8_SCHED; PG8_LDA(At, 1, 0); PG8_STAGE(PG8_SA(0, 1), a2 + hstep, voffA);
            PG8_WAIT_L(8); PG8_BAR; PG8_WAIT_L(0); PG8_MMA(0, 0, At, B0); PG8_BAR; PG8_SCHED;
            PG8_LDB(B1, 1, 1); PG8_STAGE(PG8_SB(1, 0), b3, voffB);
            PG8_BAR; PG8_WAIT_L(0); PG8_MMA(0, 1, At, B1); PG8_BAR;
            PG8_LDA(At, 1, 1); PG8_STAGE(PG8_SA(1, 0), a3, voffA);
            PG8_BAR; PG8_WAIT_L(0); PG8_MMA(1, 0, At, B0); PG8_BAR; PG8_SCHED;
            PG8_STAGE(PG8_SB(1, 1), b3 + hstep, voffB);
            PG8_WAIT_V(6); PG8_BAR; PG8_MMA(1, 1, At, B1); PG8_BAR;
            }
        }
        if constexpr (ALIGN_EPI) { if (wr == 0) PG8_BAR; }
        if constexpr (!Epi::AFTER_DRAIN) { E(acc, cur, wr, wc, fr, fq); S.done(cur); }
        if (!has_next) break;
#pragma unroll
        for (int a = 0; a < 2; ++a)
#pragma unroll
            for (int b = 0; b < 2; ++b)
#pragma unroll
                for (int m = 0; m < 4; ++m)
#pragma unroll
                    for (int n = 0; n < 2; ++n) acc[a][b][m][n] = (f32x4){0.f, 0.f, 0.f, 0.f};
        cur = nxt; cA = nA; cB = nB; ++ui;
        if constexpr (ALIGN_EPI) { if (wr == 1) PG8_BAR; }
    }
    PG8_WAIT_V(0);
    if constexpr (!ALIGN_EPI) { if (wr == 0) PG8_BAR; }
    PG8_BAR;
    if constexpr (Epi::AFTER_DRAIN) { E.fused(acc, cur, wr, wc, fr, fq, lds, wid, lane); S.done(cur); }
#undef PG8_SA
#undef PG8_SB
#undef PG8_STAGE
#undef PG8_LDA
#undef PG8_LDB
#undef PG8_MMA
#undef PG8_WAIT_V
#undef PG8_WAIT_L
#undef PG8_BAR
#undef PG8_SCHED
}
}
#ifndef LAS
#define LAS __attribute__((address_space(3)))
#endif
#define XB_TMO      128
#define XB_XCNT(j)  (256  + 64 * (j))
#define XB_XSUB(j)  (1280 + 64 * (j))
#define XB_XGEN(j)  (2304 + 64 * (j))
#define XB_TOP      3328
#define XB_TOPGEN   3392
#define XCD_BAR_WORDS 3456
#define XB_SPIN_CAP (1u << 18)

__device__ __forceinline__ unsigned xb_ld(unsigned* p)              { return __hip_atomic_load(p, __ATOMIC_RELAXED, __HIP_MEMORY_SCOPE_AGENT); }
__device__ __forceinline__ unsigned xb_add(unsigned* p, unsigned v) { return __hip_atomic_fetch_add(p, v, __ATOMIC_RELAXED, __HIP_MEMORY_SCOPE_AGENT); }
__device__ __forceinline__ unsigned xb_xcc_id() { return (unsigned)__builtin_amdgcn_s_getreg((3 << 11) | 20) & 0xFu; }
#define XB_SPIN(cond, bar) do { unsigned _sp = 0; while (cond) { __builtin_amdgcn_s_sleep(1); \
    if ((++_sp & 255u) == 0u) { if (xb_ld(&(bar)[XB_TMO])) break; if (_sp > XB_SPIN_CAP) { atomicAdd(&(bar)[XB_TMO], 1u); break; } } } } while (0)

struct XcdBarrier {
    unsigned* bar; unsigned x;
    volatile LAS unsigned* st;
};

__device__ __forceinline__ XcdBarrier xcd_barrier_post(unsigned* bar, volatile LAS unsigned* st) {
    XcdBarrier b; b.bar = bar; b.x = xb_xcc_id(); b.st = st;
    if (threadIdx.x == 0) (void)xb_add(&bar[XB_XCNT(b.x)], 1u);
    return b;
}
__device__ __forceinline__ void xcd_barrier_complete(unsigned* bar, unsigned x, unsigned& nloc, unsigned& nx) {
    const unsigned G = gridDim.x * gridDim.y * gridDim.z;
    unsigned sum, cnt, mine, sp = 0u;
    for (;;) {
        sum = 0u; cnt = 0u; mine = 0u;
#pragma unroll
        for (unsigned j = 0; j < 16; ++j) { const unsigned c = xb_ld(&bar[XB_XCNT(j)]); sum += c; cnt += (c > 0u) ? 1u : 0u; mine = (j == x) ? c : mine; }
        if (sum == G) break;
        __builtin_amdgcn_s_sleep(1);
        if ((++sp & 255u) == 0u) { if (xb_ld(&bar[XB_TMO])) break; if (sp > XB_SPIN_CAP) { atomicAdd(&bar[XB_TMO], 1u); break; } }
    }
    nloc = mine > 0u ? mine : 1u; nx = cnt > 0u ? cnt : 1u;
}

__device__ __forceinline__ void xcd_barrier(const XcdBarrier& b) {
    asm volatile("s_waitcnt vmcnt(0)" ::: "memory");
    __syncthreads();
    if (threadIdx.x == 0) {
        unsigned* bar = b.bar;
        __builtin_amdgcn_s_waitcnt(0);
        unsigned nloc = b.st[0], nx = b.st[1];
        if (nloc == 0u) { xcd_barrier_complete(bar, b.x, nloc, nx); b.st[0] = nloc; b.st[1] = nx; }
        const unsigned old = xb_add(&bar[XB_XSUB(b.x)], 1u);
        const unsigned gen = old / nloc;
        if (old + 1u == (gen + 1u) * nloc) {
            __builtin_amdgcn_fence(__ATOMIC_RELEASE, "agent");
            asm volatile("s_waitcnt vmcnt(0)" ::: "memory");
            const unsigned og = xb_add(&bar[XB_TOP], 1u);
            const unsigned tg = og / nx;
            if (og + 1u == (tg + 1u) * nx) xb_add(&bar[XB_TOPGEN], 1u);
            else XB_SPIN(xb_ld(&bar[XB_TOPGEN]) == tg, bar);
            __builtin_amdgcn_fence(__ATOMIC_ACQUIRE, "agent");
            xb_add(&bar[XB_XGEN(b.x)], 1u);
            asm volatile("s_waitcnt vmcnt(0)" ::: "memory");
        } else {
            XB_SPIN(xb_ld(&bar[XB_XGEN(b.x)]) == gen, bar);
            __builtin_amdgcn_fence(__ATOMIC_ACQUIRE, "agent");
            asm volatile("s_waitcnt vmcnt(0)" ::: "memory");
        }
    }
    __syncthreads();
}

typedef unsigned short bf16_t;
typedef short bf16x8 __attribute__((ext_vector_type(8)));
typedef float f32x4 __attribute__((ext_vector_type(4)));
typedef float f32x16 __attribute__((ext_vector_type(16)));
typedef unsigned u32x4 __attribute__((ext_vector_type(4)));
typedef unsigned u32x2 __attribute__((ext_vector_type(2)));
#define LAS __attribute__((address_space(3)))

constexpr int DM = 1024, MTOT = 36864, NCTXTOK = 4096, PZ = 3328;
constexpr int NKL = 4352;
constexpr float LOG2E = 1.4426950408889634f;
constexpr float QSCALE = 0.125f * LOG2E;
constexpr float EPS = 1e-6f;
constexpr float KSCALE_C = 0.08838834764831845f;

constexpr size_t O_YP = 0, O_YS = 4194304, O_AK = 37748736, O_AV = 38273024, O_BK = 38797312, O_BV = 40894464,
                 O_CF = 42991616, O_CB = 44040192, O_DK = 45088768, O_DV = 45613056, O_END = 46137344;

constexpr size_t MiB = 1u << 20;
constexpr size_t WS_MOD = 0;
constexpr size_t WS_ROPE = 256 * 1024;
constexpr size_t WS_LAM = 300 * 1024;
constexpr size_t WS_BAR = 512 * 1024;
constexpr size_t WS_WIN_AB = 1 * MiB, WS_WOUT_AB = 8 * MiB, WS_WIN_CD = 10 * MiB, WS_WOUT_CD = 17 * MiB;
constexpr size_t WS_XN = 20 * MiB;
constexpr size_t WS_Z = 92 * MiB;
constexpr size_t WS_KV = 326 * MiB;
constexpr size_t L0_KA_LAT = WS_KV;
constexpr size_t L0_VTA_LAT = L0_KA_LAT + 8912896;
constexpr size_t L0_KB1_LAT = L0_VTA_LAT + 8912896;
constexpr size_t L0_KB2_LAT = L0_KB1_LAT + 17825792;
constexpr size_t L0_VTB_LAT = L0_KB2_LAT + 17825792;
constexpr size_t L0_KA_CTX = L0_VTB_LAT + 35651584;
constexpr size_t L0_VTA_CTX = L0_KA_CTX + 1 * MiB;
constexpr size_t L0_KB1_CTX = L0_VTA_CTX + 1 * MiB;
constexpr size_t L0_KB2_CTX = L0_KB1_CTX + 2 * MiB;
constexpr size_t L0_VTB_CTX = L0_KB2_CTX + 2 * MiB;
constexpr size_t L0_END = L0_VTB_CTX + 4 * MiB;
constexpr size_t L1_KTL = WS_KV;
constexpr size_t L1_VTL = L1_KTL + 32 * MiB;
constexpr size_t L1_KTC = L1_VTL + 32 * MiB;
constexpr size_t L1_VTC = L1_KTC + 4 * MiB;
constexpr size_t L1_KD_LAT = L1_VTC + 4 * MiB;
constexpr size_t L1_VTD_LAT = L1_KD_LAT + 8912896;
constexpr size_t L1_KD_CTX = L1_VTD_LAT + 8912896;
constexpr size_t L1_VTD_CTX = L1_KD_CTX + 1 * MiB;
constexpr size_t L1_STF_L = L1_VTD_CTX + 1 * MiB;
constexpr size_t L1_STB_L = L1_STF_L + 32 * MiB;
constexpr size_t L1_STF_C = L1_STB_L + 32 * MiB;
constexpr size_t L1_STB_C = L1_STF_C + 4 * MiB;
constexpr size_t L1_END = L1_STB_C + 4 * MiB;
constexpr size_t L1_KF_HI = L1_END;
constexpr size_t L1_KF_LO = 1 * MiB;
constexpr size_t WS_NEED = (L0_END > L1_END ? L0_END : L1_END);
static_assert(L1_KF_LO + 9 * MiB <= WS_WIN_CD, "Kf low part must not reach the layer-1 weight copies");
static_assert(WS_NEED <= 512 * MiB, "workspace map");

constexpr int LDS_BYTES = 136192;
constexpr int LDS_BAR = 135680;
#ifndef PHM
#define PHM 0xFFFFF
#endif
#ifndef REP_A
#define REP_A 1
#endif
#ifndef REP_G2
#define REP_G2 1
#endif
#ifndef REP_PREP
#define REP_PREP 1
#endif
#ifndef REP_SCAN
#define REP_SCAN 1
#endif
#ifndef REP_RET
#define REP_RET 1
#endif
#ifndef REP_SM
#define REP_SM 1
#endif
#ifndef REP_P4
#define REP_P4 1
#endif
#ifndef REP_P10
#define REP_P10 1
#endif

struct Params { const float* in[31]; float* out; unsigned char* ws; };
enum { I_XP = 0, I_XS, I_CAK, I_CAV, I_CBK, I_CBV, I_SCF, I_SCB, I_CDK, I_CDV, I_C, I_CCTX, I_NORMG, I_MODW, I_MODB,
       I_ABWIN, I_ABWOUT, I_SINK, I_LQ1, I_LK1, I_LQ2, I_LK2, I_BNG, I_CDWIN, I_CDWOUT, I_DECF, I_DECB, I_CNG, I_DQG, I_DKG, I_FING };

__device__ __forceinline__ unsigned cvtpk(float lo, float hi) {
    typedef float f2_t __attribute__((ext_vector_type(2))); typedef __bf16 b2_t __attribute__((ext_vector_type(2)));
    f2_t v = {lo, hi}; b2_t b = __builtin_convertvector(v, b2_t); return __builtin_bit_cast(unsigned, b);
}
__device__ __forceinline__ float bflo(unsigned w) { return __uint_as_float(w << 16); }
__device__ __forceinline__ float bfhi(unsigned w) { return __uint_as_float(w & 0xffff0000u); }
__device__ __forceinline__ void unpack8(const u32x4 w, float (&v)[8]) {
    v[0] = bflo(w.x); v[1] = bfhi(w.x); v[2] = bflo(w.y); v[3] = bfhi(w.y); v[4] = bflo(w.z); v[5] = bfhi(w.z); v[6] = bflo(w.w); v[7] = bfhi(w.w);
}
__device__ __forceinline__ u32x4 pack8(const float (&v)[8]) {
    u32x4 w; w.x = cvtpk(v[0], v[1]); w.y = cvtpk(v[2], v[3]); w.z = cvtpk(v[4], v[5]); w.w = cvtpk(v[6], v[7]); return w;
}
__device__ __forceinline__ float fexp2(float x) { return __builtin_amdgcn_exp2f(x); }
__device__ __forceinline__ float siluf(float g) { return g * __builtin_amdgcn_rcpf(1.0f + fexp2(-g * LOG2E)); }
__device__ __forceinline__ float wave_sum(float v) {
#pragma unroll
    for (int o = 1; o < 64; o <<= 1) v += __shfl_xor(v, o);
    return v;
}
__device__ __forceinline__ int crow(int r, int hi) { return (r & 3) + 8 * (r >> 2) + 4 * hi; }
__device__ __forceinline__ size_t kf_base(int sh) { return sh < 23 ? L1_KF_HI + (size_t)sh * MiB : L1_KF_LO + (size_t)(sh - 23) * MiB; }
#define MFMA32(a, b, c) __builtin_amdgcn_mfma_f32_32x32x16_bf16((a), (b), (c), 0, 0, 0)

struct EpiResid {
    static constexpr bool PERM = false, AFTER_DRAIN = false;
    const float* xp; const float* xs; float* out; const float* mod;
    __device__ __forceinline__ void operator()(const pg8::f32x4 (&acc)[2][2][4][2], const pg8::Unit& u, int wr, int wc, int fr, int fq) const {
        const int pm = u.pm;
        const float* xin = pm < 16 ? xp + (size_t)pm * 256 * DM : xs + (size_t)(pm - 16) * 256 * DM;
        float* xo = out + (size_t)pm * 256 * DM;
        const int mrow = pm < 16 ? 0 : 1 + ((pm - 16) >> 4);
        const float* gate = mod + mrow * 3072 + 2048;
        const int col0 = u.pn * 256 + wc * 32 + 4 * fq;
#pragma unroll
        for (int bj = 0; bj < 2; ++bj)
#pragma unroll
            for (int n = 0; n < 2; ++n) {
                const pg8::f32x4 g = *(const pg8::f32x4*)(gate + col0 + bj * 128 + n * 16);
                pg8::f32x4 xv[2][4];
#pragma unroll
                for (int ai = 0; ai < 2; ++ai)
#pragma unroll
                    for (int m = 0; m < 4; ++m) xv[ai][m] = *(const pg8::f32x4*)(xin + (size_t)(ai * 128 + wr * 64 + m * 16 + fr) * DM + col0 + bj * 128 + n * 16);
#pragma unroll
                for (int ai = 0; ai < 2; ++ai)
#pragma unroll
                    for (int m = 0; m < 4; ++m)
                        *(pg8::f32x4*)(xo + (size_t)(ai * 128 + wr * 64 + m * 16 + fr) * DM + col0 + bj * 128 + n * 16) = xv[ai][m] + g * acc[ai][bj][m][n];
            }
    }
};

__device__ __forceinline__ void transpose_item(const float* __restrict__ W, int K, int N, bf16_t* __restrict__ WT, float* scr, int item, int lane) {
    const int nblk = N / 32, kb = item / nblk, nb = item % nblk, k0 = 64 * kb, n0 = 32 * nb;
#pragma unroll 8
    for (int i = 0; i < 32; ++i) { const int kk = 2 * i + (lane >> 5); scr[kk * 33 + (lane & 31)] = W[(size_t)(k0 + kk) * N + n0 + (lane & 31)]; }
    asm volatile("s_waitcnt lgkmcnt(0)" ::: "memory");
    const int c = lane & 7;
#pragma unroll
    for (int j = 0; j < 4; ++j) {
        const int n = (lane >> 3) + 8 * j; const float* s = scr + (8 * c) * 33 + n;
        u32x4 o; o.x = cvtpk(s[0 * 33], s[1 * 33]); o.y = cvtpk(s[2 * 33], s[3 * 33]); o.z = cvtpk(s[4 * 33], s[5 * 33]); o.w = cvtpk(s[6 * 33], s[7 * 33]);
        *(u32x4*)(WT + (size_t)(n0 + n) * K + k0 + 8 * c) = o;
    }
    asm volatile("s_waitcnt lgkmcnt(0)" ::: "memory");
}

__device__ __forceinline__ void phase0(const Params& p, unsigned char* lds, int tid, int blk, int G) {
    const int lane = tid & 63, wave = tid >> 6;
    unsigned char* ws = p.ws;
    {
        float* scr = (float*)(lds + wave * 16384);
        const int gw = blk * 8 + wave, NGW = G * 8;
        constexpr int I_IN = 16 * 104, I_OUT = 16 * 32, NIT = 2 * (I_IN + I_OUT);
        for (int it = gw; it < NIT; it += NGW) {
            int r = it;
            if (r < I_IN) { transpose_item(p.in[I_ABWIN], 1024, PZ, (bf16_t*)(ws + WS_WIN_AB), scr, r, lane); continue; } r -= I_IN;
            if (r < I_OUT) { transpose_item(p.in[I_ABWOUT], 1024, 1024, (bf16_t*)(ws + WS_WOUT_AB), scr, r, lane); continue; } r -= I_OUT;
            if (r < I_IN) { transpose_item(p.in[I_CDWIN], 1024, PZ, (bf16_t*)(ws + WS_WIN_CD), scr, r, lane); continue; } r -= I_IN;
            transpose_item(p.in[I_CDWOUT], 1024, 1024, (bf16_t*)(ws + WS_WOUT_CD), scr, r, lane);
        }
    }
    __syncthreads();
    {
        float* red = (float*)lds;
        const int c = tid & 31, kp = tid >> 5;
        for (int cgp = blk; cgp < 256; cgp += G) {
            const int layer = cgp >> 7, colb = (cgp & 127) * 24;
            const float* W = p.in[I_MODW] + (size_t)layer * 1024 * 3072;
            float acc[9];
#pragma unroll
            for (int r = 0; r < 9; ++r) acc[r] = 0.f;
            if (c < 24) {
                for (int k = kp * 64; k < kp * 64 + 64; ++k) {
                    const float w = W[(size_t)k * 3072 + colb + c];
                    acc[0] += siluf(p.in[I_CCTX][k]) * w;
#pragma unroll
                    for (int b = 0; b < 8; ++b) acc[1 + b] += siluf(p.in[I_C][b * 1024 + k]) * w;
                }
#pragma unroll
                for (int r = 0; r < 9; ++r) red[(kp * 9 + r) * 24 + c] = acc[r];
            }
            __syncthreads();
            if (tid < 216) {
                const int r = tid / 24, cc = tid % 24; float s = 0.f;
                for (int q = 0; q < 16; ++q) s += red[(q * 9 + r) * 24 + cc];
                ((float*)(ws + WS_MOD))[(size_t)(layer * 9 + r) * 3072 + colb + cc] = s + p.in[I_MODB][layer * 3072 + colb + cc];
            }
            __syncthreads();
        }
    }
    {
        const int gt = blk * 512 + tid;
        if (gt < 1024) {
            const int pos = gt >> 4, f = gt & 15;
            const float inv = exp2f(-(float)f * (13.287712379549449f / 16.0f));
            const float ang = (float)pos * inv;
            ((float*)(ws + WS_ROPE))[gt] = cosf(ang);
            ((float*)(ws + WS_ROPE))[1024 + gt] = sinf(ang);
        }
        if (blk == 0 && tid == 0) {
            float s1 = 0.f, s2 = 0.f;
            for (int i = 0; i < 64; ++i) { s1 += p.in[I_LQ1][i] * p.in[I_LK1][i]; s2 += p.in[I_LQ2][i] * p.in[I_LK2][i]; }
            *(float*)(ws + WS_LAM) = expf(s1) - expf(s2) + 0.2f;
        }
    }
}

__device__ __forceinline__ void adaln_rows(const float* xp, const float* xs, const float* __restrict__ g, const float* __restrict__ mod,
                                           bf16_t* __restrict__ XN, int gw, int NGW, int lane) {
    for (int row = gw; row < MTOT; row += 2 * NGW) {
        const int rowB = (row + NGW < MTOT) ? row + NGW : row;
        const float* xa = row < NCTXTOK ? xp + (size_t)row * DM : xs + (size_t)(row - NCTXTOK) * DM;
        const float* xb = rowB < NCTXTOK ? xp + (size_t)rowB * DM : xs + (size_t)(rowB - NCTXTOK) * DM;
        f32x4 va[4], vb[4];
#pragma unroll
        for (int j = 0; j < 4; ++j) va[j] = __builtin_nontemporal_load((const f32x4*)(xa + 4 * (lane + 64 * j)));
#pragma unroll
        for (int j = 0; j < 4; ++j) vb[j] = __builtin_nontemporal_load((const f32x4*)(xb + 4 * (lane + 64 * j)));
        float sa = 0.f, sb = 0.f;
#pragma unroll
        for (int j = 0; j < 4; ++j) { sa += (va[j].x * va[j].x + va[j].y * va[j].y) + (va[j].z * va[j].z + va[j].w * va[j].w); sb += (vb[j].x * vb[j].x + vb[j].y * vb[j].y) + (vb[j].z * vb[j].z + vb[j].w * vb[j].w); }
        const float ra = rsqrtf(wave_sum(sa) * (1.0f / DM) + EPS), rb = rsqrtf(wave_sum(sb) * (1.0f / DM) + EPS);
        const int ma = row < NCTXTOK ? 0 : 1 + ((row - NCTXTOK) >> 12), mb = rowB < NCTXTOK ? 0 : 1 + ((rowB - NCTXTOK) >> 12);
        const float* sha = mod + ma * 3072; const float* shb = mod + mb * 3072;
#pragma unroll
        for (int j = 0; j < 4; ++j) {
            const int col = 4 * (lane + 64 * j);
            const f32x4 gg = *(const f32x4*)(g + col);
            const f32x4 ha = va[j] * ra * gg * (*(const f32x4*)(sha + 1024 + col) + 1.0f) + *(const f32x4*)(sha + col);
            const f32x4 hb = vb[j] * rb * gg * (*(const f32x4*)(shb + 1024 + col) + 1.0f) + *(const f32x4*)(shb + col);
            u32x2 wa; wa.x = cvtpk(ha.x, ha.y); wa.y = cvtpk(ha.z, ha.w);
            u32x2 wb; wb.x = cvtpk(hb.x, hb.y); wb.y = cvtpk(hb.z, hb.w);
            *(u32x2*)(XN + (size_t)row * DM + col) = wa;
            *(u32x2*)(XN + (size_t)rowB * DM + col) = wb;
        }
    }
}
__device__ __forceinline__ void final_rows(float* x, const float* __restrict__ g, int gw, int NGW, int lane) {
    for (int row = gw; row < MTOT; row += 2 * NGW) {
        const int rowB = (row + NGW < MTOT) ? row + NGW : row;
        float* xa = x + (size_t)row * DM; float* xb = x + (size_t)rowB * DM;
        f32x4 va[4], vb[4];
#pragma unroll
        for (int j = 0; j < 4; ++j) va[j] = __builtin_nontemporal_load((const f32x4*)(xa + 4 * (lane + 64 * j)));
#pragma unroll
        for (int j = 0; j < 4; ++j) vb[j] = __builtin_nontemporal_load((const f32x4*)(xb + 4 * (lane + 64 * j)));
        float sa = 0.f, sb = 0.f;
#pragma unroll
        for (int j = 0; j < 4; ++j) { sa += (va[j].x * va[j].x + va[j].y * va[j].y) + (va[j].z * va[j].z + va[j].w * va[j].w); sb += (vb[j].x * vb[j].x + vb[j].y * vb[j].y) + (vb[j].z * vb[j].z + vb[j].w * vb[j].w); }
        const float ra = rsqrtf(wave_sum(sa) * (1.0f / DM) + EPS), rb = rsqrtf(wave_sum(sb) * (1.0f / DM) + EPS);
#pragma unroll
        for (int j = 0; j < 4; ++j) {
            const int col = 4 * (lane + 64 * j);
            const f32x4 gg = *(const f32x4*)(g + col);
            __builtin_nontemporal_store(va[j] * ra * gg, (f32x4*)(xa + col));
            if (rowB != row) __builtin_nontemporal_store(vb[j] * rb * gg, (f32x4*)(xb + col));
        }
    }
}

template <bool F32SRC>
__device__ __forceinline__ void tile64(const void* src, size_t sp, bool rms, bool rope, const float* __restrict__ gain, int pos0,
                                       const float* __restrict__ cosT, const float* __restrict__ sinT,
                                       float* df, size_t dfp, bf16_t* dk, size_t dkp, bf16_t* dt, size_t dtp, unsigned char* ldsw, int lane,
                                       const int fragmode = 0, const int fraghalf = 0, const int fragtq = 0, bf16_t* dkf = nullptr) {
    const int tr = lane >> 3, ch = lane & 7;
    unsigned short* T = (unsigned short*)ldsw;
    u32x4 rawh[8]; f32x4 rawa[F32SRC ? 8 : 1], rawb[F32SRC ? 8 : 1];
#pragma unroll
    for (int g8 = 0; g8 < 8; ++g8) {
        const int tok = g8 * 8 + tr;
        if (F32SRC) { const float* s = (const float*)src + (size_t)tok * sp + ch * 8; rawa[g8] = *(const f32x4*)s; rawb[g8] = *(const f32x4*)(s + 4); }
        else rawh[g8] = *(const u32x4*)((const bf16_t*)src + (size_t)tok * sp + ch * 8);
    }
#pragma unroll
    for (int g8 = 0; g8 < 8; ++g8) {
        const int tok = g8 * 8 + tr;
        float v[8];
        if (F32SRC) {
            const f32x4 a = rawa[g8], b = rawb[g8];
            v[0] = a.x; v[1] = a.y; v[2] = a.z; v[3] = a.w; v[4] = b.x; v[5] = b.y; v[6] = b.z; v[7] = b.w;
        } else {
            unpack8(rawh[g8], v);
        }
        if (rms) {
            float ss = 0.f;
#pragma unroll
            for (int e = 0; e < 8; ++e) ss += v[e] * v[e];
            ss += __shfl_xor(ss, 1); ss += __shfl_xor(ss, 2); ss += __shfl_xor(ss, 4);
            const float rinv = rsqrtf(ss * (1.0f / 64.0f) + EPS);
#pragma unroll
            for (int e = 0; e < 8; ++e) v[e] *= rinv * gain[ch * 8 + e];
        }
        if (df) {
            float* o = df + (size_t)tok * dfp + ch * 8;
            __builtin_nontemporal_store((f32x4){v[0], v[1], v[2], v[3]}, (f32x4*)o); __builtin_nontemporal_store((f32x4){v[4], v[5], v[6], v[7]}, (f32x4*)(o + 4));
        }
        if (rope) {
            const int pos = pos0 + tok, c4 = ch & 3;
            const int trow = c4 < 2 ? (pos >> 6) : (pos & 63), f0 = 8 * (c4 & 1);
#pragma unroll
            for (int e = 0; e < 8; ++e) {
                const float other = __shfl_xor(v[e], 4);
                const float cs = cosT[trow * 16 + f0 + e], sn = sinT[trow * 16 + f0 + e];
                v[e] = ch < 4 ? v[e] * cs - other * sn : v[e] * cs + other * sn;
            }
        }
        if (dk) *(u32x4*)(dk + (size_t)tok * dkp + ch * 8) = pack8(v);
        if (dkf) {
            const int tl = 64 * fragtq + tok, t5 = tl & 31, pit = (t5 & 0x13) | ((t5 & 4) << 1) | ((t5 & 8) >> 1);
            *(u32x4*)(dkf + (size_t)((((tl >> 5) * 8 + 4 * fraghalf + (ch >> 1)) * 64 + (ch & 1) * 32 + pit) * 8)) = pack8(v);
        }
        if (dt) {
#pragma unroll
            for (int e = 0; e < 8; ++e) T[(ch * 8 + e) * 72 + tok] = (unsigned short)(cvtpk(v[e], 0.f) & 0xffffu);
        }
    }
    if (dt) {
        asm volatile("s_waitcnt lgkmcnt(0)" ::: "memory");
#pragma unroll
        for (int k = 0; k < 8; ++k) {
            const int d = tr + 8 * k, c8 = ch;
            const u32x4 w = *(const u32x4*)(T + d * 72 + c8 * 8);
            if (fragmode) {
                const int e = 64 * fraghalf + d, tl = 64 * fragtq + 8 * c8;
                *(u32x4*)(dt + (size_t)((((e >> 5) * 8 + (tl >> 4)) * 64 + ((tl >> 3) & 1) * 32 + (e & 31)) * 8)) = w;
            } else *(u32x4*)(dt + (size_t)d * dtp + c8 * 8) = w;
        }
        asm volatile("s_waitcnt lgkmcnt(0)" ::: "memory");
    }
}

__device__ __forceinline__ void prep_layer0(const Params& p, unsigned char* lds, int tid, int blk, int G) {
    unsigned char* ws = p.ws; float* out = p.out;
    const int lane = tid & 63, wave = __builtin_amdgcn_readfirstlane(tid >> 6); unsigned char* ldsw = lds + wave * 9216; const int gwp = wave * G + blk, NGWp = G * 8;
    const bf16_t* Z = (const bf16_t*)(ws + WS_Z);
    const float* cosT = (const float*)(ws + WS_ROPE); const float* sinT = cosT + 1024;
    for (int u = gwp; u < 12160; u += NGWp) {
        if (u < 11520) {
            const int tt = u / 20, g = u % 20;
            const bool ctx = tt < 64;
            const int b = ctx ? (tt >> 2) : ((tt - 64) >> 6);
            const int t0 = ctx ? (tt & 3) * 64 : ((tt - 64) & 63) * 64;
            const size_t row0 = (size_t)tt * 64;
            const int NK = ctx ? 256 : NKL, koff = ctx ? t0 : 256 + t0;
            float* df = nullptr; size_t dfp = 0; bf16_t* dk = nullptr; bf16_t* dt = nullptr; size_t dtp = NK; int zcol; bool rope = false;
            if (g < 2) {
                zcol = 512 + 64 * g; rope = !ctx;
                dk = (bf16_t*)(ws + (ctx ? L0_KA_CTX : L0_KA_LAT)) + ((size_t)(b * 2 + g) * NK + koff) * 64;
                if (ctx) { df = out + O_AK + ((size_t)(b * 2 + g) * 256 + t0) * 64; dfp = 64; }
            } else if (g < 4) {
                const int hd = g - 2; zcol = 640 + 64 * hd;
                dt = (bf16_t*)(ws + (ctx ? L0_VTA_CTX : L0_VTA_LAT)) + (size_t)(b * 2 + hd) * 64 * NK + koff;
                if (ctx) { df = out + O_AV + ((size_t)(b * 2 + hd) * 256 + t0) * 64; dfp = 64; }
            } else if (g < 12) {
                const int idx = g - 4, hd = idx >> 1, half = idx & 1; zcol = 1280 + 128 * hd + 64 * half; rope = !ctx;
                const size_t base = ctx ? (half ? L0_KB2_CTX : L0_KB1_CTX) : (half ? L0_KB2_LAT : L0_KB1_LAT);
                dk = (bf16_t*)(ws + base) + ((size_t)(b * 4 + hd) * NK + koff) * 64;
                if (ctx) { df = out + O_BK + ((size_t)(b * 4 + hd) * 256 + t0) * 128 + 64 * half; dfp = 128; }
            } else {
                const int idx = g - 12, hd = idx >> 1, half = idx & 1; zcol = 1792 + 128 * hd + 64 * half;
                dt = (bf16_t*)(ws + (ctx ? L0_VTB_CTX : L0_VTB_LAT)) + ((size_t)(b * 4 + hd) * 128 + 64 * half) * NK + koff;
                if (ctx) { df = out + O_BV + ((size_t)(b * 4 + hd) * 256 + t0) * 128 + 64 * half; dfp = 128; }
            }
            tile64<false>(Z + row0 * PZ + zcol, PZ, false, rope, nullptr, t0, cosT, sinT, df, dfp, dk, 64, dt, dtp, ldsw, lane);
        } else {
            const int cu = u - 11520, g = cu % 20, r = cu / 20, b = r >> 2, t0 = (r & 3) * 64;
            const float* src; size_t sp; bf16_t* dk = nullptr; bf16_t* dt = nullptr;
            if (g < 2) {
                src = p.in[I_CAK] + ((size_t)(b * 2 + g) * 256 + t0) * 64; sp = 64;
                dk = (bf16_t*)(ws + L0_KA_LAT) + ((size_t)(b * 2 + g) * NKL + t0) * 64;
            } else if (g < 4) {
                const int hd = g - 2; src = p.in[I_CAV] + ((size_t)(b * 2 + hd) * 256 + t0) * 64; sp = 64;
                dt = (bf16_t*)(ws + L0_VTA_LAT) + (size_t)(b * 2 + hd) * 64 * NKL + t0;
            } else if (g < 12) {
                const int idx = g - 4, hd = idx >> 1, half = idx & 1;
                src = p.in[I_CBK] + ((size_t)(b * 4 + hd) * 256 + t0) * 128 + 64 * half; sp = 128;
                dk = (bf16_t*)(ws + (half ? L0_KB2_LAT : L0_KB1_LAT)) + ((size_t)(b * 4 + hd) * NKL + t0) * 64;
            } else {
                const int idx = g - 12, hd = idx >> 1, half = idx & 1;
                src = p.in[I_CBV] + ((size_t)(b * 4 + hd) * 256 + t0) * 128 + 64 * half; sp = 128;
                dt = (bf16_t*)(ws + L0_VTB_LAT) + ((size_t)(b * 4 + hd) * 128 + 64 * half) * NKL + t0;
            }
            tile64<true>(src, sp, false, false, nullptr, 0, cosT, sinT, nullptr, 0, dk, 64, dt, NKL, ldsw, lane);
        }
    }
}

__device__ __forceinline__ void prep_layer1(const Params& p, unsigned char* lds, int tid, int blk, int G) {
    unsigned char* ws = p.ws; float* out = p.out;
    const int lane = tid & 63, wave = __builtin_amdgcn_readfirstlane(tid >> 6); unsigned char* ldsw = lds + wave * 9216; const int gwp = wave * G + blk, NGWp = G * 8;
    const bf16_t* Z = (const bf16_t*)(ws + WS_Z);
    const float* cosT = (const float*)(ws + WS_ROPE); const float* sinT = cosT + 1024;
    for (int u = gwp; u < 11520 + 128; u += NGWp) {
        if (u < 11520) {
            const int tt = u / 20, g = u % 20;
            const bool ctx = tt < 64;
            const int b = ctx ? (tt >> 2) : ((tt - 64) >> 6);
            const int t0 = ctx ? (tt & 3) * 64 : ((tt - 64) & 63) * 64;
            const size_t row0 = (size_t)tt * 64;
            float* df = nullptr; bf16_t* dk = nullptr; bf16_t* dt = nullptr; size_t dtp = 0; int zcol; bool rope = false, rms = false;
            int fragmode = 0, fraghalf = 0, fragtq = 0; bf16_t* dkf = nullptr;
            if (g < 16) {
                const int idx = g & 7, hd = idx >> 1, half = idx & 1; const bool isv = g >= 8;
                zcol = (isv ? 1024 : 512) + 128 * hd + 64 * half;
                const int NS = ctx ? 256 : 4096; dtp = NS;
                const size_t base = ctx ? (isv ? L1_VTC : L1_KTC) : (isv ? L1_VTL : L1_KTL);
                dt = (bf16_t*)(ws + base) + (size_t)(b * 4 + hd) * 128 * NS + (size_t)(t0 >> 7) * 16384;
                fragmode = 1; fraghalf = half; fragtq = (t0 >> 6) & 1;
            } else if (g < 18) {
                const int hd = g - 16; zcol = 2048 + 64 * hd; rms = true; rope = !ctx;
                const int NK = ctx ? 256 : NKL, koff = ctx ? t0 : 256 + t0;
                dk = (bf16_t*)(ws + (ctx ? L1_KD_CTX : L1_KD_LAT)) + ((size_t)(b * 2 + hd) * NK + koff) * 64;
                if (ctx) df = out + O_DK + ((size_t)(b * 2 + hd) * 256 + t0) * 64;
            } else {
                const int hd = g - 18; zcol = 2176 + 64 * hd;
                const int NK = ctx ? 256 : NKL, koff = ctx ? t0 : 256 + t0; dtp = NK;
                dt = (bf16_t*)(ws + (ctx ? L1_VTD_CTX : L1_VTD_LAT)) + (size_t)(b * 2 + hd) * 64 * NK + koff;
                if (ctx) df = out + O_DV + ((size_t)(b * 2 + hd) * 256 + t0) * 64;
            }
            tile64<false>(Z + row0 * PZ + zcol, PZ, rms, rope, p.in[I_DKG], t0, cosT, sinT, df, 64, dk, 64, dt, dtp, ldsw, lane, fragmode, fraghalf, fragtq, dkf);
        } else {
            const int cu = u - 11520, g = cu & 3, r = cu >> 2, b = r >> 2, t0 = (r & 3) * 64;
            const float* src; bf16_t* dk = nullptr; bf16_t* dt = nullptr;
            if (g < 2) {
                src = p.in[I_CDK] + ((size_t)(b * 2 + g) * 256 + t0) * 64;
                dk = (bf16_t*)(ws + L1_KD_LAT) + ((size_t)(b * 2 + g) * NKL + t0) * 64;
            } else {
                const int hd = g - 2; src = p.in[I_CDV] + ((size_t)(b * 2 + hd) * 256 + t0) * 64;
                dt = (bf16_t*)(ws + L1_VTD_LAT) + (size_t)(b * 2 + hd) * 64 * NKL + t0;
            }
            tile64<true>(src, 64, false, false, nullptr, 0, cosT, sinT, nullptr, 0, dk, 64, dt, NKL, ldsw, lane);
        }
    }
}

template <bool RMS, bool ROPE>
__device__ __forceinline__ void load_q(const bf16_t* zq, int hi, const float* __restrict__ gain, int pos,
                                       const float* __restrict__ cosT, const float* __restrict__ sinT, bf16x8 (&qf)[4]) {
    float v[4][8];
#pragma unroll
    for (int kk = 0; kk < 4; ++kk) unpack8(*(const u32x4*)(zq + 16 * kk + 8 * hi), v[kk]);
    if (RMS) {
        float ss = 0.f;
#pragma unroll
        for (int kk = 0; kk < 4; ++kk)
#pragma unroll
            for (int e = 0; e < 8; ++e) ss += v[kk][e] * v[kk][e];
        ss += __shfl_xor(ss, 32);
        const float rinv = rsqrtf(ss * (1.0f / 64.0f) + EPS);
#pragma unroll
        for (int kk = 0; kk < 4; ++kk)
#pragma unroll
            for (int e = 0; e < 8; ++e) v[kk][e] *= rinv * gain[16 * kk + 8 * hi + e];
    }
    if (ROPE) {
        const int prow = pos >> 6, pcol = pos & 63;
#pragma unroll
        for (int kk = 0; kk < 2; ++kk) {
            const int trow = kk == 0 ? prow : pcol;
#pragma unroll
            for (int e = 0; e < 8; ++e) {
                const float cs = cosT[trow * 16 + 8 * hi + e], sn = sinT[trow * 16 + 8 * hi + e];
                const float x1 = v[kk][e], x2 = v[kk + 2][e];
                v[kk][e] = x1 * cs - x2 * sn; v[kk + 2][e] = x2 * cs + x1 * sn;
            }
        }
    }
#pragma unroll
    for (int kk = 0; kk < 4; ++kk) {
#pragma unroll
        for (int e = 0; e < 8; ++e) v[kk][e] *= QSCALE;
        qf[kk] = __builtin_bit_cast(bf16x8, pack8(v[kk]));
    }
}

template <int DV, bool WINDOW>
__device__ __forceinline__ void compute_tile(const unsigned char* base, const unsigned rdK, const unsigned rdV, const bf16x8 (&qf)[4], f32x16& negm,
                                             f32x16 (&O)[DV / 32], float& m_run, float& l_run, const bool mtile, const int j0, const int qpos, const int hi, const bool first) {
    constexpr int NDB = DV / 32;
    constexpr float THR = 8.0f;
    f32x16 s0, s1;
    bf16x8 kf0[4], kf1[4], vf[NDB][4];
#pragma unroll
    for (int kk = 0; kk < 4; ++kk) { kf0[kk] = *(const bf16x8*)(base + rdK + kk * 32); kf1[kk] = *(const bf16x8*)(base + rdK + 32 * 144 + kk * 32); }
#pragma unroll
    for (int db = 0; db < NDB; ++db)
#pragma unroll
        for (int q = 0; q < 4; ++q) vf[db][q] = *(const bf16x8*)(base + rdV + db * 32 * 144 + q * 32);
    __builtin_amdgcn_sched_barrier(0);
    __builtin_amdgcn_s_setprio(1);
    s0 = MFMA32(kf0[0], qf[0], negm); s1 = MFMA32(kf1[0], qf[0], negm);
#pragma unroll
    for (int kk = 1; kk < 4; ++kk) { s0 = MFMA32(kf0[kk], qf[kk], s0); s1 = MFMA32(kf1[kk], qf[kk], s1); }
    __builtin_amdgcn_s_setprio(0);
    if (WINDOW && mtile) {
#pragma unroll
        for (int r = 0; r < 16; ++r) {
            const int j = j0 + 16 * (r >> 3) + 8 * hi + (r & 7);
            const int d0 = qpos - j, d1 = d0 - 32;
            if (d0 > 128 || d0 < -128) s0[r] = -1e30f;
            if (d1 > 128 || d1 < -128) s1[r] = -1e30f;
        }
    }
    float mx = fmaxf(s0[0], s1[0]);
#pragma unroll
    for (int r = 1; r < 16; ++r) mx = fmaxf(mx, fmaxf(s0[r], s1[r]));
    {
        auto rr = __builtin_amdgcn_permlane32_swap(__float_as_uint(mx), __float_as_uint(mx), false, false);
        mx = fmaxf(__uint_as_float(rr[0]), __uint_as_float(rr[1]));
    }
    if (first || __any(mx > THR)) {
        const float dl = first ? mx : fmaxf(mx, 0.f);
        m_run += dl;
#pragma unroll
        for (int r = 0; r < 16; ++r) { s0[r] -= dl; s1[r] -= dl; negm[r] = -m_run; }
        const float alpha = fexp2(-dl);
        l_run *= alpha;
#pragma unroll
        for (int db = 0; db < NDB; ++db)
#pragma unroll
            for (int r = 0; r < 16; ++r) O[db][r] *= alpha;
    }
    float rs = 0.f;
#pragma unroll
    for (int r = 0; r < 16; ++r) { s0[r] = fexp2(s0[r]); s1[r] = fexp2(s1[r]); rs += s0[r] + s1[r]; }
    l_run += rs;
    u32x4 w00, w01, w10, w11;
    w00.x = cvtpk(s0[0], s0[1]); w00.y = cvtpk(s0[2], s0[3]); w00.z = cvtpk(s0[4], s0[5]); w00.w = cvtpk(s0[6], s0[7]);
    w01.x = cvtpk(s0[8], s0[9]); w01.y = cvtpk(s0[10], s0[11]); w01.z = cvtpk(s0[12], s0[13]); w01.w = cvtpk(s0[14], s0[15]);
    w10.x = cvtpk(s1[0], s1[1]); w10.y = cvtpk(s1[2], s1[3]); w10.z = cvtpk(s1[4], s1[5]); w10.w = cvtpk(s1[6], s1[7]);
    w11.x = cvtpk(s1[8], s1[9]); w11.y = cvtpk(s1[10], s1[11]); w11.z = cvtpk(s1[12], s1[13]); w11.w = cvtpk(s1[14], s1[15]);
    const bf16x8 p00 = __builtin_bit_cast(bf16x8, w00), p01 = __builtin_bit_cast(bf16x8, w01), p10 = __builtin_bit_cast(bf16x8, w10), p11 = __builtin_bit_cast(bf16x8, w11);
    __builtin_amdgcn_s_setprio(1);
#pragma unroll
    for (int db = 0; db < NDB; ++db) {
        O[db] = MFMA32(vf[db][0], p00, O[db]);
        O[db] = MFMA32(vf[db][1], p01, O[db]);
        O[db] = MFMA32(vf[db][2], p10, O[db]);
        O[db] = MFMA32(vf[db][3], p11, O[db]);
    }
    __builtin_amdgcn_s_setprio(0);
}

template <int DV, bool WINDOW>
__device__ __forceinline__ void compute_block32(const unsigned char* kb, const unsigned char* vb0, const bf16x8 (&qf)[4], f32x16& negm,
                                                f32x16 (&O)[DV / 32], float& m_run, float& l_run, const bool mtile, const int jb0, const int qpos, const int hi, const bool first) {
    constexpr int NDB = DV / 32;
    constexpr float THR = 8.0f;
    f32x16 s;
    bf16x8 kf[4], vf[NDB][2];
#pragma unroll
    for (int kk = 0; kk < 4; ++kk) kf[kk] = *(const bf16x8*)(kb + kk * 32);
#pragma unroll
    for (int db = 0; db < NDB; ++db) { vf[db][0] = *(const bf16x8*)(vb0 + db * 32 * 144); vf[db][1] = *(const bf16x8*)(vb0 + db * 32 * 144 + 32); }
    __builtin_amdgcn_sched_barrier(0);
#pragma unroll
    for (int r = 0; r < 16; ++r) s[r] = 0.f;
    __builtin_amdgcn_s_setprio(1);
#pragma unroll
    for (int kk = 0; kk < 4; ++kk) s = MFMA32(kf[kk], qf[kk], s);
    __builtin_amdgcn_s_setprio(0);
    if (WINDOW && mtile) {
#pragma unroll
        for (int r = 0; r < 16; ++r) {
            const int j = jb0 + 16 * (r >> 3) + 8 * hi + (r & 7);
            const int d0 = qpos - j;
            if (d0 > 128 || d0 < -128) s[r] = -1e30f;
        }
    }
    float mx = s[0];
#pragma unroll
    for (int r = 1; r < 16; ++r) mx = fmaxf(mx, s[r]);
    {
        auto rr = __builtin_amdgcn_permlane32_swap(__float_as_uint(mx), __float_as_uint(mx), false, false);
        mx = fmaxf(__uint_as_float(rr[0]), __uint_as_float(rr[1]));
    }
    mx -= m_run;
    if (first || __any(mx > THR)) {
        const float dl = first ? mx : fmaxf(mx, 0.f);
        m_run += dl;
        const float alpha = fexp2(-dl);
        l_run *= alpha;
#pragma unroll
        for (int db = 0; db < NDB; ++db)
#pragma unroll
            for (int r = 0; r < 16; ++r) O[db][r] *= alpha;
    }
    float rs = 0.f;
#pragma unroll
    for (int r = 0; r < 16; ++r) { s[r] = fexp2(s[r] - m_run); rs += s[r]; }
    l_run += rs;
    u32x4 w0, w1;
    w0.x = cvtpk(s[0], s[1]); w0.y = cvtpk(s[2], s[3]); w0.z = cvtpk(s[4], s[5]); w0.w = cvtpk(s[6], s[7]);
    w1.x = cvtpk(s[8], s[9]); w1.y = cvtpk(s[10], s[11]); w1.z = cvtpk(s[12], s[13]); w1.w = cvtpk(s[14], s[15]);
    const bf16x8 p0 = __builtin_bit_cast(bf16x8, w0), p1 = __builtin_bit_cast(bf16x8, w1);
    __builtin_amdgcn_s_setprio(1);
#pragma unroll
    for (int db = 0; db < NDB; ++db) {
        O[db] = MFMA32(vf[db][0], p0, O[db]);
        O[db] = MFMA32(vf[db][1], p1, O[db]);
    }
    __builtin_amdgcn_s_setprio(0);
}

template <int DV, bool WINDOW>
__device__ __forceinline__ void attn_pass(const bf16x8 (&qf)[4], const bf16_t* __restrict__ Kg, const bf16_t* __restrict__ Vg, const int NK,
                                          const int nt_lead, const int lt_lo, const int lt_hi, const int qpos, const int wq0,
                                          f32x16 (&O)[DV / 32], float& m_run, float& l_run, unsigned char* lds, const int tid) {
    constexpr int NDB = DV / 32, NVH = DV / 64, BUFB = 9216 + DV * 144;
    constexpr float THR = 8.0f;
    const int lane = tid & 63, i = lane & 31, hi = lane >> 5;
    const int pi = (i & 0x13) | ((i & 4) << 1) | ((i & 8) >> 1);
    const int krow = tid >> 3, kch = tid & 7;
    const int T = nt_lead + (lt_hi - lt_lo);
    const unsigned stK = krow * 144 + kch * 16;
    const unsigned rdK = pi * 144 + hi * 16, rdV = 9216 + i * 144 + hi * 16;
    u32x4 kregA, vregA[NVH], kregB, vregB[NVH];
    f32x16 negm;
#pragma unroll
    for (int r = 0; r < 16; ++r) negm[r] = 0.f;
    m_run = 0.f;
#define TILE_OF(it) ((it) < nt_lead ? (it) : lt_lo + ((it) - nt_lead))
#define LOADT(KR, VR, kt) do { KR = *(const u32x4*)(Kg + (size_t)((kt) * 64 + krow) * 64 + kch * 8); \
        _Pragma("unroll") for (int h_ = 0; h_ < NVH; ++h_) VR[h_] = *(const u32x4*)(Vg + (size_t)(h_ * 64 + krow) * NK + (kt) * 64 + kch * 8); } while (0)
#define STORET(KR, VR, buf) do { *(u32x4*)(lds + (buf) * BUFB + stK) = KR; \
        _Pragma("unroll") for (int h_ = 0; h_ < NVH; ++h_) *(u32x4*)(lds + (buf) * BUFB + 9216 + (h_ * 64 + krow) * 144 + kch * 16) = VR[h_]; } while (0)
#define STEP(it, KR, VR) do { \
        STORET(KR, VR, ((it) + 1) & 1); \
        { const int i3_ = ((it) + 3 < T) ? (it) + 3 : T - 1; const int kt3 = TILE_OF(i3_); LOADT(KR, VR, kt3); } \
        const int kt = TILE_OF(it); \
        const bool mtile = WINDOW && ((it) >= nt_lead); \
        const int j0 = kt * 64 - 256; \
        bool active = true; \
        if (mtile) active = (j0 + 63 >= wq0 - 128) && (j0 <= wq0 + 31 + 128); \
        if (active) { if (DV == 128) { const unsigned char* b_ = lds + ((it) & 1) * BUFB; \
                compute_block32<DV, WINDOW>(b_ + rdK, b_ + rdV, qf, negm, O, m_run, l_run, mtile, j0, qpos, hi, (it) == 0); \
                compute_block32<DV, WINDOW>(b_ + rdK + 32 * 144, b_ + rdV + 64, qf, negm, O, m_run, l_run, mtile, j0 + 32, qpos, hi, false); } \
            else compute_tile<DV, WINDOW>(lds + ((it) & 1) * BUFB, rdK, rdV, qf, negm, O, m_run, l_run, mtile, j0, qpos, hi, (it) == 0); } \
        asm volatile("s_waitcnt lgkmcnt(0)\n\ts_barrier" ::: "memory"); } while (0)
    { const int kt0 = TILE_OF(0); LOADT(kregA, vregA, kt0); }
    { const int i1_ = T > 1 ? 1 : T - 1; const int kt1 = TILE_OF(i1_); LOADT(kregB, vregB, kt1); }
    STORET(kregA, vregA, 0);
    { const int i2_ = T > 2 ? 2 : T - 1; const int kt2 = TILE_OF(i2_); LOADT(kregA, vregA, kt2); }
    asm volatile("s_waitcnt lgkmcnt(0)\n\ts_barrier" ::: "memory");
    for (int it = 0; it < T; it += 2) {
        STEP(it, kregB, vregB);
        if (it + 1 < T) STEP(it + 1, kregA, vregA);
    }
#undef TILE_OF
#undef LOADT
#undef STORET
#undef STEP
}

template <int NDB>
__device__ __forceinline__ void write_y(const f32x16 (&R)[NDB], const bf16_t* zgate, bf16_t* yout, int hi) {
#pragma unroll
    for (int db = 0; db < NDB; ++db)
#pragma unroll
        for (int g = 0; g < 4; g += 2) {
            float v[8];
#pragma unroll
            for (int k = 0; k < 4; ++k) {
                auto rr = __builtin_amdgcn_permlane32_swap(__float_as_uint(R[db][4 * g + k]), __float_as_uint(R[db][4 * (g + 1) + k]), false, false);
                v[k] = __uint_as_float(rr[0]); v[4 + k] = __uint_as_float(rr[1]);
            }
            const int d0 = 32 * db + 8 * (g + hi);
            const u32x4 gw = *(const u32x4*)(zgate + d0);
            u32x4 o;
            o.x = cvtpk(v[0] * siluf(bflo(gw.x)), v[1] * siluf(bfhi(gw.x))); o.y = cvtpk(v[2] * siluf(bflo(gw.y)), v[3] * siluf(bfhi(gw.y)));
            o.z = cvtpk(v[4] * siluf(bflo(gw.z)), v[5] * siluf(bfhi(gw.z))); o.w = cvtpk(v[6] * siluf(bflo(gw.w)), v[7] * siluf(bfhi(gw.w)));
            *(u32x4*)(yout + d0) = o;
        }
}

template <int NDB>
__device__ __forceinline__ void softmax1(f32x16& s, f32x16 (&O)[NDB], float& m_run, float& l_run, const bool first, bf16x8& p0, bf16x8& p1) {
    constexpr float THR = 8.0f;
    float mx = s[0];
#pragma unroll
    for (int r = 1; r < 16; ++r) mx = fmaxf(mx, s[r]);
    {
        auto rr = __builtin_amdgcn_permlane32_swap(__float_as_uint(mx), __float_as_uint(mx), false, false);
        mx = fmaxf(__uint_as_float(rr[0]), __uint_as_float(rr[1]));
    }
    mx -= m_run;
    if (first || __any(mx > THR)) {
        const float dl = first ? mx : fmaxf(mx, 0.f);
        m_run += dl;
        const float alpha = fexp2(-dl);
        l_run *= alpha;
#pragma unroll
        for (int db = 0; db < NDB; ++db)
#pragma unroll
            for (int r = 0; r < 16; ++r) O[db][r] *= alpha;
    }
    float rs = 0.f;
#pragma unroll
    for (int r = 0; r < 16; ++r) { s[r] = fexp2(s[r] - m_run); rs += s[r]; }
    l_run += rs;
    u32x4 w0, w1;
    w0.x = cvtpk(s[0], s[1]); w0.y = cvtpk(s[2], s[3]); w0.z = cvtpk(s[4], s[5]); w0.w = cvtpk(s[6], s[7]);
    w1.x = cvtpk(s[8], s[9]); w1.y = cvtpk(s[10], s[11]); w1.z = cvtpk(s[12], s[13]); w1.w = cvtpk(s[14], s[15]);
    p0 = __builtin_bit_cast(bf16x8, w0); p1 = __builtin_bit_cast(bf16x8, w1);
}
__device__ __forceinline__ void attn_pass_q2(const bf16x8 (&qfA)[4], const bf16x8 (&qfB)[4], const bf16_t* __restrict__ Kg, const bf16_t* __restrict__ Vg, const int NK, const int T,
                                             f32x16 (&OA)[2], f32x16 (&OB)[2], float& mA, float& lA, float& mB, float& lB, unsigned char* lds, const int tid) {
    constexpr int BUFB = 9216 + 64 * 144;
    const int lane = tid & 63, i = lane & 31, hi = lane >> 5;
    const int pi = (i & 0x13) | ((i & 4) << 1) | ((i & 8) >> 1);
    const int krow = tid >> 3, kch = tid & 7;
    const unsigned stK = krow * 144 + kch * 16;
    const unsigned rdK = pi * 144 + hi * 16, rdV = 9216 + i * 144 + hi * 16;
    u32x4 kreg, vreg;
    mA = 0.f; mB = 0.f;
    const unsigned kgo = (unsigned)(krow * 64 + kch * 8) * 2u, vgo = (unsigned)(krow * NK + kch * 8) * 2u;
#define LOADT2(kt) do { kreg = *(const u32x4*)((const char*)Kg + (size_t)(kt) * 8192 + kgo); vreg = *(const u32x4*)((const char*)Vg + (size_t)(kt) * 128 + vgo); } while (0)
#define STORET2(off) do { *(u32x4*)(lds + (off) + stK) = kreg; *(u32x4*)(lds + (off) + 9216 + stK) = vreg; } while (0)
#define QK2(SA, SB, kptr) do { bf16x8 kf_[4]; \
        _Pragma("unroll") for (int kk = 0; kk < 4; ++kk) kf_[kk] = *(const bf16x8*)((kptr) + kk * 32); \
        _Pragma("unroll") for (int r = 0; r < 16; ++r) { SA[r] = 0.f; SB[r] = 0.f; } \
        __builtin_amdgcn_s_setprio(1); \
        _Pragma("unroll") for (int kk = 0; kk < 4; ++kk) { SA = MFMA32(kf_[kk], qfA[kk], SA); SB = MFMA32(kf_[kk], qfB[kk], SB); } \
        __builtin_amdgcn_s_setprio(0); } while (0)
#define SMPV2(SA, SB, vptr, first) do { bf16x8 vf_[4], p0_, p1_; \
        _Pragma("unroll") for (int q = 0; q < 4; ++q) vf_[q] = *(const bf16x8*)((vptr) + (q >> 1) * 32 * 144 + (q & 1) * 32); \
        softmax1<2>(SA, OA, mA, lA, (first), p0_, p1_); \
        __builtin_amdgcn_s_setprio(1); \
        OA[0] = MFMA32(vf_[0], p0_, OA[0]); OA[1] = MFMA32(vf_[2], p0_, OA[1]); OA[0] = MFMA32(vf_[1], p1_, OA[0]); OA[1] = MFMA32(vf_[3], p1_, OA[1]); \
        __builtin_amdgcn_s_setprio(0); \
        softmax1<2>(SB, OB, mB, lB, (first), p0_, p1_); \
        __builtin_amdgcn_s_setprio(1); \
        OB[0] = MFMA32(vf_[0], p0_, OB[0]); OB[1] = MFMA32(vf_[2], p0_, OB[1]); OB[0] = MFMA32(vf_[1], p1_, OB[0]); OB[1] = MFMA32(vf_[3], p1_, OB[1]); \
        __builtin_amdgcn_s_setprio(0); } while (0)
    LOADT2(0); STORET2(0);
    { const int t1 = T > 1 ? 1 : T - 1; LOADT2(t1); } STORET2(BUFB);
    { const int t2 = T > 2 ? 2 : T - 1; LOADT2(t2); }
    asm volatile("s_waitcnt lgkmcnt(0)\n\ts_barrier" ::: "memory");
    unsigned o_cur = 0, o_nxt = BUFB, o_nn = 2 * BUFB;
    f32x16 sXA, sXB, sYA, sYB;
    QK2(sXA, sXB, lds + o_cur + rdK);
    for (int t = 0; t < T; ++t) {
        QK2(sYA, sYB, lds + o_cur + rdK + 32 * 144);
        __builtin_amdgcn_sched_barrier(0);
        SMPV2(sXA, sXB, lds + o_cur + rdV, t == 0);
        __builtin_amdgcn_sched_barrier(0);
        if (t + 1 < T) {
            asm volatile("s_waitcnt lgkmcnt(0)\n\ts_barrier" ::: "memory");
            STORET2(o_nn);
            { const int t3 = (t + 3 < T) ? t + 3 : T - 1; LOADT2(t3); }
            QK2(sXA, sXB, lds + o_nxt + rdK);
        }
        __builtin_amdgcn_sched_barrier(0);
        SMPV2(sYA, sYB, lds + o_cur + rdV + 64, false);
        __builtin_amdgcn_sched_barrier(0);
        { const unsigned tmp = o_cur; o_cur = o_nxt; o_nxt = o_nn; o_nn = tmp; }
    }
    asm volatile("s_waitcnt lgkmcnt(0)\n\ts_barrier" ::: "memory");
#undef LOADT2
#undef STORET2
#undef QK2
#undef SMPV2
}

__device__ __forceinline__ void attn_pass_w2(const bf16x8 (&qfA)[4], const bf16x8 (&qfB)[4], const bf16_t* __restrict__ Kg, const bf16_t* __restrict__ Vg, const int NK,
                                             const int lt_lo, const int lt_hi, const int qpos, const int wq0,
                                             f32x16 (&OA)[2], f32x16 (&OB)[2], float& mA, float& lA, float& mB, float& lB, unsigned char* lds, const int tid) {
    constexpr int BUFB = 9216 + 64 * 144;
    const int lane = tid & 63, i = lane & 31, hi = lane >> 5;
    const int pi = (i & 0x13) | ((i & 4) << 1) | ((i & 8) >> 1);
    const int krow = tid >> 3, kch = tid & 7;
    const int T = 4 + (lt_hi - lt_lo);
    const unsigned stK = krow * 144 + kch * 16;
    const unsigned rdK = pi * 144 + hi * 16, rdV = 9216 + i * 144 + hi * 16;
    const unsigned kgo = (unsigned)(krow * 64 + kch * 8) * 2u, vgo = (unsigned)(krow * NK + kch * 8) * 2u;
    u32x4 kregA, vregA;
    mA = 0.f; mB = 0.f;
#define TILE_W(it) ((it) < 4 ? (it) : lt_lo + ((it) - 4))
#define LOADW(KR, VR, kt) do { KR = *(const u32x4*)((const char*)Kg + (size_t)(kt) * 8192 + kgo); VR = *(const u32x4*)((const char*)Vg + (size_t)(kt) * 128 + vgo); } while (0)
#define STOREW(KR, VR, buf) do { *(u32x4*)(lds + (buf) * BUFB + stK) = KR; *(u32x4*)(lds + (buf) * BUFB + 9216 + stK) = VR; } while (0)
#define STEPW(it, KR, VR) do { \
        STOREW(KR, VR, ((it) + 1) & 1); \
        { const int i3_ = ((it) + 2 < T) ? (it) + 2 : T - 1; const int kt3_ = TILE_W(i3_); LOADW(KR, VR, kt3_); } \
        const int kt_ = TILE_W(it); \
        const bool mtile_ = (it) >= 4; \
        const int j0_ = kt_ * 64 - 256; \
        const bool active_ = !mtile_ || ((j0_ + 63 >= wq0 - 128) && (j0_ <= wq0 + 31 + 128)); \
        if (active_) { \
            const unsigned char* base = lds + ((it) & 1) * BUFB; \
            _Pragma("unroll") for (int kb = 0; kb < 2; ++kb) { \
                bf16x8 kf[4], vf[4]; \
                _Pragma("unroll") for (int kk = 0; kk < 4; ++kk) kf[kk] = *(const bf16x8*)(base + rdK + kb * 32 * 144 + kk * 32); \
                _Pragma("unroll") for (int q = 0; q < 4; ++q) vf[q] = *(const bf16x8*)(base + rdV + (q >> 1) * 32 * 144 + kb * 64 + (q & 1) * 32); \
                bf16x8 p0, p1; \
                { f32x16 sA; \
                  _Pragma("unroll") for (int r = 0; r < 16; ++r) sA[r] = 0.f; \
                  _Pragma("unroll") for (int kk = 0; kk < 4; ++kk) sA = MFMA32(kf[kk], qfA[kk], sA); \
                  if (mtile_) { int qd_ = qpos - j0_ - 32 * kb - 8 * hi; asm volatile("" : "+v"(qd_));     \
                      _Pragma("unroll") for (int r = 0; r < 16; ++r) { \
                          const int d0_ = qd_ - (16 * (r >> 3) + (r & 7)); \
                          if (d0_ > 128 || d0_ < -128) sA[r] = -1e30f; } } \
                  softmax1<2>(sA, OA, mA, lA, (it) == 0 && kb == 0, p0, p1); } \
                OA[0] = MFMA32(vf[0], p0, OA[0]); OA[1] = MFMA32(vf[2], p0, OA[1]); OA[0] = MFMA32(vf[1], p1, OA[0]); OA[1] = MFMA32(vf[3], p1, OA[1]); \
                { f32x16 sB; \
                  _Pragma("unroll") for (int r = 0; r < 16; ++r) sB[r] = 0.f; \
                  _Pragma("unroll") for (int kk = 0; kk < 4; ++kk) sB = MFMA32(kf[kk], qfB[kk], sB); \
                  if (mtile_) { int qd_ = qpos - j0_ - 32 * kb - 8 * hi; asm volatile("" : "+v"(qd_));     \
                      _Pragma("unroll") for (int r = 0; r < 16; ++r) { \
                          const int d0_ = qd_ - (16 * (r >> 3) + (r & 7)); \
                          if (d0_ > 128 || d0_ < -128) sB[r] = -1e30f; } } \
                  softmax1<2>(sB, OB, mB, lB, (it) == 0 && kb == 0, p0, p1); } \
                OB[0] = MFMA32(vf[0], p0, OB[0]); OB[1] = MFMA32(vf[2], p0, OB[1]); OB[0] = MFMA32(vf[1], p1, OB[0]); OB[1] = MFMA32(vf[3], p1, OB[1]); \
            } } \
        asm volatile("s_waitcnt lgkmcnt(0)\n\ts_barrier" ::: "memory"); } while (0)
    LOADW(kregA, vregA, 0);
    STOREW(kregA, vregA, 0);
    { const int kt1 = TILE_W(1); LOADW(kregA, vregA, kt1); }
    asm volatile("s_waitcnt lgkmcnt(0)\n\ts_barrier" ::: "memory");
    for (int it = 0; it < T; ++it) STEPW(it, kregA, vregA);
#undef TILE_W
#undef LOADW
#undef STOREW
#undef STEPW
}

__device__ __forceinline__ void unit_A2(const Params& p, int u, unsigned char* lds, int tid) {
    unsigned char* ws = p.ws;
    const bf16_t* Z = (const bf16_t*)(ws + WS_Z); bf16_t* Y = (bf16_t*)(ws + WS_XN);
    const int qb = u & 31, kv = (u >> 5) & 1, b = u >> 6;
    const int q0 = qb * 128;
    f32x16 OA[2], OB[2];
    float mA, lA = 0.f, mB, lB = 0.f;
    {
        const float* cosT = (const float*)(ws + WS_ROPE); const float* sinT = cosT + 1024;
        const int wave = tid >> 6, lane = tid & 63, i = lane & 31, hi = lane >> 5;
        const int hA = kv * 4 + 2 * (wave >> 2);
        const int wq0 = q0 + (wave & 3) * 32, qloc = wq0 + i;
        const bf16_t* zrow = Z + ((size_t)NCTXTOK + (size_t)b * 4096 + qloc) * PZ;
        bf16x8 qfA[4], qfB[4];
        load_q<false, true>(zrow + hA * 64, hi, nullptr, qloc, cosT, sinT, qfA);
        load_q<false, true>(zrow + hA * 64 + 64, hi, nullptr, qloc, cosT, sinT, qfB);
        const bf16_t* Kg = (const bf16_t*)(ws + L0_KA_LAT) + (size_t)(b * 2 + kv) * NKL * 64;
        const bf16_t* Vg = (const bf16_t*)(ws + L0_VTA_LAT) + (size_t)(b * 2 + kv) * 64 * NKL;
#pragma unroll
        for (int db = 0; db < 2; ++db)
#pragma unroll
            for (int r = 0; r < 16; ++r) { OA[db][r] = 0.f; OB[db][r] = 0.f; }
        const int tq = q0 >> 6;
        const int lo = 4 + (tq - 2 > 0 ? tq - 2 : 0), hiT = 4 + (tq + 4 < 64 ? tq + 4 : 64);
        attn_pass_w2(qfA, qfB, Kg, Vg, NKL, lo, hiT, qloc, wq0, OA, OB, mA, lA, mB, lB, lds, tid);
    }
    int t2 = threadIdx.x; asm volatile("" : "+v"(t2));
    const int wave = t2 >> 6, lane = t2 & 63, i = lane & 31, hi = lane >> 5;
    const int hA = kv * 4 + 2 * (wave >> 2), hB = hA + 1;
    const int qloc = q0 + (wave & 3) * 32 + i;
    const size_t tok = (size_t)NCTXTOK + (size_t)b * 4096 + qloc;
    const bf16_t* zrow = Z + tok * PZ;
    lA += __shfl_xor(lA, 32); lB += __shfl_xor(lB, 32);
    lA += fexp2(p.in[I_SINK][hA] * LOG2E - mA); lB += fexp2(p.in[I_SINK][hB] * LOG2E - mB);
    const float iA = 1.0f / lA, iB = 1.0f / lB;
#pragma unroll
    for (int db = 0; db < 2; ++db)
#pragma unroll
        for (int r = 0; r < 16; ++r) { OA[db][r] *= iA; OB[db][r] *= iB; }
    write_y<2>(OA, zrow + 2304 + hA * 64, Y + tok * DM + hA * 64, hi);
    write_y<2>(OB, zrow + 2304 + hB * 64, Y + tok * DM + hB * 64, hi);
}

__device__ __forceinline__ void unit_D2(const Params& p, int u, unsigned char* lds, int tid) {
    unsigned char* ws = p.ws;
    const bf16_t* Z = (const bf16_t*)(ws + WS_Z); bf16_t* Y = (bf16_t*)(ws + WS_XN);
    const float* cosT = (const float*)(ws + WS_ROPE); const float* sinT = cosT + 1024;
    const int qb = u & 7, hq = (u >> 3) & 7, b = u >> 6;
    const int kvh = hq >> 2, wave = tid >> 6, lane = tid & 63, i = lane & 31, hi = lane >> 5;
    const int qA = qb * 512 + wave * 64 + i, qB = qA + 32;
    const size_t tokA = (size_t)NCTXTOK + (size_t)b * 4096 + qA, tokB = tokA + 32;
    bf16x8 qfA[4], qfB[4];
    load_q<true, true>(Z + tokA * PZ + 1536 + hq * 64, hi, p.in[I_DQG], qA, cosT, sinT, qfA);
    load_q<true, true>(Z + tokB * PZ + 1536 + hq * 64, hi, p.in[I_DQG], qB, cosT, sinT, qfB);
    const bf16_t* Kg = (const bf16_t*)(ws + L1_KD_LAT) + (size_t)(b * 2 + kvh) * NKL * 64;
    const bf16_t* Vg = (const bf16_t*)(ws + L1_VTD_LAT) + (size_t)(b * 2 + kvh) * 64 * NKL;
    f32x16 OA[2], OB[2];
#pragma unroll
    for (int db = 0; db < 2; ++db)
#pragma unroll
        for (int r = 0; r < 16; ++r) { OA[db][r] = 0.f; OB[db][r] = 0.f; }
    float mA, lA = 0.f, mB, lB = 0.f;
    attn_pass_q2(qfA, qfB, Kg, Vg, NKL, NKL / 64, OA, OB, mA, lA, mB, lB, lds, tid);
    lA += __shfl_xor(lA, 32); lB += __shfl_xor(lB, 32);
    const float iA = 1.0f / lA, iB = 1.0f / lB;
#pragma unroll
    for (int db = 0; db < 2; ++db)
#pragma unroll
        for (int r = 0; r < 16; ++r) { OA[db][r] *= iA; OB[db][r] *= iB; }
    write_y<2>(OA, Z + tokA * PZ + 2816 + hq * 64, Y + tokA * DM + 512 + hq * 64, hi);
    write_y<2>(OB, Z + tokB * PZ + 2816 + hq * 64, Y + tokB * DM + 512 + hq * 64, hi);
}

template <bool LAT>
__device__ __forceinline__ void unit_A(const Params& p, int u, unsigned char* lds, int tid) {
    unsigned char* ws = p.ws;
    const bf16_t* Z = (const bf16_t*)(ws + WS_Z); bf16_t* Y = (bf16_t*)(ws + WS_XN);
    const float* cosT = (const float*)(ws + WS_ROPE); const float* sinT = cosT + 1024;
    int qb, hq, b;
    if (LAT) { qb = u & 15; hq = (u >> 4) & 7; b = u >> 7; } else { qb = 0; hq = u & 7; b = u >> 3; }
    const int kvh = hq >> 2, wave = tid >> 6, lane = tid & 63, i = lane & 31, hi = lane >> 5;
    const int q0 = qb * 256, qloc = q0 + wave * 32 + i;
    const size_t tok = LAT ? (size_t)NCTXTOK + (size_t)b * 4096 + qloc : (size_t)b * 256 + qloc;
    const bf16_t* zrow = Z + tok * PZ;
    bf16x8 qf[4];
    load_q<false, LAT>(zrow + hq * 64, hi, nullptr, qloc, cosT, sinT, qf);
    const int NK = LAT ? NKL : 256;
    const bf16_t* Kg = (const bf16_t*)(ws + (LAT ? L0_KA_LAT : L0_KA_CTX)) + (size_t)(b * 2 + kvh) * NK * 64;
    const bf16_t* Vg = (const bf16_t*)(ws + (LAT ? L0_VTA_LAT : L0_VTA_CTX)) + (size_t)(b * 2 + kvh) * 64 * NK;
    f32x16 O[2];
#pragma unroll
    for (int db = 0; db < 2; ++db)
#pragma unroll
        for (int r = 0; r < 16; ++r) O[db][r] = 0.f;
    float m = -1e30f, l = 0.f;
    if (LAT) {
        const int tq = q0 >> 6;
        const int lo = 4 + (tq - 2 > 0 ? tq - 2 : 0), hiT = 4 + (tq + 6 < 64 ? tq + 6 : 64);
        attn_pass<64, true>(qf, Kg, Vg, NK, 4, lo, hiT, qloc, q0 + wave * 32, O, m, l, lds, tid);
    } else {
        attn_pass<64, false>(qf, Kg, Vg, NK, 4, 0, 0, 0, 0, O, m, l, lds, tid);
    }
    l += __shfl_xor(l, 32);
    l += fexp2(p.in[I_SINK][hq] * LOG2E - m);
    const float inv = 1.0f / l;
#pragma unroll
    for (int db = 0; db < 2; ++db)
#pragma unroll
        for (int r = 0; r < 16; ++r) O[db][r] *= inv;
    write_y<2>(O, zrow + 2304 + hq * 64, Y + tok * DM + hq * 64, hi);
}

template <bool LAT>
__device__ __forceinline__ void unit_B(const Params& p, int u, unsigned char* lds, int tid) {
    unsigned char* ws = p.ws;
    const bf16_t* Z = (const bf16_t*)(ws + WS_Z); bf16_t* Y = (bf16_t*)(ws + WS_XN);
    const float* cosT = (const float*)(ws + WS_ROPE); const float* sinT = cosT + 1024;
    int qb, h, b;
    if (LAT) { qb = u & 15; h = (u >> 4) & 3; b = u >> 6; } else { qb = 0; h = u & 3; b = u >> 2; }
    const int wave = tid >> 6, lane = tid & 63, i = lane & 31, hi = lane >> 5;
    const int q0 = qb * 256, qloc = q0 + wave * 32 + i;
    const size_t tok = LAT ? (size_t)NCTXTOK + (size_t)b * 4096 + qloc : (size_t)b * 256 + qloc;
    const bf16_t* zrow = Z + tok * PZ;
    const int NK = LAT ? NKL : 256;
    const float lam = *(const float*)(ws + WS_LAM);
    const bf16_t* Vg = (const bf16_t*)(ws + (LAT ? L0_VTB_LAT : L0_VTB_CTX)) + (size_t)(b * 4 + h) * 128 * NK;
    f32x16 R[4];
#pragma unroll 1
    for (int pass = 0; pass < 2; ++pass) {
        bf16x8 qf[4];
        load_q<false, LAT>(zrow + 768 + h * 128 + pass * 64, hi, nullptr, qloc, cosT, sinT, qf);
        const size_t kb = LAT ? (pass ? L0_KB2_LAT : L0_KB1_LAT) : (pass ? L0_KB2_CTX : L0_KB1_CTX);
        const bf16_t* Kg = (const bf16_t*)(ws + kb) + (size_t)(b * 4 + h) * NK * 64;
#pragma unroll
        for (int db = 0; db < 4; ++db)
#pragma unroll
            for (int r = 0; r < 16; ++r) R[db][r] = 0.f;
        float m = -1e30f, l = 0.f;
        attn_pass<128, false>(qf, Kg, Vg, NK, NK / 64, 0, 0, 0, 0, R, m, l, lds, tid);
        l += __shfl_xor(l, 32);
        const float inv = 1.0f / l;
        unsigned* stash = (unsigned*)(lds + 55296 + wave * 8192) + lane;
        if (pass == 0) {
#pragma unroll
            for (int db = 0; db < 4; ++db)
#pragma unroll
                for (int r = 0; r < 8; ++r) stash[(db * 8 + r) * 64] = cvtpk(R[db][2 * r] * inv, R[db][2 * r + 1] * inv);
        } else {
            const float f = lam * inv;
#pragma unroll
            for (int db = 0; db < 4; ++db)
#pragma unroll
                for (int r = 0; r < 8; ++r) { const unsigned w = stash[(db * 8 + r) * 64]; R[db][2 * r] = bflo(w) - f * R[db][2 * r]; R[db][2 * r + 1] = bfhi(w) - f * R[db][2 * r + 1]; }
        }
    }
    float ss = 0.f;
#pragma unroll
    for (int db = 0; db < 4; ++db)
#pragma unroll
        for (int r = 0; r < 16; ++r) ss += R[db][r] * R[db][r];
    ss += __shfl_xor(ss, 32);
    const float rinv = rsqrtf(ss * (1.0f / 128.0f) + EPS) * 0.8f;
    const float* bng = p.in[I_BNG];
#pragma unroll
    for (int db = 0; db < 4; ++db)
#pragma unroll
        for (int g = 0; g < 4; ++g) {
            const f32x4 gg = *(const f32x4*)(bng + 32 * db + 8 * g + 4 * hi);
            R[db][4 * g] *= rinv * gg.x; R[db][4 * g + 1] *= rinv * gg.y; R[db][4 * g + 2] *= rinv * gg.z; R[db][4 * g + 3] *= rinv * gg.w;
        }
    write_y<4>(R, zrow + 2816 + h * 128, Y + tok * DM + 512 + h * 128, hi);
}

template <bool LAT>
__device__ __forceinline__ void unit_D(const Params& p, int u, unsigned char* lds, int tid) {
    unsigned char* ws = p.ws;
    const bf16_t* Z = (const bf16_t*)(ws + WS_Z); bf16_t* Y = (bf16_t*)(ws + WS_XN);
    const float* cosT = (const float*)(ws + WS_ROPE); const float* sinT = cosT + 1024;
    int qb, hq, b;
    if (LAT) { qb = u & 15; hq = (u >> 4) & 7; b = u >> 7; } else { qb = 0; hq = u & 7; b = u >> 3; }
    const int kvh = hq >> 2, wave = tid >> 6, lane = tid & 63, i = lane & 31, hi = lane >> 5;
    const int q0 = qb * 256, qloc = q0 + wave * 32 + i;
    const size_t tok = LAT ? (size_t)NCTXTOK + (size_t)b * 4096 + qloc : (size_t)b * 256 + qloc;
    const bf16_t* zrow = Z + tok * PZ;
    bf16x8 qf[4];
    load_q<true, LAT>(zrow + 1536 + hq * 64, hi, p.in[I_DQG], qloc, cosT, sinT, qf);
    const int NK = LAT ? NKL : 256;
    const bf16_t* Kg = (const bf16_t*)(ws + (LAT ? L1_KD_LAT : L1_KD_CTX)) + (size_t)(b * 2 + kvh) * NK * 64;
    const bf16_t* Vg = (const bf16_t*)(ws + (LAT ? L1_VTD_LAT : L1_VTD_CTX)) + (size_t)(b * 2 + kvh) * 64 * NK;
    f32x16 O[2];
#pragma unroll
    for (int db = 0; db < 2; ++db)
#pragma unroll
        for (int r = 0; r < 16; ++r) O[db][r] = 0.f;
    float m = -1e30f, l = 0.f;
    attn_pass<64, false>(qf, Kg, Vg, NK, NK / 64, 0, 0, 0, 0, O, m, l, lds, tid);
    l += __shfl_xor(l, 32);
    const float inv = 1.0f / l;
#pragma unroll
    for (int db = 0; db < 2; ++db)
#pragma unroll
        for (int r = 0; r < 16; ++r) O[db][r] *= inv;
    write_y<2>(O, zrow + 2816 + hq * 64, Y + tok * DM + 512 + hq * 64, hi);
}

template <bool LAT>
__device__ __forceinline__ void scan_unit(const Params& p, int u, int lane) {
    unsigned char* ws = p.ws;
    constexpr int NS = LAT ? 4096 : 256, NCH = LAT ? 32 : 2;
    const int db = u & 3, eb = (u >> 2) & 3, dir = (u >> 4) & 1, sh = u >> 5, h = sh & 3;
    const int i = lane & 31, hi = lane >> 5;
    const bf16_t* Kt = (const bf16_t*)(ws + (LAT ? L1_KTL : L1_KTC)) + (size_t)sh * 128 * NS + (size_t)(db * 8 * 64 + lane) * 8;
    const bf16_t* Vt = (const bf16_t*)(ws + (LAT ? L1_VTL : L1_VTC)) + (size_t)sh * 128 * NS + (size_t)(eb * 8 * 64 + lane) * 8;
    bf16_t* St = (bf16_t*)(ws + (LAT ? (dir ? L1_STB_L : L1_STF_L) : (dir ? L1_STB_C : L1_STF_C))) + (size_t)sh * NCH * 16384;
    const float lg2 = -expf(p.in[dir ? I_DECB : I_DECF][h]) * LOG2E;
    f32x16 acc;
    if (LAT) {
        const float* s0 = p.in[dir ? I_SCB : I_SCF] + (size_t)sh * 16384;
#pragma unroll
        for (int r = 0; r < 16; ++r) acc[r] = s0[(size_t)(db * 32 + i) * 128 + eb * 32 + crow(r, hi)];
    } else {
#pragma unroll
        for (int r = 0; r < 16; ++r) acc[r] = 0.f;
    }
    float base[8];
#pragma unroll
    for (int jj = 0; jj < 8; ++jj) base[jj] = KSCALE_C * (dir ? fexp2(lg2 * (float)(8 * hi + jj)) : fexp2(lg2 * (float)(127 - 8 * hi - jj)));
    const float step = dir ? fexp2(16.0f * lg2) : fexp2(-16.0f * lg2);
    const float cdec = fexp2(128.0f * lg2);
    u32x4 va[8], kb[8];
    {
        const int c0 = dir ? NCH - 1 : 0;
#pragma unroll
        for (int ks = 0; ks < 8; ++ks) { va[ks] = *(const u32x4*)(Vt + (size_t)c0 * 16384 + ks * 512); kb[ks] = *(const u32x4*)(Kt + (size_t)c0 * 16384 + ks * 512); }
    }
#pragma unroll 1
    for (int cc = 0; cc < NCH; ++cc) {
        const int c = dir ? NCH - 1 - cc : cc;
        const int cn = dir ? c - 1 : c + 1;
        const bool more = cc + 1 < NCH;
        bf16_t* So = St + (size_t)c * 16384;
#pragma unroll
        for (int r = 0; r < 16; ++r) So[(size_t)(((eb * 8 + 2 * db + (i >> 4)) * 64 + ((i >> 3) & 1) * 32 + crow(r, hi)) * 8 + (i & 7))] = (bf16_t)(cvtpk(acc[r], 0.f) & 0xffffu);
#pragma unroll
        for (int r = 0; r < 16; ++r) acc[r] *= cdec;
        float f[8];
#pragma unroll
        for (int jj = 0; jj < 8; ++jj) f[jj] = base[jj];
#pragma unroll
        for (int ks = 0; ks < 8; ++ks) {
            float v[8]; unpack8(va[ks], v);
#pragma unroll
            for (int jj = 0; jj < 8; ++jj) { v[jj] *= f[jj]; f[jj] *= step; }
            const bf16x8 a = __builtin_bit_cast(bf16x8, pack8(v));
            const bf16x8 bq = __builtin_bit_cast(bf16x8, kb[ks]);
            if (more) { va[ks] = *(const u32x4*)(Vt + (size_t)cn * 16384 + ks * 512); kb[ks] = *(const u32x4*)(Kt + (size_t)cn * 16384 + ks * 512); }
            acc = MFMA32(a, bq, acc);
        }
    }
    if (!LAT) {
        float* o = p.out + (dir ? O_CB : O_CF) + (size_t)sh * 16384;
#pragma unroll
        for (int r = 0; r < 16; ++r) o[(size_t)(db * 32 + i) * 128 + eb * 32 + crow(r, hi)] = acc[r];
    }
}

template <bool LAT>
__device__ __forceinline__ void retout_unit(const Params& p, int u, int lane) {
    unsigned char* ws = p.ws;
    constexpr int NS = LAT ? 4096 : 256, NCH = LAT ? 32 : 2;
    const bf16_t* Z = (const bf16_t*)(ws + WS_Z); bf16_t* Y = (bf16_t*)(ws + WS_XN);
    const int ib = u & 3, c = (u >> 2) % NCH, sh = (u >> 2) / NCH, h = sh & 3, seq = sh >> 2;
    const int i = lane & 31, hi = lane >> 5;
    const int pi = (i & 0x13) | ((i & 4) << 1) | ((i & 8) >> 1);
    const size_t tok0 = LAT ? (size_t)NCTXTOK + (size_t)seq * 4096 + c * 128 : (size_t)seq * 256 + c * 128;
    const int iloc = ib * 32 + i;
    const bf16_t* zq = Z + (tok0 + iloc) * PZ + h * 128;
    bf16x8 qf[8];
#pragma unroll
    for (int kk = 0; kk < 8; ++kk) qf[kk] = *(const bf16x8*)(zq + 16 * kk + 8 * hi);
    const float lgf2 = -expf(p.in[I_DECF][h]) * LOG2E, lgb2 = -expf(p.in[I_DECB][h]) * LOG2E;
    const bf16_t* Vt = (const bf16_t*)(ws + (LAT ? L1_VTL : L1_VTC)) + (size_t)sh * 128 * NS + (size_t)c * 16384;
    const bf16_t* SF = (const bf16_t*)(ws + (LAT ? L1_STF_L : L1_STF_C)) + ((size_t)sh * NCH + c) * 16384;
    const bf16_t* SB = (const bf16_t*)(ws + (LAT ? L1_STB_L : L1_STB_C)) + ((size_t)sh * NCH + c) * 16384;
    const char* zkU = LAT ? (const char*)(ws + kf_base(sh)) + (size_t)c * 32768 : (const char*)(Z + tok0 * PZ + 512 + h * 128);
    const unsigned zkL = LAT ? (unsigned)lane * 16u : (unsigned)(pi * PZ + 8 * hi) * 2u;
    constexpr unsigned kjs = LAT ? 8192u : (unsigned)(32 * PZ * 2), kks = LAT ? 1024u : 32u;
    const char* vtU = (const char*)Vt;
    const unsigned vtL = (unsigned)lane * 16u;
    const char* sfU = (const char*)SF; const char* sbU = (const char*)SB;
    const unsigned sL = (unsigned)lane * 16u;
    f32x16 O[4];
#pragma unroll
    for (int eb = 0; eb < 4; ++eb)
#pragma unroll
        for (int r = 0; r < 16; ++r) O[eb][r] = 0.f;
    bf16x8 fa[8], fb[8];
#pragma unroll
    for (int kk = 0; kk < 8; ++kk) fa[kk] = *(const bf16x8*)(zkU + kk * kks + zkL);
#pragma unroll
    for (int q = 0; q < 8; ++q) fb[q] = *(const bf16x8*)(vtU + (size_t)((q >> 1) * 8192 + (q & 1) * 1024) + vtL);
#pragma unroll 1
    for (int jb = 0; jb < 4; ++jb) {
        const bool lastj = (jb == 3);
        const char* nA = lastj ? sfU : zkU + (size_t)(jb + 1) * kjs;
        const unsigned nAL = lastj ? sL : zkL;
        const char* nB = lastj ? sbU : vtU + (size_t)2048 * (jb + 1);
        const unsigned nBL = lastj ? sL : vtL;
        const unsigned qs1 = 1024u, qs2 = lastj ? 2048u : 8192u;
        const unsigned kst = lastj ? 1024u : kks;
        f32x16 s;
#pragma unroll
        for (int r = 0; r < 16; ++r) s[r] = 0.f;
#pragma unroll
        for (int kk = 0; kk < 8; ++kk) {
            s = MFMA32(fa[kk], qf[kk], s);
            fa[kk] = *(const bf16x8*)(nA + (size_t)(kk * kst) + nAL);
        }
#pragma unroll
        for (int r = 0; r < 16; ++r) {
            const int j = 32 * jb + 16 * (r >> 3) + 8 * hi + (r & 7);
            const int dl = iloc - j;
            const float w = dl >= 0 ? fexp2(lgf2 * (float)dl) : fexp2(lgb2 * (float)(-dl - 1));
            s[r] *= w * KSCALE_C;
        }
        u32x4 w0, w1;
        w0.x = cvtpk(s[0], s[1]); w0.y = cvtpk(s[2], s[3]); w0.z = cvtpk(s[4], s[5]); w0.w = cvtpk(s[6], s[7]);
        w1.x = cvtpk(s[8], s[9]); w1.y = cvtpk(s[10], s[11]); w1.z = cvtpk(s[12], s[13]); w1.w = cvtpk(s[14], s[15]);
        const bf16x8 p0 = __builtin_bit_cast(bf16x8, w0), p1 = __builtin_bit_cast(bf16x8, w1);
#pragma unroll
        for (int q = 0; q < 8; ++q) {
            O[q >> 1] = MFMA32(fb[q], (q & 1) ? p1 : p0, O[q >> 1]);
            fb[q] = *(const bf16x8*)(nB + (size_t)((q & 1) * qs1 + (q >> 1) * qs2) + nBL);
        }
    }
    const float wf = fexp2(lgf2 * (float)(iloc + 1)), wb = fexp2(lgb2 * (float)(127 - iloc));
#pragma unroll 1
    for (int eb = 0; eb < 4; ++eb) {
        const int ebn = eb < 3 ? eb + 1 : 3;
        const char* nA = sfU + (size_t)ebn * 8192; const char* nB = sbU + (size_t)ebn * 8192;
        f32x16 xf, xb;
#pragma unroll
        for (int r = 0; r < 16; ++r) { xf[r] = 0.f; xb[r] = 0.f; }
#pragma unroll
        for (int kk = 0; kk < 8; ++kk) {
            xf = MFMA32(fa[kk], qf[kk], xf);
            fa[kk] = *(const bf16x8*)(nA + 1024 * kk + sL);
            xb = MFMA32(fb[kk], qf[kk], xb);
            fb[kk] = *(const bf16x8*)(nB + 1024 * kk + sL);
        }
#pragma unroll
        for (int e2 = 0; e2 < 4; ++e2)
            if (e2 == eb) {
#pragma unroll
                for (int r = 0; r < 16; ++r) O[e2][r] += wf * xf[r] + wb * xb[r];
            }
    }
    float sum = 0.f;
#pragma unroll
    for (int eb = 0; eb < 4; ++eb)
#pragma unroll
        for (int r = 0; r < 16; ++r) sum += O[eb][r];
    sum += __shfl_xor(sum, 32);
    const float mu = sum * (1.0f / 128.0f);
    float var = 0.f;
#pragma unroll
    for (int eb = 0; eb < 4; ++eb)
#pragma unroll
        for (int r = 0; r < 16; ++r) { O[eb][r] -= mu; var += O[eb][r] * O[eb][r]; }
    var += __shfl_xor(var, 32);
    const float rinv = rsqrtf(var * (1.0f / 128.0f) + EPS);
    const float* cng = p.in[I_CNG] + h * 128;
#pragma unroll
    for (int eb = 0; eb < 4; ++eb)
#pragma unroll
        for (int g = 0; g < 4; ++g) {
            const f32x4 gg = *(const f32x4*)(cng + 32 * eb + 8 * g + 4 * hi);
            O[eb][4 * g] *= rinv * gg.x; O[eb][4 * g + 1] *= rinv * gg.y; O[eb][4 * g + 2] *= rinv * gg.z; O[eb][4 * g + 3] *= rinv * gg.w;
        }
    const size_t tok = tok0 + iloc;
    write_y<4>(O, Z + tok * PZ + 2304 + h * 128, Y + tok * DM + h * 128, hi);
}

template <bool LAT>
__device__ __forceinline__ void retout_block(const Params& p, int sh, int c, unsigned char* lds, int tid) {
    unsigned char* ws = p.ws;
    constexpr int NS = LAT ? 4096 : 256, NCH = LAT ? 32 : 2;
    constexpr int KL = 0, VL = 34816, SFL = VL + 32768, SBL = SFL + 32768, RED = SBL + 32768;
    const bf16_t* Z = (const bf16_t*)(ws + WS_Z); bf16_t* Y = (bf16_t*)(ws + WS_XN);
    const int h = sh & 3, seq = sh >> 2;
    const int lane = tid & 63, wave = tid >> 6, i = lane & 31, hi = lane >> 5, ib = wave & 3, eh = wave >> 2;
    const int pi = (i & 0x13) | ((i & 4) << 1) | ((i & 8) >> 1);
    const size_t tok0 = LAT ? (size_t)NCTXTOK + (size_t)seq * 4096 + c * 128 : (size_t)seq * 256 + c * 128;
    const int iloc = ib * 32 + i;
    {
        const bf16_t* ksrc = Z + (tok0 + (tid >> 2)) * PZ + 512 + h * 128 + (tid & 3) * 32;
        const char* vsrc = (const char*)((const bf16_t*)(ws + (LAT ? L1_VTL : L1_VTC)) + (size_t)sh * 128 * NS + (size_t)c * 16384);
        const char* fsrc = (const char*)((const bf16_t*)(ws + (LAT ? L1_STF_L : L1_STF_C)) + ((size_t)sh * NCH + c) * 16384);
        const char* bsrc = (const char*)((const bf16_t*)(ws + (LAT ? L1_STB_L : L1_STB_C)) + ((size_t)sh * NCH + c) * 16384);
        u32x4 kr[4], vr[4], fr[4], br[4];
#pragma unroll
        for (int q = 0; q < 4; ++q) {
            kr[q] = *(const u32x4*)(ksrc + q * 8);
            vr[q] = *(const u32x4*)(vsrc + (size_t)(tid + 512 * q) * 16);
            fr[q] = *(const u32x4*)(fsrc + (size_t)(tid + 512 * q) * 16);
            br[q] = *(const u32x4*)(bsrc + (size_t)(tid + 512 * q) * 16);
        }
        __syncthreads();
#pragma unroll
        for (int q = 0; q < 4; ++q) {
            *(u32x4*)(lds + KL + (tid >> 2) * 272 + (tid & 3) * 64 + q * 16) = kr[q];
            *(u32x4*)(lds + VL + (tid + 512 * q) * 16) = vr[q];
            *(u32x4*)(lds + SFL + (tid + 512 * q) * 16) = fr[q];
            *(u32x4*)(lds + SBL + (tid + 512 * q) * 16) = br[q];
        }
    }
    bf16x8 qf[8];
    {
        const bf16_t* zq = Z + (tok0 + iloc) * PZ + h * 128;
#pragma unroll
        for (int kk = 0; kk < 8; ++kk) qf[kk] = *(const bf16x8*)(zq + 16 * kk + 8 * hi);
    }
    const float lgf2 = -expf(p.in[I_DECF][h]) * LOG2E, lgb2 = -expf(p.in[I_DECB][h]) * LOG2E;
    __syncthreads();
    f32x16 O[2];
#pragma unroll
    for (int e2 = 0; e2 < 2; ++e2)
#pragma unroll
        for (int r = 0; r < 16; ++r) O[e2][r] = 0.f;
    const unsigned char* kbase = lds + KL + pi * 272 + hi * 16;
    const unsigned char* vbase = lds + VL + (2 * eh) * 8192 + lane * 16;
#pragma unroll 1
    for (int jb = 0; jb < 4; ++jb) {
        f32x16 s;
#pragma unroll
        for (int r = 0; r < 16; ++r) s[r] = 0.f;
#pragma unroll
        for (int kk = 0; kk < 8; ++kk) s = MFMA32(*(const bf16x8*)(kbase + jb * 32 * 272 + kk * 32), qf[kk], s);
#pragma unroll
        for (int r = 0; r < 16; ++r) {
            const int j = 32 * jb + 16 * (r >> 3) + 8 * hi + (r & 7);
            const int dl = iloc - j;
            const float w = dl >= 0 ? fexp2(lgf2 * (float)dl) : fexp2(lgb2 * (float)(-dl - 1));
            s[r] *= w * KSCALE_C;
        }
        u32x4 w0, w1;
        w0.x = cvtpk(s[0], s[1]); w0.y = cvtpk(s[2], s[3]); w0.z = cvtpk(s[4], s[5]); w0.w = cvtpk(s[6], s[7]);
        w1.x = cvtpk(s[8], s[9]); w1.y = cvtpk(s[10], s[11]); w1.z = cvtpk(s[12], s[13]); w1.w = cvtpk(s[14], s[15]);
        const bf16x8 p0 = __builtin_bit_cast(bf16x8, w0), p1 = __builtin_bit_cast(bf16x8, w1);
#pragma unroll
        for (int e2 = 0; e2 < 2; ++e2) {
            O[e2] = MFMA32(*(const bf16x8*)(vbase + e2 * 8192 + jb * 2048), p0, O[e2]);
            O[e2] = MFMA32(*(const bf16x8*)(vbase + e2 * 8192 + jb * 2048 + 1024), p1, O[e2]);
        }
    }
    const float wf = fexp2(lgf2 * (float)(iloc + 1)), wb = fexp2(lgb2 * (float)(127 - iloc));
#pragma unroll
    for (int e2 = 0; e2 < 2; ++e2) {
        f32x16 xf, xb;
#pragma unroll
        for (int r = 0; r < 16; ++r) { xf[r] = 0.f; xb[r] = 0.f; }
        const unsigned char* sf = lds + SFL + (2 * eh + e2) * 8192 + lane * 16;
        const unsigned char* sb = lds + SBL + (2 * eh + e2) * 8192 + lane * 16;
#pragma unroll
        for (int kk = 0; kk < 8; ++kk) {
            xf = MFMA32(*(const bf16x8*)(sf + kk * 1024), qf[kk], xf);
            xb = MFMA32(*(const bf16x8*)(sb + kk * 1024), qf[kk], xb);
        }
#pragma unroll
        for (int r = 0; r < 16; ++r) O[e2][r] += wf * xf[r] + wb * xb[r];
    }
    float s1 = 0.f, s2 = 0.f;
#pragma unroll
    for (int e2 = 0; e2 < 2; ++e2)
#pragma unroll
        for (int r = 0; r < 16; ++r) { s1 += O[e2][r]; s2 += O[e2][r] * O[e2][r]; }
    s1 += __shfl_xor(s1, 32); s2 += __shfl_xor(s2, 32);
    float* red = (float*)(lds + RED);
    if (hi == 0) { red[(eh * 128 + iloc) * 2] = s1; red[(eh * 128 + iloc) * 2 + 1] = s2; }
    __syncthreads();
    {
        const float o1 = red[((1 - eh) * 128 + iloc) * 2], o2 = red[((1 - eh) * 128 + iloc) * 2 + 1];
        s1 += o1; s2 += o2;
    }
    const float mu = s1 * (1.0f / 128.0f);
    const float var = fmaxf(s2 * (1.0f / 128.0f) - mu * mu, 0.f);
    const float rinv = rsqrtf(var + EPS);
    const float* cng = p.in[I_CNG] + h * 128 + 64 * eh;
#pragma unroll
    for (int e2 = 0; e2 < 2; ++e2)
#pragma unroll
        for (int g = 0; g < 4; ++g) {
            const f32x4 gg = *(const f32x4*)(cng + 32 * e2 + 8 * g + 4 * hi);
            O[e2][4 * g] = (O[e2][4 * g] - mu) * rinv * gg.x; O[e2][4 * g + 1] = (O[e2][4 * g + 1] - mu) * rinv * gg.y;
            O[e2][4 * g + 2] = (O[e2][4 * g + 2] - mu) * rinv * gg.z; O[e2][4 * g + 3] = (O[e2][4 * g + 3] - mu) * rinv * gg.w;
        }
    const size_t tok = tok0 + iloc;
    write_y<2>(O, Z + tok * PZ + 2304 + h * 128 + 64 * eh, Y + tok * DM + h * 128 + 64 * eh, hi);
}

__global__ void __launch_bounds__(512) mega_fwd(Params p) {
    extern __shared__ __attribute__((aligned(16))) unsigned char lds[];
    cg::grid_group grid = cg::this_grid();
    const int blk = blockIdx.x, G = gridDim.x;
    const int vb = (G % 8 == 0) ? (blk % 8) * (G / 8) + blk / 8 : blk;
    const int NGW = G * 8;
    unsigned char* ws = p.ws;
    bf16_t* XN = (bf16_t*)(ws + WS_XN); bf16_t* Zb = (bf16_t*)(ws + WS_Z);
    const float* mod0 = (const float*)(ws + WS_MOD); const float* mod1 = mod0 + 9 * 3072;
    LAS unsigned char* lds3 = (LAS unsigned char*)lds;
#define FRESH() int tid = threadIdx.x; asm volatile("" : "+v"(tid)); const int lane = tid & 63, wave = __builtin_amdgcn_readfirstlane(tid >> 6), gw = blk * 8 + wave; (void)lane; (void)gw;

    unsigned* barw = (unsigned*)(ws + WS_BAR);
    volatile LAS unsigned* bst = (volatile LAS unsigned*)(lds3 + LDS_BAR);
    if (threadIdx.x < 2) bst[threadIdx.x] = 0u;
    if (blk == 0) for (int w = threadIdx.x; w < XCD_BAR_WORDS; w += 512) barw[w] = 0u;
    __syncthreads();
    for (int rs_ = 0; rs_ < REP_SM; ++rs_) { FRESH(); phase0(p, lds, tid, blk, G); __syncthreads(); }
    grid.sync();
    XcdBarrier bar = xcd_barrier_post(barw, bst);
#define GSYNC() xcd_barrier(bar)
    for (int rs_ = 0; rs_ < REP_SM; ++rs_) { FRESH(); adaln_rows(p.in[I_XP], p.in[I_XS], p.in[I_NORMG], mod0, XN, gw, NGW, lane); }
    GSYNC();
    for (int rg_ = 0; rg_ < REP_G2; ++rg_) {
        pg8::Gemm g{XN, (const bf16_t*)(ws + WS_WIN_AB), MTOT, PZ, DM}; pg8::StaticOrder S; S.init(MTOT, PZ, G, blk);
        pg8::EpiBf16<0> E{Zb, PZ, nullptr, 0, 0, 1.f};
        pg8::gemm_phase<pg8::EpiBf16<0>, pg8::StaticOrder, true, true>(lds3, g, S, E);
    }
    GSYNC();
    for (int rs_ = 0; rs_ < REP_PREP; ++rs_) { FRESH(); prep_layer0(p, lds, tid, blk, G); }
    GSYNC();
    for (int rep_ = 0; rep_ < REP_P4; ++rep_) {
        if (PHM & 16) { FRESH(); for (int u = vb; u < 512; u += G) unit_B<true>(p, u, lds, tid); }
        for (int ra_ = 0; ra_ < REP_A; ++ra_) { FRESH(); for (int u = vb; u < 512; u += G) unit_A2(p, u, lds, tid); }
        if (PHM & 64) { FRESH(); for (int u = vb; u < 128; u += G) unit_A<false>(p, u, lds, tid); }
        if (PHM & 128) { FRESH(); for (int u = (vb + 8 * G - 128) % G; u < 64; u += G) unit_B<false>(p, u, lds, tid); }
    }
    GSYNC();
    if (PHM & 256) {
        pg8::Gemm g{XN, (const bf16_t*)(ws + WS_WOUT_AB), MTOT, DM, DM}; pg8::StaticOrder S; S.init(MTOT, DM, G, blk);
        EpiResid E{p.in[I_XP], p.in[I_XS], p.out, mod0};
        pg8::gemm_phase<EpiResid, pg8::StaticOrder, true, true>(lds3, g, S, E);
    }
    GSYNC();
    for (int rs_ = 0; rs_ < REP_SM; ++rs_) { FRESH(); adaln_rows(p.out, p.out + (size_t)NCTXTOK * DM, p.in[I_NORMG] + DM, mod1, XN, gw, NGW, lane); }
    GSYNC();
    {
        pg8::Gemm g{XN, (const bf16_t*)(ws + WS_WIN_CD), MTOT, PZ, DM}; pg8::StaticOrder S; S.init(MTOT, PZ, G, blk);
        pg8::EpiBf16<0> E{Zb, PZ, nullptr, 0, 0, 1.f};
        pg8::gemm_phase<pg8::EpiBf16<0>, pg8::StaticOrder, true, true>(lds3, g, S, E);
    }
    GSYNC();
    for (int rs_ = 0; rs_ < REP_PREP; ++rs_) { FRESH(); prep_layer1(p, lds, tid, blk, G); }
    GSYNC();
    for (int rs_ = 0; rs_ < REP_SCAN; ++rs_) {
        FRESH(); const int sw = wave * G + blk;
        for (int u = sw; u < 1024 + 2048; u += NGW) { if (u < 1024) scan_unit<true>(p, u, lane); else scan_unit<false>(p, u - 1024, lane); }
    }
    GSYNC();
    for (int rep_ = 0; rep_ < REP_P10; ++rep_) {
        if (PHM & 2048) { FRESH(); for (int u = vb; u < 512; u += G) unit_D2(p, u, lds, tid); }
        if (PHM & 2048) { FRESH(); for (int u = (vb + 8 * G - 128) % G; u < 128; u += G) unit_D<false>(p, u, lds, tid); }
        for (int rr_ = 0; rr_ < REP_RET; ++rr_) { FRESH();
            for (int u = vb; u < 1152; u += G) { if (u < 1024) retout_block<true>(p, u >> 5, u & 31, lds, tid); else retout_block<false>(p, (u - 1024) >> 1, (u - 1024) & 1, lds, tid); }
            __syncthreads(); }
    }
    GSYNC();
    {
        pg8::Gemm g{XN, (const bf16_t*)(ws + WS_WOUT_CD), MTOT, DM, DM}; pg8::StaticOrder S; S.init(MTOT, DM, G, blk);
        EpiResid E{p.out, p.out + (size_t)NCTXTOK * DM, p.out, mod1};
        pg8::gemm_phase<EpiResid, pg8::StaticOrder, true, true>(lds3, g, S, E);
    }
    GSYNC();
    { FRESH(); final_rows(p.out, p.in[I_FING], gw, NGW, lane); }
}

extern "C" void kernel_launch(void* const* d_in, const int* in_sizes, int n_in, void* d_out, int out_size, void* d_ws, size_t ws_size, hipStream_t stream) {
    static int grid = 0;
    if (grid == 0) {
        if (n_in != 31 || (size_t)out_size != O_END || ws_size < WS_NEED) {
            fprintf(stderr, "kernel_launch: unexpected problem: n_in %d out %d ws %zu (need %zu)\n", n_in, out_size, ws_size, (size_t)WS_NEED); grid = -1; return; }
        int dev = 0, cus = 0, per_cu = 0;
        hipGetDevice(&dev);
        hipDeviceGetAttribute(&cus, hipDeviceAttributeMultiprocessorCount, dev);
        if (hipFuncSetAttribute((const void*)mega_fwd, hipFuncAttributeMaxDynamicSharedMemorySize, LDS_BYTES) != hipSuccess) { fprintf(stderr, "kernel_launch: hipFuncSetAttribute failed\n"); }
        if (hipOccupancyMaxActiveBlocksPerMultiprocessor(&per_cu, (const void*)mega_fwd, 512, LDS_BYTES) != hipSuccess || per_cu < 1) { fprintf(stderr, "kernel_launch: occupancy query gave %d\n", per_cu); per_cu = 1; }
        (void)hipGetLastError();
        if (per_cu > 1) per_cu = 1;
        grid = cus * per_cu;
    }
    if (grid < 0) return;
    Params p{};
    for (int i = 0; i < 31; ++i) p.in[i] = (const float*)d_in[i];
    p.out = (float*)d_out; p.ws = (unsigned char*)d_ws;
    void* args[] = {&p};
    hipError_t e = hipLaunchCooperativeKernel((const void*)mega_fwd, dim3(grid), dim3(512), args, LDS_BYTES, stream);
    if (e != hipSuccess) fprintf(stderr, "kernel_launch: cooperative launch failed: %s (grid %d)\n", hipGetErrorString(e), grid);
}
```

```cpp
#include <hip/hip_runtime.h>
#include <hip/hip_cooperative_groups.h>
#include <cstdio>
#include <cstdint>
namespace cg = cooperative_groups;
namespace pg8 {
#define PG8_LAS __attribute__((address_space(3)))
typedef unsigned short bf16_t;
typedef short bf16x8 __attribute__((ext_vector_type(8)));
typedef float f32x4 __attribute__((ext_vector_type(4)));
typedef unsigned u32x4 __attribute__((ext_vector_type(4)));
constexpr int BM = 256, BK = 64, HALF = 128, HTB = HALF * BK * 2  , STAGE_BYTES = 8 * HTB, NXCD = 8, WGM = 8;

__host__ __device__ __forceinline__ int lds_byte(int r, int c) { const int st = (r >> 4) * 2 + (c >> 5), rr = r & 15, cc = c & 31, ob = rr * 64 + cc * 2; return st * 1024 + (ob ^ (((ob >> 9) & 1) << 5)); }
__host__ __device__ __forceinline__ void stage_rc(int b, int& R, int& C) { const int st = b / 1024, sb = b % 1024, swz = sb ^ (((sb >> 9) & 1) << 5); R = (st >> 1) * 16 + swz / 64; C = (st & 1) * 32 + (swz % 64) / 2; }
__host__ __device__ __forceinline__ int perm32(int rho) { const int n = rho >> 4, i = rho & 15; return 8 * (i >> 2) + 4 * n + (i & 3); }

struct Unit { int pm, pn; };
struct Gemm { const bf16_t* A; const bf16_t* Bt; int M, N, K; };

struct StaticOrder {
    int nM, nN, nwg, G, c;
    __host__ __device__ void init(int M, int N, int G_, int c_) { nM = M / BM; nN = N / BM; nwg = nM * nN; G = G_; c = c_; }
    __host__ __device__ bool next(int i, Unit& u) const {
        const long L = (long)i * G + c; if (L >= nwg) return false;
        int wgid = (int)L; { const int q = nwg / NXCD, r = nwg % NXCD, xcd = wgid % NXCD, off = wgid / NXCD; wgid = (xcd < r ? xcd * (q + 1) : r * (q + 1) + (xcd - r) * q) + off; }
        const int nig = WGM * nN, gid = wgid / nig, fm = gid * WGM, gsz = (nM - fm) < WGM ? (nM - fm) : WGM;
        u.pm = fm + ((wgid % nig) % gsz); u.pn = (wgid % nig) / gsz; return true;
    }
    __device__ __forceinline__ void a_ready(const Unit&) const {}
    __device__ __forceinline__ void done(const Unit&) const {}
};

__device__ __forceinline__ unsigned cvt_pk_bf16(float lo, float hi) { unsigned r; asm volatile("v_cvt_pk_bf16_f32 %0, %1, %2" : "=v"(r) : "v"(lo), "v"(hi)); return r; }
typedef float f32x2 __attribute__((ext_vector_type(2)));
__device__ __forceinline__ f32x2 gelu_pk(f32x2 v) {
    const f32x2 av = __builtin_elementwise_abs(v), d = av * 0.2316418882f + 1.0f;
    f32x2 t; t.x = __builtin_amdgcn_rcpf(d.x); t.y = __builtin_amdgcn_rcpf(d.y);
    f32x2 q = t * 0.5307027145f + (-0.7265760135f); q = q * t + 0.7107068705f; q = q * t + (-0.142248368f); q = q * t + 0.127414796f; q = q * t;
    const f32x2 s = (v * v) * (-0.72134752044f);
    f32x2 e; e.x = __builtin_amdgcn_exp2f(s.x); e.y = __builtin_amdgcn_exp2f(s.y);
    const f32x2 m = v * (q * e), r = v - m;
    f32x2 o; o.x = v.x < 0.f ? m.x : r.x; o.y = v.y < 0.f ? m.y : r.y; return o;
}

template <int ACT  > struct EpiBf16 {
    static constexpr bool PERM = true, AFTER_DRAIN = false; static_assert(ACT == 0 || ACT == 1, "EpiBf16: ACT is 0 (none) or 1 (gelu_pk)");
    bf16_t* O; int ldc; const float* bias; int split_cols; size_t split_stride; float scale0;
    __device__ __forceinline__ void operator()(const f32x4 (&acc)[2][2][4][2], const Unit& u, int wr, int wc, int fr, int fq) const {
        const int row0 = u.pm * BM + wr * 64 + fr; int colt = u.pn * BM; bf16_t* base = O;
        float sc = 1.f; if (split_cols) { const int t = colt / split_cols; base += (size_t)t * split_stride; colt -= t * split_cols; if (t == 0) sc = scale0; }
        const int col0 = colt + wc * 32 + 8 * fq, bcol0 = u.pn * BM + wc * 32 + 8 * fq;
        f32x4 bv[2][2];
#pragma unroll
        for (int bj = 0; bj < 2; ++bj)
#pragma unroll
            for (int n = 0; n < 2; ++n) bv[bj][n] = bias ? *(const f32x4*)(bias + bcol0 + bj * HALF + 4 * n) : (f32x4){0.f, 0.f, 0.f, 0.f};
#pragma unroll
        for (int ai = 0; ai < 2; ++ai)
#pragma unroll
            for (int m = 0; m < 4; ++m) { bf16_t* rowp = base + (size_t)(row0 + ai * HALF + m * 16) * ldc + col0;
#pragma unroll
                for (int bj = 0; bj < 2; ++bj) { f32x4 v0 = acc[ai][bj][m][0] + bv[bj][0], v1 = acc[ai][bj][m][1] + bv[bj][1];
                    if (ACT == 1) { f32x2 a = gelu_pk((f32x2){v0[0], v0[1]}), b = gelu_pk((f32x2){v0[2], v0[3]}), c = gelu_pk((f32x2){v1[0], v1[1]}), d = gelu_pk((f32x2){v1[2], v1[3]});
                        v0 = (f32x4){a.x, a.y, b.x, b.y}; v1 = (f32x4){c.x, c.y, d.x, d.y}; }
                    v0 = v0 * sc; v1 = v1 * sc; u32x4 w; w.x = cvt_pk_bf16(v0[0], v0[1]); w.y = cvt_pk_bf16(v0[2], v0[3]); w.z = cvt_pk_bf16(v1[0], v1[1]); w.w = cvt_pk_bf16(v1[2], v1[3]);
                    __builtin_nontemporal_store(w, (u32x4*)(rowp + bj * HALF)); } }
    }
};
template <class Epi, class Sched, bool ALIGN_EPI = false, bool SP2 = false>
__device__ __forceinline__ void gemm_phase(PG8_LAS unsigned char* lds, const Gemm g, const Sched& S, const Epi& E) {
    int tid_l = threadIdx.x; asm volatile("" : "+v"(tid_l));
    const int tid = tid_l, wid = __builtin_amdgcn_readfirstlane(tid >> 6), lane = tid & 63, wr = wid >> 2, wc = wid & 3, fr = lane & 15, fq = lane >> 4;
    const int K = g.K, nt = K / BK;
    unsigned voffA[2], voffB[2];
#pragma unroll
    for (int i = 0; i < 2; ++i) { int R, C; stage_rc(tid * 16 + i * 8192, R, C); const int Rb = Epi::PERM ? ((R & ~31) + perm32(R & 31)) : R;
        voffA[i] = (unsigned)(R * K + C) * 2u; voffB[i] = (unsigned)(Rb * K + C) * 2u; }
    const size_t kstep = (size_t)(BK * 2);
    const size_t hstep = (size_t)HALF * K * 2;
    const size_t tstep = 2 * hstep;
    const unsigned ldsw = (unsigned)wid * 1024u;
    const int aoff = lds_byte(wr * 64 + fr, fq * 8), boff = lds_byte(wc * 32 + fr, fq * 8);
#define PG8_SA(b, h) (((b) * 2 + (h)) * HTB)
#define PG8_SB(b, h) ((4 + (b) * 2 + (h)) * HTB)
#define PG8_STAGE(bufoff, gbase, voff) do { _Pragma("unroll") for (int _i = 0; _i < 2; ++_i) \
        __builtin_amdgcn_global_load_lds((const unsigned*)((const char*)(gbase) + (voff)[_i]), (PG8_LAS unsigned*)(lds + (bufoff) + ldsw + _i * 8192), 16, 0, 0); } while (0)
#define PG8_LDA(dst, b, h) do { _Pragma("unroll") for (int m = 0; m < 4; ++m) _Pragma("unroll") for (int k = 0; k < 2; ++k) dst[m][k] = *(const PG8_LAS bf16x8*)(lds + PG8_SA(b, h) + aoff + m * 2048 + k * 1024); } while (0)
#define PG8_LDB(dst, b, h) do { _Pragma("unroll") for (int n = 0; n < 2; ++n) _Pragma("unroll") for (int k = 0; k < 2; ++k) dst[n][k] = *(const PG8_LAS bf16x8*)(lds + PG8_SB(b, h) + boff + n * 2048 + k * 1024); } while (0)
#define PG8_MMA(ai, bj, At, Bt) do { __builtin_amdgcn_s_setprio(1); _Pragma("unroll") for (int m = 0; m < 4; ++m) _Pragma("unroll") for (int n = 0; n < 2; ++n) _Pragma("unroll") for (int k = 0; k < 2; ++k) \
        acc[ai][bj][m][n] = __builtin_amdgcn_mfma_f32_16x16x32_bf16(Bt[n][k], At[m][k], acc[ai][bj][m][n], 0, 0, 0); __builtin_amdgcn_s_setprio(0); } while (0)
#define PG8_WAIT_V(n) asm volatile("s_waitcnt vmcnt(" #n ")" ::: "memory")
#define PG8_WAIT_L(n) asm volatile("s_waitcnt lgkmcnt(" #n ")" ::: "memory")
#define PG8_BAR __builtin_amdgcn_s_barrier()
#define PG8_SCHED __builtin_amdgcn_sched_barrier(0)
    Unit cur, nxt; int ui = 0;
    if (!S.next(0, cur)) return;
    f32x4 acc[2][2][4][2];
#pragma unroll
    for (int a = 0; a < 2; ++a)
#pragma unroll
        for (int b = 0; b < 2; ++b)
#pragma unroll
            for (int m = 0; m < 4; ++m)
#pragma unroll
                for (int n = 0; n < 2; ++n) acc[a][b][m][n] = (f32x4){0.f, 0.f, 0.f, 0.f};
    bf16x8 At[4][2], B0[2][2], B1[2][2];
    const char* cA = (const char*)g.A + (size_t)cur.pm * tstep; const char* cB = (const char*)g.Bt + (size_t)cur.pn * tstep;
    S.a_ready(cur);
    if constexpr (SP2) {
        PG8_STAGE(PG8_SB(0, 0), cB, voffB); PG8_STAGE(PG8_SB(0, 1), cB + hstep, voffB); PG8_STAGE(PG8_SA(0, 0), cA, voffA); PG8_STAGE(PG8_SA(0, 1), cA + hstep, voffA);
        if (wr == 1) PG8_BAR;
        PG8_WAIT_V(2); PG8_BAR;
        PG8_STAGE(PG8_SB(1, 0), cB + kstep, voffB); PG8_STAGE(PG8_SA(1, 0), cA + kstep, voffA); PG8_STAGE(PG8_SB(1, 1), cB + hstep + kstep, voffB);
        PG8_WAIT_V(6); PG8_BAR;
    } else {
        PG8_STAGE(PG8_SB(0, 0), cB, voffB); PG8_STAGE(PG8_SA(0, 0), cA, voffA); PG8_STAGE(PG8_SB(0, 1), cB + hstep, voffB); PG8_STAGE(PG8_SA(0, 1), cA + hstep, voffA);
        if (wr == 1) PG8_BAR;
        PG8_WAIT_V(4); PG8_BAR;
        PG8_STAGE(PG8_SB(1, 0), cB + kstep, voffB); PG8_STAGE(PG8_SA(1, 0), cA + kstep, voffA); PG8_STAGE(PG8_SB(1, 1), cB + hstep + kstep, voffB);
        PG8_WAIT_V(6); PG8_BAR;
    }
    for (;;) {
        const bool has_next = S.next(ui + 1, nxt);
        const char* nA = has_next ? (const char*)g.A + (size_t)nxt.pm * tstep : cA; const char* nB = has_next ? (const char*)g.Bt + (size_t)nxt.pn * tstep : cB;
        for (int t = 0; t < nt; t += 2) {
            const bool last = (t == nt - 2);
            const char* a1 = cA + (size_t)(t + 1) * kstep;
            const char* a2 = last ? nA : cA + (size_t)(t + 2) * kstep; const char* b2 = last ? nB : cB + (size_t)(t + 2) * kstep;
            const char* a3 = a2 + kstep; const char* b3 = b2 + kstep;
            if (last && has_next) S.a_ready(nxt);
            if constexpr (SP2) {
            PG8_LDB(B0, 0, 0); PG8_LDB(B1, 0, 1); PG8_SCHED; PG8_LDA(At, 0, 0); PG8_STAGE(PG8_SA(1, 1), a1 + hstep, voffA);
            PG8_WAIT_V(8); PG8_WAIT_L(0); PG8_BAR; PG8_MMA(0, 0, At, B0); PG8_MMA(0, 1, At, B1); PG8_BAR; PG8_SCHED;
            PG8_LDA(At, 0, 1); PG8_STAGE(PG8_SB(0, 0), b2, voffB); PG8_STAGE(PG8_SB(0, 1), b2 + hstep, voffB); PG8_STAGE(PG8_SA(0, 0), a2, voffA);
            PG8_WAIT_V(8); PG8_WAIT_L(0); PG8_BAR; PG8_MMA(1, 0, At, B0); PG8_MMA(1, 1, At, B1); PG8_BAR; PG8_SCHED;
            PG8_LDB(B0, 1, 0); PG8_LDB(B1, 1, 1); PG8_SCHED; PG8_LDA(At, 1, 0); PG8_STAGE(PG8_SA(0, 1), a2 + hstep, voffA);
            PG8_WAIT_V(8); PG8_WAIT_L(0); PG8_BAR; PG8_MMA(0, 0, At, B0); PG8_MMA(0, 1, At, B1); PG8_BAR; PG8_SCHED;
            PG8_LDA(At, 1, 1); PG8_STAGE(PG8_SB(1, 0), b3, voffB); PG8_STAGE(PG8_SB(1, 1), b3 + hstep, voffB); PG8_STAGE(PG8_SA(1, 0), a3, voffA);
            PG8_WAIT_V(8); PG8_WAIT_L(0); PG8_BAR; PG8_MMA(1, 0, At, B0); PG8_MMA(1, 1, At, B1); PG8_BAR; PG8_SCHED;
            } else {
            PG8_LDB(B0, 0, 0); PG8_SCHED; PG8_LDA(At, 0, 0); PG8_STAGE(PG8_SA(1, 1), a1 + hstep, voffA);
            PG8_WAIT_L(8); PG8_BAR; PG8_WAIT_L(0); PG8_MMA(0, 0, At, B0); PG8_BAR; PG8_SCHED;
            PG8_LDB(B1, 0, 1); PG8_STAGE(PG8_SB(0, 0), b2, voffB);
            PG8_BAR; PG8_WAIT_L(0); PG8_MMA(0, 1, At, B1); PG8_BAR;
            PG8_LDA(At, 0, 1); PG8_STAGE(PG8_SA(0, 0), a2, voffA);
            PG8_BAR; PG8_WAIT_L(0); PG8_MMA(1, 0, At, B0); PG8_BAR; PG8_SCHED;
            PG8_STAGE(PG8_SB(0, 1), b2 + hstep, voffB);
            PG8_WAIT_V(6); PG8_BAR; PG8_MMA(1, 1, At, B1); PG8_BAR;
            PG8_LDB(B0, 1, 0); PG8_SCHED; PG8_LDA(At, 1, 0); PG8_STAGE(PG8_SA(0, 1), a2 + hstep, voffA);
            PG8_WAIT_L(8); PG8_BAR; PG8_WAIT_L(0); PG8_MMA(0, 0, At, B0); PG8_BAR; PG8_SCHED;
            PG8_LDB(B1, 1, 1); PG8_STAGE(PG8_SB(1, 0), b3, voffB);
            PG8_BAR; PG8_WAIT_L(0); PG8_MMA(0, 1, At, B1); PG8_BAR;
            PG8_LDA(At, 1, 1); PG8_STAGE(PG8_SA(1, 0), a3, voffA);
            PG8_BAR; PG8_WAIT_L(0); PG8_MMA(1, 0, At, B0); PG8_BAR; PG8_SCHED;
            PG8_STAGE(PG8_SB(1, 1), b3 + hstep, voffB);
            PG8_WAIT_V(6); PG8_BAR; PG8_MMA(1, 1, At, B1); PG8_BAR;
            }
        }
        if constexpr (ALIGN_EPI) { if (wr == 0) PG8_BAR; }
        if constexpr (!Epi::AFTER_DRAIN) { E(acc, cur, wr, wc, fr, fq); S.done(cur); }
        if (!has_next) break;
#pragma unroll
        for (int a = 0; a < 2; ++a)
#pragma unroll
            for (int b = 0; b < 2; ++b)
#pragma unroll
                for (int m = 0; m < 4; ++m)
#pragma unroll
                    for (int n = 0; n < 2; ++n) acc[a][b][m][n] = (f32x4){0.f, 0.f, 0.f, 0.f};
        cur = nxt; cA = nA; cB = nB; ++ui;
        if constexpr (ALIGN_EPI) { if (wr == 1) PG8_BAR; }
    }
    PG8_WAIT_V(0);
    if constexpr (!ALIGN_EPI) { if (wr == 0) PG8_BAR; }
    PG8_BAR;
    if constexpr (Epi::AFTER_DRAIN) { E.fused(acc, cur, wr, wc, fr, fq, lds, wid, lane); S.done(cur); }
#undef PG8_SA
#undef PG8_SB
#undef PG8_STAGE
#undef PG8_LDA
#undef PG8_LDB
#undef PG8_MMA
#undef PG8_WAIT_V
#undef PG8_WAIT_L
#undef PG8_BAR
#undef PG8_SCHED
}
}
#ifndef LAS
#define LAS __attribute__((address_space(3)))
#endif
#define XB_TMO      128
#define XB_XCNT(j)  (256  + 64 * (j))
#define XB_XSUB(j)  (1280 + 64 * (j))
#define XB_XGEN(j)  (2304 + 64 * (j))
#define XB_TOP      3328
#define XB_TOPGEN   3392
#define XCD_BAR_WORDS 3456
#define XB_SPIN_CAP (1u << 18)

__device__ __forceinline__ unsigned xb_ld(unsigned* p)              { return __hip_atomic_load(p, __ATOMIC_RELAXED, __HIP_MEMORY_SCOPE_AGENT); }
__device__ __forceinline__ unsigned xb_add(unsigned* p, unsigned v) { return __hip_atomic_fetch_add(p, v, __ATOMIC_RELAXED, __HIP_MEMORY_SCOPE_AGENT); }
__device__ __forceinline__ unsigned xb_xcc_id() { return (unsigned)__builtin_amdgcn_s_getreg((3 << 11) | 20) & 0xFu; }
#define XB_SPIN(cond, bar) do { unsigned _sp = 0; while (cond) { __builtin_amdgcn_s_sleep(1); \
    if ((++_sp & 255u) == 0u) { if (xb_ld(&(bar)[XB_TMO])) break; if (_sp > XB_SPIN_CAP) { atomicAdd(&(bar)[XB_TMO], 1u); break; } } } } while (0)

struct XcdBarrier {
    unsigned* bar; unsigned x;
    volatile LAS unsigned* st;
};

__device__ __forceinline__ XcdBarrier xcd_barrier_post(unsigned* bar, volatile LAS unsigned* st) {
    XcdBarrier b; b.bar = bar; b.x = xb_xcc_id(); b.st = st;
    if (threadIdx.x == 0) (void)xb_add(&bar[XB_XCNT(b.x)], 1u);
    return b;
}
__device__ __forceinline__ void xcd_barrier_complete(unsigned* bar, unsigned x, unsigned& nloc, unsigned& nx) {
    const unsigned G = gridDim.x * gridDim.y * gridDim.z;
    unsigned sum, cnt, mine, sp = 0u;
    for (;;) {
        sum = 0u; cnt = 0u; mine = 0u;
#pragma unroll
        for (unsigned j = 0; j < 16; ++j) { const unsigned c = xb_ld(&bar[XB_XCNT(j)]); sum += c; cnt += (c > 0u) ? 1u : 0u; mine = (j == x) ? c : mine; }
        if (sum == G) break;
        __builtin_amdgcn_s_sleep(1);
        if ((++sp & 255u) == 0u) { if (xb_ld(&bar[XB_TMO])) break; if (sp > XB_SPIN_CAP) { atomicAdd(&bar[XB_TMO], 1u); break; } }
    }
    nloc = mine > 0u ? mine : 1u; nx = cnt > 0u ? cnt : 1u;
}

__device__ __forceinline__ void xcd_barrier(const XcdBarrier& b) {
    asm volatile("s_waitcnt vmcnt(0)" ::: "memory");
    __syncthreads();
    if (threadIdx.x == 0) {
        unsigned* bar = b.bar;
        __builtin_amdgcn_s_waitcnt(0);
        unsigned nloc = b.st[0], nx = b.st[1];
        if (nloc == 0u) { xcd_barrier_complete(bar, b.x, nloc, nx); b.st[0] = nloc; b.st[1] = nx; }
        const unsigned old = xb_add(&bar[XB_XSUB(b.x)], 1u);
        const unsigned gen = old / nloc;
        if (old + 1u == (gen + 1u) * nloc) {
            __builtin_amdgcn_fence(__ATOMIC_RELEASE, "agent");
            asm volatile("s_waitcnt vmcnt(0)" ::: "memory");
            const unsigned og = xb_add(&bar[XB_TOP], 1u);
            const unsigned tg = og / nx;
            if (og + 1u == (tg + 1u) * nx) xb_add(&bar[XB_TOPGEN], 1u);
            else XB_SPIN(xb_ld(&bar[XB_TOPGEN]) == tg, bar);
            __builtin_amdgcn_fence(__ATOMIC_ACQUIRE, "agent");
            xb_add(&bar[XB_XGEN(b.x)], 1u);
            asm volatile("s_waitcnt vmcnt(0)" ::: "memory");
        } else {
            XB_SPIN(xb_ld(&bar[XB_XGEN(b.x)]) == gen, bar);
            __builtin_amdgcn_fence(__ATOMIC_ACQUIRE, "agent");
            asm volatile("s_waitcnt vmcnt(0)" ::: "memory");
        }
    }
    __syncthreads();
}

typedef unsigned short bf16_t;
typedef short bf16x8 __attribute__((ext_vector_type(8)));
typedef float f32x4 __attribute__((ext_vector_type(4)));
typedef float f32x16 __attribute__((ext_vector_type(16)));
typedef unsigned u32x4 __attribute__((ext_vector_type(4)));
typedef unsigned u32x2 __attribute__((ext_vector_type(2)));
#define LAS __attribute__((address_space(3)))

constexpr int DM = 1024, MTOT = 36864, NCTXTOK = 4096, PZ = 3328;
constexpr int NKL = 4352;
constexpr float LOG2E = 1.4426950408889634f;
constexpr float QSCALE = 0.125f * LOG2E;
constexpr float EPS = 1e-6f;
constexpr float KSCALE_C = 0.08838834764831845f;

constexpr size_t O_YP = 0, O_YS = 4194304, O_AK = 37748736, O_AV = 38273024, O_BK = 38797312, O_BV = 40894464,
                 O_CF = 42991616, O_CB = 44040192, O_DK = 45088768, O_DV = 45613056, O_END = 46137344;

constexpr size_t MiB = 1u << 20;
constexpr size_t WS_MOD = 0;
constexpr size_t WS_ROPE = 256 * 1024;
constexpr size_t WS_LAM = 300 * 1024;
constexpr size_t WS_BAR = 512 * 1024;
constexpr size_t WS_WIN_AB = 1 * MiB, WS_WOUT_AB = 8 * MiB, WS_WIN_CD = 10 * MiB, WS_WOUT_CD = 17 * MiB;
constexpr size_t WS_XN = 20 * MiB;
constexpr size_t WS_Z = 92 * MiB;
constexpr size_t WS_KV = 326 * MiB;
constexpr size_t L0_KA_LAT = WS_KV;
constexpr size_t L0_VTA_LAT = L0_KA_LAT + 8912896;
constexpr size_t L0_KB1_LAT = L0_VTA_LAT + 8912896;
constexpr size_t L0_KB2_LAT = L0_KB1_LAT + 17825792;
constexpr size_t L0_VTB_LAT = L0_KB2_LAT + 17825792;
constexpr size_t L0_KA_CTX = L0_VTB_LAT + 35651584;
constexpr size_t L0_VTA_CTX = L0_KA_CTX + 1 * MiB;
constexpr size_t L0_KB1_CTX = L0_VTA_CTX + 1 * MiB;
constexpr size_t L0_KB2_CTX = L0_KB1_CTX + 2 * MiB;
constexpr size_t L0_VTB_CTX = L0_KB2_CTX + 2 * MiB;
constexpr size_t L0_END = L0_VTB_CTX + 4 * MiB;
constexpr size_t L1_KTL = WS_KV;
constexpr size_t L1_VTL = L1_KTL + 32 * MiB;
constexpr size_t L1_KTC = L1_VTL + 32 * MiB;
constexpr size_t L1_VTC = L1_KTC + 4 * MiB;
constexpr size_t L1_KD_LAT = L1_VTC + 4 * MiB;
constexpr size_t L1_VTD_LAT = L1_KD_LAT + 8912896;
constexpr size_t L1_KD_CTX = L1_VTD_LAT + 8912896;
constexpr size_t L1_VTD_CTX = L1_KD_CTX + 1 * MiB;
constexpr size_t L1_STF_L = L1_VTD_CTX + 1 * MiB;
constexpr size_t L1_STB_L = L1_STF_L + 32 * MiB;
constexpr size_t L1_STF_C = L1_STB_L + 32 * MiB;
constexpr size_t L1_STB_C = L1_STF_C + 4 * MiB;
constexpr size_t L1_END = L1_STB_C + 4 * MiB;
constexpr size_t L1_KF_HI = L1_END;
constexpr size_t L1_KF_LO = 1 * MiB;
constexpr size_t WS_NEED = (L0_END > L1_END ? L0_END : L1_END);
static_assert(L1_KF_LO + 9 * MiB <= WS_WIN_CD, "Kf low part must not reach the layer-1 weight copies");
static_assert(WS_NEED <= 512 * MiB, "workspace map");

constexpr int LDS_BYTES = 136192;
constexpr int LDS_BAR = 135680;
#ifndef PHM
#define PHM 0xFFFFF
#endif
#ifndef REP_A
#define REP_A 1
#endif
#ifndef REP_G2
#define REP_G2 1
#endif
#ifndef REP_PREP
#define REP_PREP 1
#endif
#ifndef REP_SCAN
#define REP_SCAN 1
#endif
#ifndef REP_RET
#define REP_RET 1
#endif
#ifndef REP_SM
#define REP_SM 1
#endif
#ifndef REP_P4
#define REP_P4 1
#endif
#ifndef REP_P10
#define REP_P10 1
#endif

struct Params { const float* in[31]; float* out; unsigned char* ws; };
enum { I_XP = 0, I_XS, I_CAK, I_CAV, I_CBK, I_CBV, I_SCF, I_SCB, I_CDK, I_CDV, I_C, I_CCTX, I_NORMG, I_MODW, I_MODB,
       I_ABWIN, I_ABWOUT, I_SINK, I_LQ1, I_LK1, I_LQ2, I_LK2, I_BNG, I_CDWIN, I_CDWOUT, I_DECF, I_DECB, I_CNG, I_DQG, I_DKG, I_FING };

__device__ __forceinline__ unsigned cvtpk(float lo, float hi) {
    typedef float f2_t __attribute__((ext_vector_type(2))); typedef __bf16 b2_t __attribute__((ext_vector_type(2)));
    f2_t v = {lo, hi}; b2_t b = __builtin_convertvector(v, b2_t); return __builtin_bit_cast(unsigned, b);
}
__device__ __forceinline__ float bflo(unsigned w) { return __uint_as_float(w << 16); }
__device__ __forceinline__ float bfhi(unsigned w) { return __uint_as_float(w & 0xffff0000u); }
__device__ __forceinline__ void unpack8(const u32x4 w, float (&v)[8]) {
    v[0] = bflo(w.x); v[1] = bfhi(w.x); v[2] = bflo(w.y); v[3] = bfhi(w.y); v[4] = bflo(w.z); v[5] = bfhi(w.z); v[6] = bflo(w.w); v[7] = bfhi(w.w);
}
__device__ __forceinline__ u32x4 pack8(const float (&v)[8]) {
    u32x4 w; w.x = cvtpk(v[0], v[1]); w.y = cvtpk(v[2], v[3]); w.z = cvtpk(v[4], v[5]); w.w = cvtpk(v[6], v[7]); return w;
}
__device__ __forceinline__ float fexp2(float x) { return __builtin_amdgcn_exp2f(x); }
__device__ __forceinline__ float siluf(float g) { return g * __builtin_amdgcn_rcpf(1.0f + fexp2(-g * LOG2E)); }
__device__ __forceinline__ float wave_sum(float v) {
#pragma unroll
    for (int o = 1; o < 64; o <<= 1) v += __shfl_xor(v, o);
    return v;
}
__device__ __forceinline__ int crow(int r, int hi) { return (r & 3) + 8 * (r >> 2) + 4 * hi; }
__device__ __forceinline__ size_t kf_base(int sh) { return sh < 23 ? L1_KF_HI + (size_t)sh * MiB : L1_KF_LO + (size_t)(sh - 23) * MiB; }
#define MFMA32(a, b, c) __builtin_amdgcn_mfma_f32_32x32x16_bf16((a), (b), (c), 0, 0, 0)

struct EpiResid {
    static constexpr bool PERM = false, AFTER_DRAIN = false;
    const float* xp; const float* xs; float* out; const float* mod;
    __device__ __forceinline__ void operator()(const pg8::f32x4 (&acc)[2][2][4][2], const pg8::Unit& u, int wr, int wc, int fr, int fq) const {
        const int pm = u.pm;
        const float* xin = pm < 16 ? xp + (size_t)pm * 256 * DM : xs + (size_t)(pm - 16) * 256 * DM;
        float* xo = out + (size_t)pm * 256 * DM;
        const int mrow = pm < 16 ? 0 : 1 + ((pm - 16) >> 4);
        const float* gate = mod + mrow * 3072 + 2048;
        const int col0 = u.pn * 256 + wc * 32 + 4 * fq;
#pragma unroll
        for (int bj = 0; bj < 2; ++bj)
#pragma unroll
            for (int n = 0; n < 2; ++n) {
                const pg8::f32x4 g = *(const pg8::f32x4*)(gate + col0 + bj * 128 + n * 16);
                pg8::f32x4 xv[2][4];
#pragma unroll
                for (int ai = 0; ai < 2; ++ai)
#pragma unroll
                    for (int m = 0; m < 4; ++m) xv[ai][m] = *(const pg8::f32x4*)(xin + (size_t)(ai * 128 + wr * 64 + m * 16 + fr) * DM + col0 + bj * 128 + n * 16);
#pragma unroll
                for (int ai = 0; ai < 2; ++ai)
#pragma unroll
                    for (int m = 0; m < 4; ++m)
                        *(pg8::f32x4*)(xo + (size_t)(ai * 128 + wr * 64 + m * 16 + fr) * DM + col0 + bj * 128 + n * 16) = xv[ai][m] + g * acc[ai][bj][m][n];
            }
    }
};

__device__ __forceinline__ void transpose_item(const float* __restrict__ W, int K, int N, bf16_t* __restrict__ WT, float* scr, int item, int lane) {
    const int nblk = N / 32, kb = item / nblk, nb = item % nblk, k0 = 64 * kb, n0 = 32 * nb;
#pragma unroll 8
    for (int i = 0; i < 32; ++i) { const int kk = 2 * i + (lane >> 5); scr[kk * 33 + (lane & 31)] = W[(size_t)(k0 + kk) * N + n0 + (lane & 31)]; }
    asm volatile("s_waitcnt lgkmcnt(0)" ::: "memory");
    const int c = lane & 7;
#pragma unroll
    for (int j = 0; j < 4; ++j) {
        const int n = (lane >> 3) + 8 * j; const float* s = scr + (8 * c) * 33 + n;
        u32x4 o; o.x = cvtpk(s[0 * 33], s[1 * 33]); o.y = cvtpk(s[2 * 33], s[3 * 33]); o.z = cvtpk(s[4 * 33], s[5 * 33]); o.w = cvtpk(s[6 * 33], s[7 * 33]);
        *(u32x4*)(WT + (size_t)(n0 + n) * K + k0 + 8 * c) = o;
    }
    asm volatile("s_waitcnt lgkmcnt(0)" ::: "memory");
}

__device__ __forceinline__ void phase0(const Params& p, unsigned char* lds, int tid, int blk, int G) {
    const int lane = tid & 63, wave = tid >> 6;
    unsigned char* ws = p.ws;
    {
        float* scr = (float*)(lds + wave * 16384);
        const int gw = blk * 8 + wave, NGW = G * 8;
        constexpr int I_IN = 16 * 104, I_OUT = 16 * 32, NIT = 2 * (I_IN + I_OUT);
        for (int it = gw; it < NIT; it += NGW) {
            int r = it;
            if (r < I_IN) { transpose_item(p.in[I_ABWIN], 1024, PZ, (bf16_t*)(ws + WS_WIN_AB), scr, r, lane); continue; } r -= I_IN;
            if (r < I_OUT) { transpose_item(p.in[I_ABWOUT], 1024, 1024, (bf16_t*)(ws + WS_WOUT_AB), scr, r, lane); continue; } r -= I_OUT;
            if (r < I_IN) { transpose_item(p.in[I_CDWIN], 1024, PZ, (bf16_t*)(ws + WS_WIN_CD), scr, r, lane); continue; } r -= I_IN;
            transpose_item(p.in[I_CDWOUT], 1024, 1024, (bf16_t*)(ws + WS_WOUT_CD), scr, r, lane);
        }
    }
    __syncthreads();
    {
        float* red = (float*)lds;
        const int c = tid & 31, kp = tid >> 5;
        for (int cgp = blk; cgp < 256; cgp += G) {
            const int layer = cgp >> 7, colb = (cgp & 127) * 24;
            const float* W = p.in[I_MODW] + (size_t)layer * 1024 * 3072;
            float acc[9];
#pragma unroll
            for (int r = 0; r < 9; ++r) acc[r] = 0.f;
            if (c < 24) {
                for (int k = kp * 64; k < kp * 64 + 64; ++k) {
                    const float w = W[(size_t)k * 3072 + colb + c];
                    acc[0] += siluf(p.in[I_CCTX][k]) * w;
#pragma unroll
                    for (int b = 0; b < 8; ++b) acc[1 + b] += siluf(p.in[I_C][b * 1024 + k]) * w;
                }
#pragma unroll
                for (int r = 0; r < 9; ++r) red[(kp * 9 + r) * 24 + c] = acc[r];
            }
            __syncthreads();
            if (tid < 216) {
                const int r = tid / 24, cc = tid % 24; float s = 0.f;
                for (int q = 0; q < 16; ++q) s += red[(q * 9 + r) * 24 + cc];
                ((float*)(ws + WS_MOD))[(size_t)(layer * 9 + r) * 3072 + colb + cc] = s + p.in[I_MODB][layer * 3072 + colb + cc];
            }
            __syncthreads();
        }
    }
    {
        const int gt = blk * 512 + tid;
        if (gt < 1024) {
            const int pos = gt >> 4, f = gt & 15;
            const float inv = exp2f(-(float)f * (13.287712379549449f / 16.0f));
            const float ang = (float)pos * inv;
            ((float*)(ws + WS_ROPE))[gt] = cosf(ang);
            ((float*)(ws + WS_ROPE))[1024 + gt] = sinf(ang);
        }
        if (blk == 0 && tid == 0) {
            float s1 = 0.f, s2 = 0.f;
            for (int i = 0; i < 64; ++i) { s1 += p.in[I_LQ1][i] * p.in[I_LK1][i]; s2 += p.in[I_LQ2][i] * p.in[I_LK2][i]; }
            *(float*)(ws + WS_LAM) = expf(s1) - expf(s2) + 0.2f;
        }
    }
}

__device__ __forceinline__ void adaln_rows(const float* xp, const float* xs, const float* __restrict__ g, const float* __restrict__ mod,
                                           bf16_t* __restrict__ XN, int gw, int NGW, int lane) {
    for (int row = gw; row < MTOT; row += 2 * NGW) {
        const int rowB = (row + NGW < MTOT) ? row + NGW : row;
        const float* xa = row < NCTXTOK ? xp + (size_t)row * DM : xs + (size_t)(row - NCTXTOK) * DM;
        const float* xb = rowB < NCTXTOK ? xp + (size_t)rowB * DM : xs + (size_t)(rowB - NCTXTOK) * DM;
        f32x4 va[4], vb[4];
#pragma unroll
        for (int j = 0; j < 4; ++j) va[j] = __builtin_nontemporal_load((const f32x4*)(xa + 4 * (lane + 64 * j)));
#pragma unroll
        for (int j = 0; j < 4; ++j) vb[j] = __builtin_nontemporal_load((const f32x4*)(xb + 4 * (lane + 64 * j)));
        float sa = 0.f, sb = 0.f;
#pragma unroll
        for (int j = 0; j < 4; ++j) { sa += (va[j].x * va[j].x + va[j].y * va[j].y) + (va[j].z * va[j].z + va[j].w * va[j].w); sb += (vb[j].x * vb[j].x + vb[j].y * vb[j].y) + (vb[j].z * vb[j].z + vb[j].w * vb[j].w); }
        const float ra = rsqrtf(wave_sum(sa) * (1.0f / DM) + EPS), rb = rsqrtf(wave_sum(sb) * (1.0f / DM) + EPS);
        const int ma = row < NCTXTOK ? 0 : 1 + ((row - NCTXTOK) >> 12), mb = rowB < NCTXTOK ? 0 : 1 + ((rowB - NCTXTOK) >> 12);
        const float* sha = mod + ma * 3072; const float* shb = mod + mb * 3072;
#pragma unroll
        for (int j = 0; j < 4; ++j) {
            const int col = 4 * (lane + 64 * j);
            const f32x4 gg = *(const f32x4*)(g + col);
            const f32x4 ha = va[j] * ra * gg * (*(const f32x4*)(sha + 1024 + col) + 1.0f) + *(const f32x4*)(sha + col);
            const f32x4 hb = vb[j] * rb * gg * (*(const f32x4*)(shb + 1024 + col) + 1.0f) + *(const f32x4*)(shb + col);
            u32x2 wa; wa.x = cvtpk(ha.x, ha.y); wa.y = cvtpk(ha.z, ha.w);
            u32x2 wb; wb.x = cvtpk(hb.x, hb.y); wb.y = cvtpk(hb.z, hb.w);
            *(u32x2*)(XN + (size_t)row * DM + col) = wa;
            *(u32x2*)(XN + (size_t)rowB * DM + col) = wb;
        }
    }
}
__device__ __forceinline__ void final_rows(float* x, const float* __restrict__ g, int gw, int NGW, int lane) {
    for (int row = gw; row < MTOT; row += 2 * NGW) {
        const int rowB = (row + NGW < MTOT) ? row + NGW : row;
        float* xa = x + (size_t)row * DM; float* xb = x + (size_t)rowB * DM;
        f32x4 va[4], vb[4];
#pragma unroll
        for (int j = 0; j < 4; ++j) va[j] = __builtin_nontemporal_load((const f32x4*)(xa + 4 * (lane + 64 * j)));
#pragma unroll
        for (int j = 0; j < 4; ++j) vb[j] = __builtin_nontemporal_load((const f32x4*)(xb + 4 * (lane + 64 * j)));
        float sa = 0.f, sb = 0.f;
#pragma unroll
        for (int j = 0; j < 4; ++j) { sa += (va[j].x * va[j].x + va[j].y * va[j].y) + (va[j].z * va[j].z + va[j].w * va[j].w); sb += (vb[j].x * vb[j].x + vb[j].y * vb[j].y) + (vb[j].z * vb[j].z + vb[j].w * vb[j].w); }
        const float ra = rsqrtf(wave_sum(sa) * (1.0f / DM) + EPS), rb = rsqrtf(wave_sum(sb) * (1.0f / DM) + EPS);
#pragma unroll
        for (int j = 0; j < 4; ++j) {
            const int col = 4 * (lane + 64 * j);
            const f32x4 gg = *(const f32x4*)(g + col);
            __builtin_nontemporal_store(va[j] * ra * gg, (f32x4*)(xa + col));
            if (rowB != row) __builtin_nontemporal_store(vb[j] * rb * gg, (f32x4*)(xb + col));
        }
    }
}

template <bool F32SRC>
__device__ __forceinline__ void tile64(const void* src, size_t sp, bool rms, bool rope, const float* __restrict__ gain, int pos0,
                                       const float* __restrict__ cosT, const float* __restrict__ sinT,
                                       float* df, size_t dfp, bf16_t* dk, size_t dkp, bf16_t* dt, size_t dtp, unsigned char* ldsw, int lane,
                                       const int fragmode = 0, const int fraghalf = 0, const int fragtq = 0, bf16_t* dkf = nullptr) {
    const int tr = lane >> 3, ch = lane & 7;
    unsigned short* T = (unsigned short*)ldsw;
    u32x4 rawh[8]; f32x4 rawa[F32SRC ? 8 : 1], rawb[F32SRC ? 8 : 1];
#pragma unroll
    for (int g8 = 0; g8 < 8; ++g8) {
        const int tok = g8 * 8 + tr;
        if (F32SRC) { const float* s = (const float*)src + (size_t)tok * sp + ch * 8; rawa[g8] = *(const f32x4*)s; rawb[g8] = *(const f32x4*)(s + 4); }
        else rawh[g8] = *(const u32x4*)((const bf16_t*)src + (size_t)tok * sp + ch * 8);
    }
#pragma unroll
    for (int g8 = 0; g8 < 8; ++g8) {
        const int tok = g8 * 8 + tr;
        float v[8];
        if (F32SRC) {
            const f32x4 a = rawa[g8], b = rawb[g8];
            v[0] = a.x; v[1] = a.y; v[2] = a.z; v[3] = a.w; v[4] = b.x; v[5] = b.y; v[6] = b.z; v[7] = b.w;
        } else {
            unpack8(rawh[g8], v);
        }
        if (rms) {
            float ss = 0.f;
#pragma unroll
            for (int e = 0; e < 8; ++e) ss += v[e] * v[e];
            ss += __shfl_xor(ss, 1); ss += __shfl_xor(ss, 2); ss += __shfl_xor(ss, 4);
            const float rinv = rsqrtf(ss * (1.0f / 64.0f) + EPS);
#pragma unroll
            for (int e = 0; e < 8; ++e) v[e] *= rinv * gain[ch * 8 + e];
        }
        if (df) {
            float* o = df + (size_t)tok * dfp + ch * 8;
            __builtin_nontemporal_store((f32x4){v[0], v[1], v[2], v[3]}, (f32x4*)o); __builtin_nontemporal_store((f32x4){v[4], v[5], v[6], v[7]}, (f32x4*)(o + 4));
        }
        if (rope) {
            const int pos = pos0 + tok, c4 = ch & 3;
            const int trow = c4 < 2 ? (pos >> 6) : (pos & 63), f0 = 8 * (c4 & 1);
#pragma unroll
            for (int e = 0; e < 8; ++e) {
                const float other = __shfl_xor(v[e], 4);
                const float cs = cosT[trow * 16 + f0 + e], sn = sinT[trow * 16 + f0 + e];
                v[e] = ch < 4 ? v[e] * cs - other * sn : v[e] * cs + other * sn;
            }
        }
        if (dk) *(u32x4*)(dk + (size_t)tok * dkp + ch * 8) = pack8(v);
        if (dkf) {
            const int tl = 64 * fragtq + tok, t5 = tl & 31, pit = (t5 & 0x13) | ((t5 & 4) << 1) | ((t5 & 8) >> 1);
            *(u32x4*)(dkf + (size_t)((((tl >> 5) * 8 + 4 * fraghalf + (ch >> 1)) * 64 + (ch & 1) * 32 + pit) * 8)) = pack8(v);
        }
        if (dt) {
#pragma unroll
            for (int e = 0; e < 8; ++e) T[(ch * 8 + e) * 72 + tok] = (unsigned short)(cvtpk(v[e], 0.f) & 0xffffu);
        }
    }
    if (dt) {
        asm volatile("s_waitcnt lgkmcnt(0)" ::: "memory");
#pragma unroll
        for (int k = 0; k < 8; ++k) {
            const int d = tr + 8 * k, c8 = ch;
            const u32x4 w = *(const u32x4*)(T + d * 72 + c8 * 8);
            if (fragmode) {
                const int e = 64 * fraghalf + d, tl = 64 * fragtq + 8 * c8;
                *(u32x4*)(dt + (size_t)((((e >> 5) * 8 + (tl >> 4)) * 64 + ((tl >> 3) & 1) * 32 + (e & 31)) * 8)) = w;
            } else *(u32x4*)(dt + (size_t)d * dtp + c8 * 8) = w;
        }
        asm volatile("s_waitcnt lgkmcnt(0)" ::: "memory");
    }
}

__device__ __forceinline__ void prep_layer0(const Params& p, unsigned char* lds, int tid, int blk, int G) {
    unsigned char* ws = p.ws; float* out = p.out;
    const int lane = tid & 63, wave = __builtin_amdgcn_readfirstlane(tid >> 6); unsigned char* ldsw = lds + wave * 9216; const int gwp = wave * G + blk, NGWp = G * 8;
    const bf16_t* Z = (const bf16_t*)(ws + WS_Z);
    const float* cosT = (const float*)(ws + WS_ROPE); const float* sinT = cosT + 1024;
    for (int u = gwp; u < 12160; u += NGWp) {
        if (u < 11520) {
            const int tt = u / 20, g = u % 20;
            const bool ctx = tt < 64;
            const int b = ctx ? (tt >> 2) : ((tt - 64) >> 6);
            const int t0 = ctx ? (tt & 3) * 64 : ((tt - 64) & 63) * 64;
            const size_t row0 = (size_t)tt * 64;
            const int NK = ctx ? 256 : NKL, koff = ctx ? t0 : 256 + t0;
            float* df = nullptr; size_t dfp = 0; bf16_t* dk = nullptr; bf16_t* dt = nullptr; size_t dtp = NK; int zcol; bool rope = false;
            if (g < 2) {
                zcol = 512 + 64 * g; rope = !ctx;
                dk = (bf16_t*)(ws + (ctx ? L0_KA_CTX : L0_KA_LAT)) + ((size_t)(b * 2 + g) * NK + koff) * 64;
                if (ctx) { df = out + O_AK + ((size_t)(b * 2 + g) * 256 + t0) * 64; dfp = 64; }
            } else if (g < 4) {
                const int hd = g - 2; zcol = 640 + 64 * hd;
                dt = (bf16_t*)(ws + (ctx ? L0_VTA_CTX : L0_VTA_LAT)) + (size_t)(b * 2 + hd) * 64 * NK + koff;
                if (ctx) { df = out + O_AV + ((size_t)(b * 2 + hd) * 256 + t0) * 64; dfp = 64; }
            } else if (g < 12) {
                const int idx = g - 4, hd = idx >> 1, half = idx & 1; zcol = 1280 + 128 * hd + 64 * half; rope = !ctx;
                const size_t base = ctx ? (half ? L0_KB2_CTX : L0_KB1_CTX) : (half ? L0_KB2_LAT : L0_KB1_LAT);
                dk = (bf16_t*)(ws + base) + ((size_t)(b * 4 + hd) * NK + koff) * 64;
                if (ctx) { df = out + O_BK + ((size_t)(b * 4 + hd) * 256 + t0) * 128 + 64 * half; dfp = 128; }
            } else {
                const int idx = g - 12, hd = idx >> 1, half = idx & 1; zcol = 1792 + 128 * hd + 64 * half;
                dt = (bf16_t*)(ws + (ctx ? L0_VTB_CTX : L0_VTB_LAT)) + ((size_t)(b * 4 + hd) * 128 + 64 * half) * NK + koff;
                if (ctx) { df = out + O_BV + ((size_t)(b * 4 + hd) * 256 + t0) * 128 + 64 * half; dfp = 128; }
            }
            tile64<false>(Z + row0 * PZ + zcol, PZ, false, rope, nullptr, t0, cosT, sinT, df, dfp, dk, 64, dt, dtp, ldsw, lane);
        } else {
            const int cu = u - 11520, g = cu % 20, r = cu / 20, b = r >> 2, t0 = (r & 3) * 64;
            const float* src; size_t sp; bf16_t* dk = nullptr; bf16_t* dt = nullptr;
            if (g < 2) {
                src = p.in[I_CAK] + ((size_t)(b * 2 + g) * 256 + t0) * 64; sp = 64;
                dk = (bf16_t*)(ws + L0_KA_LAT) + ((size_t)(b * 2 + g) * NKL + t0) * 64;
            } else if (g < 4) {
                const int hd = g - 2; src = p.in[I_CAV] + ((size_t)(b * 2 + hd) * 256 + t0) * 64; sp = 64;
                dt = (bf16_t*)(ws + L0_VTA_LAT) + (size_t)(b * 2 + hd) * 64 * NKL + t0;
            } else if (g < 12) {
                const int idx = g - 4, hd = idx >> 1, half = idx & 1;
                src = p.in[I_CBK] + ((size_t)(b * 4 + hd) * 256 + t0) * 128 + 64 * half; sp = 128;
                dk = (bf16_t*)(ws + (half ? L0_KB2_LAT : L0_KB1_LAT)) + ((size_t)(b * 4 + hd) * NKL + t0) * 64;
            } else {
                const int idx = g - 12, hd = idx >> 1, half = idx & 1;
                src = p.in[I_CBV] + ((size_t)(b * 4 + hd) * 256 + t0) * 128 + 64 * half; sp = 128;
                dt = (bf16_t*)(ws + L0_VTB_LAT) + ((size_t)(b * 4 + hd) * 128 + 64 * half) * NKL + t0;
            }
            tile64<true>(src, sp, false, false, nullptr, 0, cosT, sinT, nullptr, 0, dk, 64, dt, NKL, ldsw, lane);
        }
    }
}

__device__ __forceinline__ void prep_layer1(const Params& p, unsigned char* lds, int tid, int blk, int G) {
    unsigned char* ws = p.ws; float* out = p.out;
    const int lane = tid & 63, wave = __builtin_amdgcn_readfirstlane(tid >> 6); unsigned char* ldsw = lds + wave * 9216; const int gwp = wave * G + blk, NGWp = G * 8;
    const bf16_t* Z = (const bf16_t*)(ws + WS_Z);
    const float* cosT = (const float*)(ws + WS_ROPE); const float* sinT = cosT + 1024;
    for (int u = gwp; u < 11520 + 128; u += NGWp) {
        if (u < 11520) {
            const int tt = u / 20, g = u % 20;
            const bool ctx = tt < 64;
            const int b = ctx ? (tt >> 2) : ((tt - 64) >> 6);
            const int t0 = ctx ? (tt & 3) * 64 : ((tt - 64) & 63) * 64;
            const size_t row0 = (size_t)tt * 64;
            float* df = nullptr; bf16_t* dk = nullptr; bf16_t* dt = nullptr; size_t dtp = 0; int zcol; bool rope = false, rms = false;
            int fragmode = 0, fraghalf = 0, fragtq = 0; bf16_t* dkf = nullptr;
            if (g < 16) {
                const int idx = g & 7, hd = idx >> 1, half = idx & 1; const bool isv = g >= 8;
                zcol = (isv ? 1024 : 512) + 128 * hd + 64 * half;
                const int NS = ctx ? 256 : 4096; dtp = NS;
                const size_t base = ctx ? (isv ? L1_VTC : L1_KTC) : (isv ? L1_VTL : L1_KTL);
                dt = (bf16_t*)(ws + base) + (size_t)(b * 4 + hd) * 128 * NS + (size_t)(t0 >> 7) * 16384;
                fragmode = 1; fraghalf = half; fragtq = (t0 >> 6) & 1;
            } else if (g < 18) {
                const int hd = g - 16; zcol = 2048 + 64 * hd; rms = true; rope = !ctx;
                const int NK = ctx ? 256 : NKL, koff = ctx ? t0 : 256 + t0;
                dk = (bf16_t*)(ws + (ctx ? L1_KD_CTX : L1_KD_LAT)) + ((size_t)(b * 2 + hd) * NK + koff) * 64;
                if (ctx) df = out + O_DK + ((size_t)(b * 2 + hd) * 256 + t0) * 64;
            } else {
                const int hd = g - 18; zcol = 2176 + 64 * hd;
                const int NK = ctx ? 256 : NKL, koff = ctx ? t0 : 256 + t0; dtp = NK;
                dt = (bf16_t*)(ws + (ctx ? L1_VTD_CTX : L1_VTD_LAT)) + (size_t)(b * 2 + hd) * 64 * NK + koff;
                if (ctx) df = out + O_DV + ((size_t)(b * 2 + hd) * 256 + t0) * 64;
            }
            tile64<false>(Z + row0 * PZ + zcol, PZ, rms, rope, p.in[I_DKG], t0, cosT, sinT, df, 64, dk, 64, dt, dtp, ldsw, lane, fragmode, fraghalf, fragtq, dkf);
        } else {
            const int cu = u - 11520, g = cu & 3, r = cu >> 2, b = r >> 2, t0 = (r & 3) * 64;
            const float* src; bf16_t* dk = nullptr; bf16_t* dt = nullptr;
            if (g < 2) {
                src = p.in[I_CDK] + ((size_t)(b * 2 + g) * 256 + t0) * 64;
                dk = (bf16_t*)(ws + L1_KD_LAT) + ((size_t)(b * 2 + g) * NKL + t0) * 64;
            } else {
                const int hd = g - 2; src = p.in[I_CDV] + ((size_t)(b * 2 + hd) * 256 + t0) * 64;
                dt = (bf16_t*)(ws + L1_VTD_LAT) + (size_t)(b * 2 + hd) * 64 * NKL + t0;
            }
            tile64<true>(src, 64, false, false, nullptr, 0, cosT, sinT, nullptr, 0, dk, 64, dt, NKL, ldsw, lane);
        }
    }
}

template <bool RMS, bool ROPE>
__device__ __forceinline__ void load_q(const bf16_t* zq, int hi, const float* __restrict__ gain, int pos,
                                       const float* __restrict__ cosT, const float* __restrict__ sinT, bf16x8 (&qf)[4]) {
    float v[4][8];
#pragma unroll
    for (int kk = 0; kk < 4; ++kk) unpack8(*(const u32x4*)(zq + 16 * kk + 8 * hi), v[kk]);
    if (RMS) {
        float ss = 0.f;
#pragma unroll
        for (int kk = 0; kk < 4; ++kk)
#pragma unroll
            for (int e = 0; e < 8; ++e) ss += v[kk][e] * v[kk][e];
        ss += __shfl_xor(ss, 32);
        const float rinv = rsqrtf(ss * (1.0f / 64.0f) + EPS);
#pragma unroll
        for (int kk = 0; kk < 4; ++kk)
#pragma unroll
            for (int e = 0; e < 8; ++e) v[kk][e] *= rinv * gain[16 * kk + 8 * hi + e];
    }
    if (ROPE) {
        const int prow = pos >> 6, pcol = pos & 63;
#pragma unroll
        for (int kk = 0; kk < 2; ++kk) {
            const int trow = kk == 0 ? prow : pcol;
#pragma unroll
            for (int e = 0; e < 8; ++e) {
                const float cs = cosT[trow * 16 + 8 * hi + e], sn = sinT[trow * 16 + 8 * hi + e];
                const float x1 = v[kk][e], x2 = v[kk + 2][e];
                v[kk][e] = x1 * cs - x2 * sn; v[kk + 2][e] = x2 * cs + x1 * sn;
            }
        }
    }
#pragma unroll
    for (int kk = 0; kk < 4; ++kk) {
#pragma unroll
        for (int e = 0; e < 8; ++e) v[kk][e] *= QSCALE;
        qf[kk] = __builtin_bit_cast(bf16x8, pack8(v[kk]));
    }
}

template <int DV, bool WINDOW>
__device__ __forceinline__ void compute_tile(const unsigned char* base, const unsigned rdK, const unsigned rdV, const bf16x8 (&qf)[4], f32x16& negm,
                                             f32x16 (&O)[DV / 32], float& m_run, float& l_run, const bool mtile, const int j0, const int qpos, const int hi, const bool first) {
    constexpr int NDB = DV / 32;
    constexpr float THR = 8.0f;
    f32x16 s0, s1;
    bf16x8 kf0[4], kf1[4], vf[NDB][4];
#pragma unroll
    for (int kk = 0; kk < 4; ++kk) { kf0[kk] = *(const bf16x8*)(base + rdK + kk * 32); kf1[kk] = *(const bf16x8*)(base + rdK + 32 * 144 + kk * 32); }
#pragma unroll
    for (int db = 0; db < NDB; ++db)
#pragma unroll
        for (int q = 0; q < 4; ++q) vf[db][q] = *(const bf16x8*)(base + rdV + db * 32 * 144 + q * 32);
    __builtin_amdgcn_sched_barrier(0);
    __builtin_amdgcn_s_setprio(1);
    s0 = MFMA32(kf0[0], qf[0], negm); s1 = MFMA32(kf1[0], qf[0], negm);
#pragma unroll
    for (int kk = 1; kk < 4; ++kk) { s0 = MFMA32(kf0[kk], qf[kk], s0); s1 = MFMA32(kf1[kk], qf[kk], s1); }
    __builtin_amdgcn_s_setprio(0);
    if (WINDOW && mtile) {
#pragma unroll
        for (int r = 0; r < 16; ++r) {
            const int j = j0 + 16 * (r >> 3) + 8 * hi + (r & 7);
            const int d0 = qpos - j, d1 = d0 - 32;
            if (d0 > 128 || d0 < -128) s0[r] = -1e30f;
            if (d1 > 128 || d1 < -128) s1[r] = -1e30f;
        }
    }
    float mx = fmaxf(s0[0], s1[0]);
#pragma unroll
    for (int r = 1; r < 16; ++r) mx = fmaxf(mx, fmaxf(s0[r], s1[r]));
    {
        auto rr = __builtin_amdgcn_permlane32_swap(__float_as_uint(mx), __float_as_uint(mx), false, false);
        mx = fmaxf(__uint_as_float(rr[0]), __uint_as_float(rr[1]));
    }
    if (first || __any(mx > THR)) {
        const float dl = first ? mx : fmaxf(mx, 0.f);
        m_run += dl;
#pragma unroll
        for (int r = 0; r < 16; ++r) { s0[r] -= dl; s1[r] -= dl; negm[r] = -m_run; }
        const float alpha = fexp2(-dl);
        l_run *= alpha;
#pragma unroll
        for (int db = 0; db < NDB; ++db)
#pragma unroll
            for (int r = 0; r < 16; ++r) O[db][r] *= alpha;
    }
    float rs = 0.f;
#pragma unroll
    for (int r = 0; r < 16; ++r) { s0[r] = fexp2(s0[r]); s1[r] = fexp2(s1[r]); rs += s0[r] + s1[r]; }
    l_run += rs;
    u32x4 w00, w01, w10, w11;
    w00.x = cvtpk(s0[0], s0[1]); w00.y = cvtpk(s0[2], s0[3]); w00.z = cvtpk(s0[4], s0[5]); w00.w = cvtpk(s0[6], s0[7]);
    w01.x = cvtpk(s0[8], s0[9]); w01.y = cvtpk(s0[10], s0[11]); w01.z = cvtpk(s0[12], s0[13]); w01.w = cvtpk(s0[14], s0[15]);
    w10.x = cvtpk(s1[0], s1[1]); w10.y = cvtpk(s1[2], s1[3]); w10.z = cvtpk(s1[4], s1[5]); w10.w = cvtpk(s1[6], s1[7]);
    w11.x = cvtpk(s1[8], s1[9]); w11.y = cvtpk(s1[10], s1[11]); w11.z = cvtpk(s1[12], s1[13]); w11.w = cvtpk(s1[14], s1[15]);
    const bf16x8 p00 = __builtin_bit_cast(bf16x8, w00), p01 = __builtin_bit_cast(bf16x8, w01), p10 = __builtin_bit_cast(bf16x8, w10), p11 = __builtin_bit_cast(bf16x8, w11);
    __builtin_amdgcn_s_setprio(1);
#pragma unroll
    for (int db = 0; db < NDB; ++db) {
        O[db] = MFMA32(vf[db][0], p00, O[db]);
        O[db] = MFMA32(vf[db][1], p01, O[db]);
        O[db] = MFMA32(vf[db][2], p10, O[db]);
        O[db] = MFMA32(vf[db][3], p11, O[db]);
    }
    __builtin_amdgcn_s_setprio(0);
}

template <int DV, bool WINDOW>
__device__ __forceinline__ void compute_block32(const unsigned char* kb, const unsigned char* vb0, const bf16x8 (&qf)[4], f32x16& negm,
                                                f32x16 (&O)[DV / 32], float& m_run, float& l_run, const bool mtile, const int jb0, const int qpos, const int hi, const bool first) {
    constexpr int NDB = DV / 32;
    constexpr float THR = 8.0f;
    f32x16 s;
    bf16x8 kf[4], vf[NDB][2];
#pragma unroll
    for (int kk = 0; kk < 4; ++kk) kf[kk] = *(const bf16x8*)(kb + kk * 32);
#pragma unroll
    for (int db = 0; db < NDB; ++db) { vf[db][0] = *(const bf16x8*)(vb0 + db * 32 * 144); vf[db][1] = *(const bf16x8*)(vb0 + db * 32 * 144 + 32); }
    __builtin_amdgcn_sched_barrier(0);
#pragma unroll
    for (int r = 0; r < 16; ++r) s[r] = 0.f;
    __builtin_amdgcn_s_setprio(1);
#pragma unroll
    for (int kk = 0; kk < 4; ++kk) s = MFMA32(kf[kk], qf[kk], s);
    __builtin_amdgcn_s_setprio(0);
    if (WINDOW && mtile) {
#pragma unroll
        for (int r = 0; r < 16; ++r) {
            const int j = jb0 + 16 * (r >> 3) + 8 * hi + (r & 7);
            const int d0 = qpos - j;
            if (d0 > 128 || d0 < -128) s[r] = -1e30f;
        }
    }
    float mx = s[0];
#pragma unroll
    for (int r = 1; r < 16; ++r) mx = fmaxf(mx, s[r]);
    {
        auto rr = __builtin_amdgcn_permlane32_swap(__float_as_uint(mx), __float_as_uint(mx), false, false);
        mx = fmaxf(__uint_as_float(rr[0]), __uint_as_float(rr[1]));
    }
    mx -= m_run;
    if (first || __any(mx > THR)) {
        const float dl = first ? mx : fmaxf(mx, 0.f);
        m_run += dl;
        const float alpha = fexp2(-dl);
        l_run *= alpha;
#pragma unroll
        for (int db = 0; db < NDB; ++db)
#pragma unroll
            for (int r = 0; r < 16; ++r) O[db][r] *= alpha;
    }
    float rs = 0.f;
#pragma unroll
    for (int r = 0; r < 16; ++r) { s[r] = fexp2(s[r] - m_run); rs += s[r]; }
    l_run += rs;
    u32x4 w0, w1;
    w0.x = cvtpk(s[0], s[1]); w0.y = cvtpk(s[2], s[3]); w0.z = cvtpk(s[4], s[5]); w0.w = cvtpk(s[6], s[7]);
    w1.x = cvtpk(s[8], s[9]); w1.y = cvtpk(s[10], s[11]); w1.z = cvtpk(s[12], s[13]); w1.w = cvtpk(s[14], s[15]);
    const bf16x8 p0 = __builtin_bit_cast(bf16x8, w0), p1 = __builtin_bit_cast(bf16x8, w1);
    __builtin_amdgcn_s_setprio(1);
#pragma unroll
    for (int db = 0; db < NDB; ++db) {
        O[db] = MFMA32(vf[db][0], p0, O[db]);
        O[db] = MFMA32(vf[db][1], p1, O[db]);
    }
    __builtin_amdgcn_s_setprio(0);
}

template <int DV, bool WINDOW>
__device__ __forceinline__ void attn_pass(const bf16x8 (&qf)[4], const bf16_t* __restrict__ Kg, const bf16_t* __restrict__ Vg, const int NK,
                                          const int nt_lead, const int lt_lo, const int lt_hi, const int qpos, const int wq0,
                                          f32x16 (&O)[DV / 32], float& m_run, float& l_run, unsigned char* lds, const int tid) {
    constexpr int NDB = DV / 32, NVH = DV / 64, BUFB = 9216 + DV * 144;
    constexpr float THR = 8.0f;
    const int lane = tid & 63, i = lane & 31, hi = lane >> 5;
    const int pi = (i & 0x13) | ((i & 4) << 1) | ((i & 8) >> 1);
    const int krow = tid >> 3, kch = tid & 7;
    const int T = nt_lead + (lt_hi - lt_lo);
    const unsigned stK = krow * 144 + kch * 16;
    const unsigned rdK = pi * 144 + hi * 16, rdV = 9216 + i * 144 + hi * 16;
    u32x4 kregA, vregA[NVH], kregB, vregB[NVH];
    f32x16 negm;
#pragma unroll
    for (int r = 0; r < 16; ++r) negm[r] = 0.f;
    m_run = 0.f;
#define TILE_OF(it) ((it) < nt_lead ? (it) : lt_lo + ((it) - nt_lead))
#define LOADT(KR, VR, kt) do { KR = *(const u32x4*)(Kg + (size_t)((kt) * 64 + krow) * 64 + kch * 8); \
        _Pragma("unroll") for (int h_ = 0; h_ < NVH; ++h_) VR[h_] = *(const u32x4*)(Vg + (size_t)(h_ * 64 + krow) * NK + (kt) * 64 + kch * 8); } while (0)
#define STORET(KR, VR, buf) do { *(u32x4*)(lds + (buf) * BUFB + stK) = KR; \
        _Pragma("unroll") for (int h_ = 0; h_ < NVH; ++h_) *(u32x4*)(lds + (buf) * BUFB + 9216 + (h_ * 64 + krow) * 144 + kch * 16) = VR[h_]; } while (0)
#define STEP(it, KR, VR) do { \
        STORET(KR, VR, ((it) + 1) & 1); \
        { const int i3_ = ((it) + 3 < T) ? (it) + 3 : T - 1; const int kt3 = TILE_OF(i3_); LOADT(KR, VR, kt3); } \
        const int kt = TILE_OF(it); \
        const bool mtile = WINDOW && ((it) >= nt_lead); \
        const int j0 = kt * 64 - 256; \
        bool active = true; \
        if (mtile) active = (j0 + 63 >= wq0 - 128) && (j0 <= wq0 + 31 + 128); \
        if (active) { if (DV == 128) { const unsigned char* b_ = lds + ((it) & 1) * BUFB; \
                compute_block32<DV, WINDOW>(b_ + rdK, b_ + rdV, qf, negm, O, m_run, l_run, mtile, j0, qpos, hi, (it) == 0); \
                compute_block32<DV, WINDOW>(b_ + rdK + 32 * 144, b_ + rdV + 64, qf, negm, O, m_run, l_run, mtile, j0 + 32, qpos, hi, false); } \
            else compute_tile<DV, WINDOW>(lds + ((it) & 1) * BUFB, rdK, rdV, qf, negm, O, m_run, l_run, mtile, j0, qpos, hi, (it) == 0); } \
        asm volatile("s_waitcnt lgkmcnt(0)\n\ts_barrier" ::: "memory"); } while (0)
    { const int kt0 = TILE_OF(0); LOADT(kregA, vregA, kt0); }
    { const int i1_ = T > 1 ? 1 : T - 1; const int kt1 = TILE_OF(i1_); LOADT(kregB, vregB, kt1); }
    STORET(kregA, vregA, 0);
    { const int i2_ = T > 2 ? 2 : T - 1; const int kt2 = TILE_OF(i2_); LOADT(kregA, vregA, kt2); }
    asm volatile("s_waitcnt lgkmcnt(0)\n\ts_barrier" ::: "memory");
    for (int it = 0; it < T; it += 2) {
        STEP(it, kregB, vregB);
        if (it + 1 < T) STEP(it + 1, kregA, vregA);
    }
#undef TILE_OF
#undef LOADT
#undef STORET
#undef STEP
}

template <int NDB>
__device__ __forceinline__ void write_y(const f32x16 (&R)[NDB], const bf16_t* zgate, bf16_t* yout, int hi) {
    u32x4 gwv[NDB][2];
#pragma unroll
    for (int db = 0; db < NDB; ++db)
#pragma unroll
        for (int gp = 0; gp < 2; ++gp) gwv[db][gp] = *(const u32x4*)(zgate + 32 * db + 8 * (2 * gp + hi));
#pragma unroll
    for (int db = 0; db < NDB; ++db)
#pragma unroll
        for (int g = 0; g < 4; g += 2) {
            float v[8];
#pragma unroll
            for (int k = 0; k < 4; ++k) {
                auto rr = __builtin_amdgcn_permlane32_swap(__float_as_uint(R[db][4 * g + k]), __float_as_uint(R[db][4 * (g + 1) + k]), false, false);
                v[k] = __uint_as_float(rr[0]); v[4 + k] = __uint_as_float(rr[1]);
            }
            const int d0 = 32 * db + 8 * (g + hi);
            const u32x4 gw = gwv[db][g >> 1];
            u32x4 o;
            o.x = cvtpk(v[0] * siluf(bflo(gw.x)), v[1] * siluf(bfhi(gw.x))); o.y = cvtpk(v[2] * siluf(bflo(gw.y)), v[3] * siluf(bfhi(gw.y)));
            o.z = cvtpk(v[4] * siluf(bflo(gw.z)), v[5] * siluf(bfhi(gw.z))); o.w = cvtpk(v[6] * siluf(bflo(gw.w)), v[7] * siluf(bfhi(gw.w)));
            *(u32x4*)(yout + d0) = o;
        }
}

template <int NDB>
__device__ __forceinline__ void softmax1(f32x16& s, f32x16 (&O)[NDB], float& m_run, float& l_run, const bool first, bf16x8& p0, bf16x8& p1) {
    constexpr float THR = 8.0f;
    float mx = s[0];
#pragma unroll
    for (int r = 1; r < 16; ++r) mx = fmaxf(mx, s[r]);
    {
        auto rr = __builtin_amdgcn_permlane32_swap(__float_as_uint(mx), __float_as_uint(mx), false, false);
        mx = fmaxf(__uint_as_float(rr[0]), __uint_as_float(rr[1]));
    }
    mx -= m_run;
    if (first || __any(mx > THR)) {
        const float dl = first ? mx : fmaxf(mx, 0.f);
        m_run += dl;
        const float alpha = fexp2(-dl);
        l_run *= alpha;
#pragma unroll
        for (int db = 0; db < NDB; ++db)
#pragma unroll
            for (int r = 0; r < 16; ++r) O[db][r] *= alpha;
    }
    float rs = 0.f;
#pragma unroll
    for (int r = 0; r < 16; ++r) { s[r] = fexp2(s[r] - m_run); rs += s[r]; }
    l_run += rs;
    u32x4 w0, w1;
    w0.x = cvtpk(s[0], s[1]); w0.y = cvtpk(s[2], s[3]); w0.z = cvtpk(s[4], s[5]); w0.w = cvtpk(s[6], s[7]);
    w1.x = cvtpk(s[8], s[9]); w1.y = cvtpk(s[10], s[11]); w1.z = cvtpk(s[12], s[13]); w1.w = cvtpk(s[14], s[15]);
    p0 = __builtin_bit_cast(bf16x8, w0); p1 = __builtin_bit_cast(bf16x8, w1);
}
__device__ __forceinline__ void attn_pass_q2(const bf16x8 (&qfA)[4], const bf16x8 (&qfB)[4], const bf16_t* __restrict__ Kg, const bf16_t* __restrict__ Vg, const int NK, const int T,
                                             f32x16 (&OA)[2], f32x16 (&OB)[2], float& mA, float& lA, float& mB, float& lB, unsigned char* lds, const int tid) {
    constexpr int BUFB = 9216 + 64 * 144;
    const int lane = tid & 63, i = lane & 31, hi = lane >> 5;
    const int pi = (i & 0x13) | ((i & 4) << 1) | ((i & 8) >> 1);
    const int krow = tid >> 3, kch = tid & 7;
    const unsigned stK = krow * 144 + kch * 16;
    const unsigned rdK = pi * 144 + hi * 16, rdV = 9216 + i * 144 + hi * 16;
    u32x4 kreg, vreg;
    mA = 0.f; mB = 0.f;
    const unsigned kgo = (unsigned)(krow * 64 + kch * 8) * 2u, vgo = (unsigned)(krow * NK + kch * 8) * 2u;
#define LOADT2(kt) do { kreg = *(const u32x4*)((const char*)Kg + (size_t)(kt) * 8192 + kgo); vreg = *(const u32x4*)((const char*)Vg + (size_t)(kt) * 128 + vgo); } while (0)
#define STORET2(off) do { *(u32x4*)(lds + (off) + stK) = kreg; *(u32x4*)(lds + (off) + 9216 + stK) = vreg; } while (0)
#define QK2(SA, SB, kptr) do { bf16x8 kf_[4]; \
        _Pragma("unroll") for (int kk = 0; kk < 4; ++kk) kf_[kk] = *(const bf16x8*)((kptr) + kk * 32); \
        _Pragma("unroll") for (int r = 0; r < 16; ++r) { SA[r] = 0.f; SB[r] = 0.f; } \
        __builtin_amdgcn_s_setprio(1); \
        _Pragma("unroll") for (int kk = 0; kk < 4; ++kk) { SA = MFMA32(kf_[kk], qfA[kk], SA); SB = MFMA32(kf_[kk], qfB[kk], SB); } \
        __builtin_amdgcn_s_setprio(0); } while (0)
#define SMPV2(SA, SB, vptr, first) do { bf16x8 vf_[4], p0_, p1_; \
        _Pragma("unroll") for (int q = 0; q < 4; ++q) vf_[q] = *(const bf16x8*)((vptr) + (q >> 1) * 32 * 144 + (q & 1) * 32); \
        softmax1<2>(SA, OA, mA, lA, (first), p0_, p1_); \
        __builtin_amdgcn_s_setprio(1); \
        OA[0] = MFMA32(vf_[0], p0_, OA[0]); OA[1] = MFMA32(vf_[2], p0_, OA[1]); OA[0] = MFMA32(vf_[1], p1_, OA[0]); OA[1] = MFMA32(vf_[3], p1_, OA[1]); \
        __builtin_amdgcn_s_setprio(0); \
        softmax1<2>(SB, OB, mB, lB, (first), p0_, p1_); \
        __builtin_amdgcn_s_setprio(1); \
        OB[0] = MFMA32(vf_[0], p0_, OB[0]); OB[1] = MFMA32(vf_[2], p0_, OB[1]); OB[0] = MFMA32(vf_[1], p1_, OB[0]); OB[1] = MFMA32(vf_[3], p1_, OB[1]); \
        __builtin_amdgcn_s_setprio(0); } while (0)
    LOADT2(0); STORET2(0);
    { const int t1 = T > 1 ? 1 : T - 1; LOADT2(t1); } STORET2(BUFB);
    { const int t2 = T > 2 ? 2 : T - 1; LOADT2(t2); }
    asm volatile("s_waitcnt lgkmcnt(0)\n\ts_barrier" ::: "memory");
    unsigned o_cur = 0, o_nxt = BUFB, o_nn = 2 * BUFB;
    f32x16 sXA, sXB, sYA, sYB;
    QK2(sXA, sXB, lds + o_cur + rdK);
    for (int t = 0; t < T; ++t) {
        QK2(sYA, sYB, lds + o_cur + rdK + 32 * 144);
        __builtin_amdgcn_sched_barrier(0);
        SMPV2(sXA, sXB, lds + o_cur + rdV, t == 0);
        __builtin_amdgcn_sched_barrier(0);
        if (t + 1 < T) {
            asm volatile("s_waitcnt lgkmcnt(0)\n\ts_barrier" ::: "memory");
            STORET2(o_nn);
            { const int t3 = (t + 3 < T) ? t + 3 : T - 1; LOADT2(t3); }
            QK2(sXA, sXB, lds + o_nxt + rdK);
        }
        __builtin_amdgcn_sched_barrier(0);
        SMPV2(sYA, sYB, lds + o_cur + rdV + 64, false);
        __builtin_amdgcn_sched_barrier(0);
        { const unsigned tmp = o_cur; o_cur = o_nxt; o_nxt = o_nn; o_nn = tmp; }
    }
    asm volatile("s_waitcnt lgkmcnt(0)\n\ts_barrier" ::: "memory");
#undef LOADT2
#undef STORET2
#undef QK2
#undef SMPV2
}

__device__ __forceinline__ void attn_pass_w2(const bf16x8 (&qfA)[4], const bf16x8 (&qfB)[4], const bf16_t* __restrict__ Kg, const bf16_t* __restrict__ Vg, const int NK,
                                             const int lt_lo, const int lt_hi, const int qpos, const int wq0,
                                             f32x16 (&OA)[2], f32x16 (&OB)[2], float& mA, float& lA, float& mB, float& lB, unsigned char* lds, const int tid) {
    constexpr int BUFB = 9216 + 64 * 144;
    const int lane = tid & 63, i = lane & 31, hi = lane >> 5;
    const int pi = (i & 0x13) | ((i & 4) << 1) | ((i & 8) >> 1);
    const int krow = tid >> 3, kch = tid & 7;
    const int T = 4 + (lt_hi - lt_lo);
    const unsigned stK = krow * 144 + kch * 16;
    const unsigned rdK = pi * 144 + hi * 16, rdV = 9216 + i * 144 + hi * 16;
    const unsigned kgo = (unsigned)(krow * 64 + kch * 8) * 2u, vgo = (unsigned)(krow * NK + kch * 8) * 2u;
    u32x4 kregA, vregA;
    mA = 0.f; mB = 0.f;
#define TILE_W(it) ((it) < 4 ? (it) : lt_lo + ((it) - 4))
#define LOADW(KR, VR, kt) do { KR = *(const u32x4*)((const char*)Kg + (size_t)(kt) * 8192 + kgo); VR = *(const u32x4*)((const char*)Vg + (size_t)(kt) * 128 + vgo); } while (0)
#define STOREW(KR, VR, buf) do { *(u32x4*)(lds + (buf) * BUFB + stK) = KR; *(u32x4*)(lds + (buf) * BUFB + 9216 + stK) = VR; } while (0)
#define STEPW(it, KR, VR) do { \
        STOREW(KR, VR, ((it) + 1) & 1); \
        { const int i3_ = ((it) + 2 < T) ? (it) + 2 : T - 1; const int kt3_ = TILE_W(i3_); LOADW(KR, VR, kt3_); } \
        const int kt_ = TILE_W(it); \
        const bool mtile_ = (it) >= 4; \
        const int j0_ = kt_ * 64 - 256; \
        const bool active_ = !mtile_ || ((j0_ + 63 >= wq0 - 128) && (j0_ <= wq0 + 31 + 128)); \
        if (active_) { \
            const unsigned char* base = lds + ((it) & 1) * BUFB; \
            _Pragma("unroll") for (int kb = 0; kb < 2; ++kb) { \
                bf16x8 kf[4], vf[4]; \
                _Pragma("unroll") for (int kk = 0; kk < 4; ++kk) kf[kk] = *(const bf16x8*)(base + rdK + kb * 32 * 144 + kk * 32); \
                _Pragma("unroll") for (int q = 0; q < 4; ++q) vf[q] = *(const bf16x8*)(base + rdV + (q >> 1) * 32 * 144 + kb * 64 + (q & 1) * 32); \
                bf16x8 p0, p1; \
                { f32x16 sA; \
                  _Pragma("unroll") for (int r = 0; r < 16; ++r) sA[r] = 0.f; \
                  _Pragma("unroll") for (int kk = 0; kk < 4; ++kk) sA = MFMA32(kf[kk], qfA[kk], sA); \
                  if (mtile_) { int qd_ = qpos - j0_ - 32 * kb - 8 * hi; asm volatile("" : "+v"(qd_));     \
                      _Pragma("unroll") for (int r = 0; r < 16; ++r) { \
                          const int d0_ = qd_ - (16 * (r >> 3) + (r & 7)); \
                          if (d0_ > 128 || d0_ < -128) sA[r] = -1e30f; } } \
                  softmax1<2>(sA, OA, mA, lA, (it) == 0 && kb == 0, p0, p1); } \
                OA[0] = MFMA32(vf[0], p0, OA[0]); OA[1] = MFMA32(vf[2], p0, OA[1]); OA[0] = MFMA32(vf[1], p1, OA[0]); OA[1] = MFMA32(vf[3], p1, OA[1]); \
                { f32x16 sB; \
                  _Pragma("unroll") for (int r = 0; r < 16; ++r) sB[r] = 0.f; \
                  _Pragma("unroll") for (int kk = 0; kk < 4; ++kk) sB = MFMA32(kf[kk], qfB[kk], sB); \
                  if (mtile_) { int qd_ = qpos - j0_ - 32 * kb - 8 * hi; asm volatile("" : "+v"(qd_));     \
                      _Pragma("unroll") for (int r = 0; r < 16; ++r) { \
                          const int d0_ = qd_ - (16 * (r >> 3) + (r & 7)); \
                          if (d0_ > 128 || d0_ < -128) sB[r] = -1e30f; } } \
                  softmax1<2>(sB, OB, mB, lB, (it) == 0 && kb == 0, p0, p1); } \
                OB[0] = MFMA32(vf[0], p0, OB[0]); OB[1] = MFMA32(vf[2], p0, OB[1]); OB[0] = MFMA32(vf[1], p1, OB[0]); OB[1] = MFMA32(vf[3], p1, OB[1]); \
            } } \
        asm volatile("s_waitcnt lgkmcnt(0)\n\ts_barrier" ::: "memory"); } while (0)
    LOADW(kregA, vregA, 0);
    STOREW(kregA, vregA, 0);
    { const int kt1 = TILE_W(1); LOADW(kregA, vregA, kt1); }
    asm volatile("s_waitcnt lgkmcnt(0)\n\ts_barrier" ::: "memory");
    for (int it = 0; it < T; ++it) STEPW(it, kregA, vregA);
#undef TILE_W
#undef LOADW
#undef STOREW
#undef STEPW
}

__device__ __forceinline__ void unit_A2(const Params& p, int u, unsigned char* lds, int tid) {
    unsigned char* ws = p.ws;
    const bf16_t* Z = (const bf16_t*)(ws + WS_Z); bf16_t* Y = (bf16_t*)(ws + WS_XN);
    const int qb = u & 31, kv = (u >> 5) & 1, b = u >> 6;
    const int q0 = qb * 128;
    f32x16 OA[2], OB[2];
    float mA, lA = 0.f, mB, lB = 0.f;
    {
        const float* cosT = (const float*)(ws + WS_ROPE); const float* sinT = cosT + 1024;
        const int wave = tid >> 6, lane = tid & 63, i = lane & 31, hi = lane >> 5;
        const int hA = kv * 4 + 2 * (wave >> 2);
        const int wq0 = q0 + (wave & 3) * 32, qloc = wq0 + i;
        const bf16_t* zrow = Z + ((size_t)NCTXTOK + (size_t)b * 4096 + qloc) * PZ;
        bf16x8 qfA[4], qfB[4];
        load_q<false, true>(zrow + hA * 64, hi, nullptr, qloc, cosT, sinT, qfA);
        load_q<false, true>(zrow + hA * 64 + 64, hi, nullptr, qloc, cosT, sinT, qfB);
        const bf16_t* Kg = (const bf16_t*)(ws + L0_KA_LAT) + (size_t)(b * 2 + kv) * NKL * 64;
        const bf16_t* Vg = (const bf16_t*)(ws + L0_VTA_LAT) + (size_t)(b * 2 + kv) * 64 * NKL;
#pragma unroll
        for (int db = 0; db < 2; ++db)
#pragma unroll
            for (int r = 0; r < 16; ++r) { OA[db][r] = 0.f; OB[db][r] = 0.f; }
        const int tq = q0 >> 6;
        const int lo = 4 + (tq - 2 > 0 ? tq - 2 : 0), hiT = 4 + (tq + 4 < 64 ? tq + 4 : 64);
        attn_pass_w2(qfA, qfB, Kg, Vg, NKL, lo, hiT, qloc, wq0, OA, OB, mA, lA, mB, lB, lds, tid);
    }
    int t2 = threadIdx.x; asm volatile("" : "+v"(t2));
    const int wave = t2 >> 6, lane = t2 & 63, i = lane & 31, hi = lane >> 5;
    const int hA = kv * 4 + 2 * (wave >> 2), hB = hA + 1;
    const int qloc = q0 + (wave & 3) * 32 + i;
    const size_t tok = (size_t)NCTXTOK + (size_t)b * 4096 + qloc;
    const bf16_t* zrow = Z + tok * PZ;
    lA += __shfl_xor(lA, 32); lB += __shfl_xor(lB, 32);
    lA += fexp2(p.in[I_SINK][hA] * LOG2E - mA); lB += fexp2(p.in[I_SINK][hB] * LOG2E - mB);
    const float iA = 1.0f / lA, iB = 1.0f / lB;
#pragma unroll
    for (int db = 0; db < 2; ++db)
#pragma unroll
        for (int r = 0; r < 16; ++r) { OA[db][r] *= iA; OB[db][r] *= iB; }
    write_y<2>(OA, zrow + 2304 + hA * 64, Y + tok * DM + hA * 64, hi);
    write_y<2>(OB, zrow + 2304 + hB * 64, Y + tok * DM + hB * 64, hi);
}

__device__ __forceinline__ void unit_D2(const Params& p, int u, unsigned char* lds, int tid) {
    unsigned char* ws = p.ws;
    const bf16_t* Z = (const bf16_t*)(ws + WS_Z); bf16_t* Y = (bf16_t*)(ws + WS_XN);
    const float* cosT = (const float*)(ws + WS_ROPE); const float* sinT = cosT + 1024;
    const int qb = u & 7, hq = (u >> 3) & 7, b = u >> 6;
    const int kvh = hq >> 2, wave = tid >> 6, lane = tid & 63, i = lane & 31, hi = lane >> 5;
    const int qA = qb * 512 + wave * 64 + i, qB = qA + 32;
    const size_t tokA = (size_t)NCTXTOK + (size_t)b * 4096 + qA, tokB = tokA + 32;
    bf16x8 qfA[4], qfB[4];
    load_q<true, true>(Z + tokA * PZ + 1536 + hq * 64, hi, p.in[I_DQG], qA, cosT, sinT, qfA);
    load_q<true, true>(Z + tokB * PZ + 1536 + hq * 64, hi, p.in[I_DQG], qB, cosT, sinT, qfB);
    const bf16_t* Kg = (const bf16_t*)(ws + L1_KD_LAT) + (size_t)(b * 2 + kvh) * NKL * 64;
    const bf16_t* Vg = (const bf16_t*)(ws + L1_VTD_LAT) + (size_t)(b * 2 + kvh) * 64 * NKL;
    f32x16 OA[2], OB[2];
#pragma unroll
    for (int db = 0; db < 2; ++db)
#pragma unroll
        for (int r = 0; r < 16; ++r) { OA[db][r] = 0.f; OB[db][r] = 0.f; }
    float mA, lA = 0.f, mB, lB = 0.f;
    attn_pass_q2(qfA, qfB, Kg, Vg, NKL, NKL / 64, OA, OB, mA, lA, mB, lB, lds, tid);
    lA += __shfl_xor(lA, 32); lB += __shfl_xor(lB, 32);
    const float iA = 1.0f / lA, iB = 1.0f / lB;
#pragma unroll
    for (int db = 0; db < 2; ++db)
#pragma unroll
        for (int r = 0; r < 16; ++r) { OA[db][r] *= iA; OB[db][r] *= iB; }
    write_y<2>(OA, Z + tokA * PZ + 2816 + hq * 64, Y + tokA * DM + 512 + hq * 64, hi);
    write_y<2>(OB, Z + tokB * PZ + 2816 + hq * 64, Y + tokB * DM + 512 + hq * 64, hi);
}

template <bool LAT>
__device__ __forceinline__ void unit_A(const Params& p, int u, unsigned char* lds, int tid) {
    unsigned char* ws = p.ws;
    const bf16_t* Z = (const bf16_t*)(ws + WS_Z); bf16_t* Y = (bf16_t*)(ws + WS_XN);
    const float* cosT = (const float*)(ws + WS_ROPE); const float* sinT = cosT + 1024;
    int qb, hq, b;
    if (LAT) { qb = u & 15; hq = (u >> 4) & 7; b = u >> 7; } else { qb = 0; hq = u & 7; b = u >> 3; }
    const int kvh = hq >> 2, wave = tid >> 6, lane = tid & 63, i = lane & 31, hi = lane >> 5;
    const int q0 = qb * 256, qloc = q0 + wave * 32 + i;
    const size_t tok = LAT ? (size_t)NCTXTOK + (size_t)b * 4096 + qloc : (size_t)b * 256 + qloc;
    const bf16_t* zrow = Z + tok * PZ;
    bf16x8 qf[4];
    load_q<false, LAT>(zrow + hq * 64, hi, nullptr, qloc, cosT, sinT, qf);
    const int NK = LAT ? NKL : 256;
    const bf16_t* Kg = (const bf16_t*)(ws + (LAT ? L0_KA_LAT : L0_KA_CTX)) + (size_t)(b * 2 + kvh) * NK * 64;
    const bf16_t* Vg = (const bf16_t*)(ws + (LAT ? L0_VTA_LAT : L0_VTA_CTX)) + (size_t)(b * 2 + kvh) * 64 * NK;
    f32x16 O[2];
#pragma unroll
    for (int db = 0; db < 2; ++db)
#pragma unroll
        for (int r = 0; r < 16; ++r) O[db][r] = 0.f;
    float m = -1e30f, l = 0.f;
    if (LAT) {
        const int tq = q0 >> 6;
        const int lo = 4 + (tq - 2 > 0 ? tq - 2 : 0), hiT = 4 + (tq + 6 < 64 ? tq + 6 : 64);
        attn_pass<64, true>(qf, Kg, Vg, NK, 4, lo, hiT, qloc, q0 + wave * 32, O, m, l, lds, tid);
    } else {
        attn_pass<64, false>(qf, Kg, Vg, NK, 4, 0, 0, 0, 0, O, m, l, lds, tid);
    }
    l += __shfl_xor(l, 32);
    l += fexp2(p.in[I_SINK][hq] * LOG2E - m);
    const float inv = 1.0f / l;
#pragma unroll
    for (int db = 0; db < 2; ++db)
#pragma unroll
        for (int r = 0; r < 16; ++r) O[db][r] *= inv;
    write_y<2>(O, zrow + 2304 + hq * 64, Y + tok * DM + hq * 64, hi);
}

template <bool LAT>
__device__ __forceinline__ void unit_B(const Params& p, int u, unsigned char* lds, int tid) {
    unsigned char* ws = p.ws;
    const bf16_t* Z = (const bf16_t*)(ws + WS_Z); bf16_t* Y = (bf16_t*)(ws + WS_XN);
    const float* cosT = (const float*)(ws + WS_ROPE); const float* sinT = cosT + 1024;
    int qb, h, b;
    if (LAT) { qb = u & 15; h = (u >> 4) & 3; b = u >> 6; } else { qb = 0; h = u & 3; b = u >> 2; }
    const int wave = tid >> 6, lane = tid & 63, i = lane & 31, hi = lane >> 5;
    const int q0 = qb * 256, qloc = q0 + wave * 32 + i;
    const size_t tok = LAT ? (size_t)NCTXTOK + (size_t)b * 4096 + qloc : (size_t)b * 256 + qloc;
    const bf16_t* zrow = Z + tok * PZ;
    const int NK = LAT ? NKL : 256;
    const float lam = *(const float*)(ws + WS_LAM);
    const bf16_t* Vg = (const bf16_t*)(ws + (LAT ? L0_VTB_LAT : L0_VTB_CTX)) + (size_t)(b * 4 + h) * 128 * NK;
    f32x16 R[4];
#pragma unroll 1
    for (int pass = 0; pass < 2; ++pass) {
        bf16x8 qf[4];
        load_q<false, LAT>(zrow + 768 + h * 128 + pass * 64, hi, nullptr, qloc, cosT, sinT, qf);
        const size_t kb = LAT ? (pass ? L0_KB2_LAT : L0_KB1_LAT) : (pass ? L0_KB2_CTX : L0_KB1_CTX);
        const bf16_t* Kg = (const bf16_t*)(ws + kb) + (size_t)(b * 4 + h) * NK * 64;
#pragma unroll
        for (int db = 0; db < 4; ++db)
#pragma unroll
            for (int r = 0; r < 16; ++r) R[db][r] = 0.f;
        float m = -1e30f, l = 0.f;
        attn_pass<128, false>(qf, Kg, Vg, NK, NK / 64, 0, 0, 0, 0, R, m, l, lds, tid);
        l += __shfl_xor(l, 32);
        const float inv = 1.0f / l;
        unsigned* stash = (unsigned*)(lds + 55296 + wave * 8192) + lane;
        if (pass == 0) {
#pragma unroll
            for (int db = 0; db < 4; ++db)
#pragma unroll
                for (int r = 0; r < 8; ++r) stash[(db * 8 + r) * 64] = cvtpk(R[db][2 * r] * inv, R[db][2 * r + 1] * inv);
        } else {
            const float f = lam * inv;
#pragma unroll
            for (int db = 0; db < 4; ++db)
#pragma unroll
                for (int r = 0; r < 8; ++r) { const unsigned w = stash[(db * 8 + r) * 64]; R[db][2 * r] = bflo(w) - f * R[db][2 * r]; R[db][2 * r + 1] = bfhi(w) - f * R[db][2 * r + 1]; }
        }
    }
    float ss = 0.f;
#pragma unroll
    for (int db = 0; db < 4; ++db)
#pragma unroll
        for (int r = 0; r < 16; ++r) ss += R[db][r] * R[db][r];
    ss += __shfl_xor(ss, 32);
    const float rinv = rsqrtf(ss * (1.0f / 128.0f) + EPS) * 0.8f;
    const float* bng = p.in[I_BNG];
#pragma unroll
    for (int db = 0; db < 4; ++db)
#pragma unroll
        for (int g = 0; g < 4; ++g) {
            const f32x4 gg = *(const f32x4*)(bng + 32 * db + 8 * g + 4 * hi);
            R[db][4 * g] *= rinv * gg.x; R[db][4 * g + 1] *= rinv * gg.y; R[db][4 * g + 2] *= rinv * gg.z; R[db][4 * g + 3] *= rinv * gg.w;
        }
    write_y<4>(R, zrow + 2816 + h * 128, Y + tok * DM + 512 + h * 128, hi);
}

template <bool LAT>
__device__ __forceinline__ void unit_D(const Params& p, int u, unsigned char* lds, int tid) {
    unsigned char* ws = p.ws;
    const bf16_t* Z = (const bf16_t*)(ws + WS_Z); bf16_t* Y = (bf16_t*)(ws + WS_XN);
    const float* cosT = (const float*)(ws + WS_ROPE); const float* sinT = cosT + 1024;
    int qb, hq, b;
    if (LAT) { qb = u & 15; hq = (u >> 4) & 7; b = u >> 7; } else { qb = 0; hq = u & 7; b = u >> 3; }
    const int kvh = hq >> 2, wave = tid >> 6, lane = tid & 63, i = lane & 31, hi = lane >> 5;
    const int q0 = qb * 256, qloc = q0 + wave * 32 + i;
    const size_t tok = LAT ? (size_t)NCTXTOK + (size_t)b * 4096 + qloc : (size_t)b * 256 + qloc;
    const bf16_t* zrow = Z + tok * PZ;
    bf16x8 qf[4];
    load_q<true, LAT>(zrow + 1536 + hq * 64, hi, p.in[I_DQG], qloc, cosT, sinT, qf);
    const int NK = LAT ? NKL : 256;
    const bf16_t* Kg = (const bf16_t*)(ws + (LAT ? L1_KD_LAT : L1_KD_CTX)) + (size_t)(b * 2 + kvh) * NK * 64;
    const bf16_t* Vg = (const bf16_t*)(ws + (LAT ? L1_VTD_LAT : L1_VTD_CTX)) + (size_t)(b * 2 + kvh) * 64 * NK;
    f32x16 O[2];
#pragma unroll
    for (int db = 0; db < 2; ++db)
#pragma unroll
        for (int r = 0; r < 16; ++r) O[db][r] = 0.f;
    float m = -1e30f, l = 0.f;
    attn_pass<64, false>(qf, Kg, Vg, NK, NK / 64, 0, 0, 0, 0, O, m, l, lds, tid);
    l += __shfl_xor(l, 32);
    const float inv = 1.0f / l;
#pragma unroll
    for (int db = 0; db < 2; ++db)
#pragma unroll
        for (int r = 0; r < 16; ++r) O[db][r] *= inv;
    write_y<2>(O, zrow + 2816 + hq * 64, Y + tok * DM + 512 + hq * 64, hi);
}

template <bool LAT>
__device__ __forceinline__ void scan_unit(const Params& p, int u, int lane) {
    unsigned char* ws = p.ws;
    constexpr int NS = LAT ? 4096 : 256, NCH = LAT ? 32 : 2;
    const int db = u & 3, eb = (u >> 2) & 3, dir = (u >> 4) & 1, sh = u >> 5, h = sh & 3;
    const int i = lane & 31, hi = lane >> 5;
    const bf16_t* Kt = (const bf16_t*)(ws + (LAT ? L1_KTL : L1_KTC)) + (size_t)sh * 128 * NS + (size_t)(db * 8 * 64 + lane) * 8;
    const bf16_t* Vt = (const bf16_t*)(ws + (LAT ? L1_VTL : L1_VTC)) + (size_t)sh * 128 * NS + (size_t)(eb * 8 * 64 + lane) * 8;
    bf16_t* St = (bf16_t*)(ws + (LAT ? (dir ? L1_STB_L : L1_STF_L) : (dir ? L1_STB_C : L1_STF_C))) + (size_t)sh * NCH * 16384;
    const float lg2 = -expf(p.in[dir ? I_DECB : I_DECF][h]) * LOG2E;
    f32x16 acc;
    if (LAT) {
        const float* s0 = p.in[dir ? I_SCB : I_SCF] + (size_t)sh * 16384;
#pragma unroll
        for (int r = 0; r < 16; ++r) acc[r] = s0[(size_t)(db * 32 + i) * 128 + eb * 32 + crow(r, hi)];
    } else {
#pragma unroll
        for (int r = 0; r < 16; ++r) acc[r] = 0.f;
    }
    float base[8];
#pragma unroll
    for (int jj = 0; jj < 8; ++jj) base[jj] = KSCALE_C * (dir ? fexp2(lg2 * (float)(8 * hi + jj)) : fexp2(lg2 * (float)(127 - 8 * hi - jj)));
    const float step = dir ? fexp2(16.0f * lg2) : fexp2(-16.0f * lg2);
    const float cdec = fexp2(128.0f * lg2);
    u32x4 va[8], kb[8];
    {
        const int c0 = dir ? NCH - 1 : 0;
#pragma unroll
        for (int ks = 0; ks < 8; ++ks) { va[ks] = *(const u32x4*)(Vt + (size_t)c0 * 16384 + ks * 512); kb[ks] = *(const u32x4*)(Kt + (size_t)c0 * 16384 + ks * 512); }
    }
#pragma unroll 1
    for (int cc = 0; cc < NCH; ++cc) {
        const int c = dir ? NCH - 1 - cc : cc;
        const int cn = dir ? c - 1 : c + 1;
        const bool more = cc + 1 < NCH;
        bf16_t* So = St + (size_t)c * 16384;
#pragma unroll
        for (int r = 0; r < 16; ++r) So[(size_t)(((eb * 8 + 2 * db + (i >> 4)) * 64 + ((i >> 3) & 1) * 32 + crow(r, hi)) * 8 + (i & 7))] = (bf16_t)(cvtpk(acc[r], 0.f) & 0xffffu);
#pragma unroll
        for (int r = 0; r < 16; ++r) acc[r] *= cdec;
        float f[8];
#pragma unroll
        for (int jj = 0; jj < 8; ++jj) f[jj] = base[jj];
#pragma unroll
        for (int ks = 0; ks < 8; ++ks) {
            float v[8]; unpack8(va[ks], v);
#pragma unroll
            for (int jj = 0; jj < 8; ++jj) { v[jj] *= f[jj]; f[jj] *= step; }
            const bf16x8 a = __builtin_bit_cast(bf16x8, pack8(v));
            const bf16x8 bq = __builtin_bit_cast(bf16x8, kb[ks]);
            if (more) { va[ks] = *(const u32x4*)(Vt + (size_t)cn * 16384 + ks * 512); kb[ks] = *(const u32x4*)(Kt + (size_t)cn * 16384 + ks * 512); }
            acc = MFMA32(a, bq, acc);
        }
    }
    if (!LAT) {
        float* o = p.out + (dir ? O_CB : O_CF) + (size_t)sh * 16384;
#pragma unroll
        for (int r = 0; r < 16; ++r) o[(size_t)(db * 32 + i) * 128 + eb * 32 + crow(r, hi)] = acc[r];
    }
}

template <bool LAT>
__device__ __forceinline__ void retout_unit(const Params& p, int u, int lane) {
    unsigned char* ws = p.ws;
    constexpr int NS = LAT ? 4096 : 256, NCH = LAT ? 32 : 2;
    const bf16_t* Z = (const bf16_t*)(ws + WS_Z); bf16_t* Y = (bf16_t*)(ws + WS_XN);
    const int ib = u & 3, c = (u >> 2) % NCH, sh = (u >> 2) / NCH, h = sh & 3, seq = sh >> 2;
    const int i = lane & 31, hi = lane >> 5;
    const int pi = (i & 0x13) | ((i & 4) << 1) | ((i & 8) >> 1);
    const size_t tok0 = LAT ? (size_t)NCTXTOK + (size_t)seq * 4096 + c * 128 : (size_t)seq * 256 + c * 128;
    const int iloc = ib * 32 + i;
    const bf16_t* zq = Z + (tok0 + iloc) * PZ + h * 128;
    bf16x8 qf[8];
#pragma unroll
    for (int kk = 0; kk < 8; ++kk) qf[kk] = *(const bf16x8*)(zq + 16 * kk + 8 * hi);
    const float lgf2 = -expf(p.in[I_DECF][h]) * LOG2E, lgb2 = -expf(p.in[I_DECB][h]) * LOG2E;
    const bf16_t* Vt = (const bf16_t*)(ws + (LAT ? L1_VTL : L1_VTC)) + (size_t)sh * 128 * NS + (size_t)c * 16384;
    const bf16_t* SF = (const bf16_t*)(ws + (LAT ? L1_STF_L : L1_STF_C)) + ((size_t)sh * NCH + c) * 16384;
    const bf16_t* SB = (const bf16_t*)(ws + (LAT ? L1_STB_L : L1_STB_C)) + ((size_t)sh * NCH + c) * 16384;
    const char* zkU = LAT ? (const char*)(ws + kf_base(sh)) + (size_t)c * 32768 : (const char*)(Z + tok0 * PZ + 512 + h * 128);
    const unsigned zkL = LAT ? (unsigned)lane * 16u : (unsigned)(pi * PZ + 8 * hi) * 2u;
    constexpr unsigned kjs = LAT ? 8192u : (unsigned)(32 * PZ * 2), kks = LAT ? 1024u : 32u;
    const char* vtU = (const char*)Vt;
    const unsigned vtL = (unsigned)lane * 16u;
    const char* sfU = (const char*)SF; const char* sbU = (const char*)SB;
    const unsigned sL = (unsigned)lane * 16u;
    f32x16 O[4];
#pragma unroll
    for (int eb = 0; eb < 4; ++eb)
#pragma unroll
        for (int r = 0; r < 16; ++r) O[eb][r] = 0.f;
    bf16x8 fa[8], fb[8];
#pragma unroll
    for (int kk = 0; kk < 8; ++kk) fa[kk] = *(const bf16x8*)(zkU + kk * kks + zkL);
#pragma unroll
    for (int q = 0; q < 8; ++q) fb[q] = *(const bf16x8*)(vtU + (size_t)((q >> 1) * 8192 + (q & 1) * 1024) + vtL);
#pragma unroll 1
    for (int jb = 0; jb < 4; ++jb) {
        const bool lastj = (jb == 3);
        const char* nA = lastj ? sfU : zkU + (size_t)(jb + 1) * kjs;
        const unsigned nAL = lastj ? sL : zkL;
        const char* nB = lastj ? sbU : vtU + (size_t)2048 * (jb + 1);
        const unsigned nBL = lastj ? sL : vtL;
        const unsigned qs1 = 1024u, qs2 = lastj ? 2048u : 8192u;
        const unsigned kst = lastj ? 1024u : kks;
        f32x16 s;
#pragma unroll
        for (int r = 0; r < 16; ++r) s[r] = 0.f;
#pragma unroll
        for (int kk = 0; kk < 8; ++kk) {
            s = MFMA32(fa[kk], qf[kk], s);
            fa[kk] = *(const bf16x8*)(nA + (size_t)(kk * kst) + nAL);
        }
#pragma unroll
        for (int r = 0; r < 16; ++r) {
            const int j = 32 * jb + 16 * (r >> 3) + 8 * hi + (r & 7);
            const int dl = iloc - j;
            const float w = dl >= 0 ? fexp2(lgf2 * (float)dl) : fexp2(lgb2 * (float)(-dl - 1));
            s[r] *= w * KSCALE_C;
        }
        u32x4 w0, w1;
        w0.x = cvtpk(s[0], s[1]); w0.y = cvtpk(s[2], s[3]); w0.z = cvtpk(s[4], s[5]); w0.w = cvtpk(s[6], s[7]);
        w1.x = cvtpk(s[8], s[9]); w1.y = cvtpk(s[10], s[11]); w1.z = cvtpk(s[12], s[13]); w1.w = cvtpk(s[14], s[15]);
        const bf16x8 p0 = __builtin_bit_cast(bf16x8, w0), p1 = __builtin_bit_cast(bf16x8, w1);
#pragma unroll
        for (int q = 0; q < 8; ++q) {
            O[q >> 1] = MFMA32(fb[q], (q & 1) ? p1 : p0, O[q >> 1]);
            fb[q] = *(const bf16x8*)(nB + (size_t)((q & 1) * qs1 + (q >> 1) * qs2) + nBL);
        }
    }
    const float wf = fexp2(lgf2 * (float)(iloc + 1)), wb = fexp2(lgb2 * (float)(127 - iloc));
#pragma unroll 1
    for (int eb = 0; eb < 4; ++eb) {
        const int ebn = eb < 3 ? eb + 1 : 3;
        const char* nA = sfU + (size_t)ebn * 8192; const char* nB = sbU + (size_t)ebn * 8192;
        f32x16 xf, xb;
#pragma unroll
        for (int r = 0; r < 16; ++r) { xf[r] = 0.f; xb[r] = 0.f; }
#pragma unroll
        for (int kk = 0; kk < 8; ++kk) {
            xf = MFMA32(fa[kk], qf[kk], xf);
            fa[kk] = *(const bf16x8*)(nA + 1024 * kk + sL);
            xb = MFMA32(fb[kk], qf[kk], xb);
            fb[kk] = *(const bf16x8*)(nB + 1024 * kk + sL);
        }
#pragma unroll
        for (int e2 = 0; e2 < 4; ++e2)
            if (e2 == eb) {
#pragma unroll
                for (int r = 0; r < 16; ++r) O[e2][r] += wf * xf[r] + wb * xb[r];
            }
    }
    float sum = 0.f;
#pragma unroll
    for (int eb = 0; eb < 4; ++eb)
#pragma unroll
        for (int r = 0; r < 16; ++r) sum += O[eb][r];
    sum += __shfl_xor(sum, 32);
    const float mu = sum * (1.0f / 128.0f);
    float var = 0.f;
#pragma unroll
    for (int eb = 0; eb < 4; ++eb)
#pragma unroll
        for (int r = 0; r < 16; ++r) { O[eb][r] -= mu; var += O[eb][r] * O[eb][r]; }
    var += __shfl_xor(var, 32);
    const float rinv = rsqrtf(var * (1.0f / 128.0f) + EPS);
    const float* cng = p.in[I_CNG] + h * 128;
#pragma unroll
    for (int eb = 0; eb < 4; ++eb)
#pragma unroll
        for (int g = 0; g < 4; ++g) {
            const f32x4 gg = *(const f32x4*)(cng + 32 * eb + 8 * g + 4 * hi);
            O[eb][4 * g] *= rinv * gg.x; O[eb][4 * g + 1] *= rinv * gg.y; O[eb][4 * g + 2] *= rinv * gg.z; O[eb][4 * g + 3] *= rinv * gg.w;
        }
    const size_t tok = tok0 + iloc;
    write_y<4>(O, Z + tok * PZ + 2304 + h * 128, Y + tok * DM + h * 128, hi);
}

template <bool LAT>
__device__ __forceinline__ void retout_block(const Params& p, int sh, int c, unsigned char* lds, int tid) {
    unsigned char* ws = p.ws;
    constexpr int NS = LAT ? 4096 : 256, NCH = LAT ? 32 : 2;
    constexpr int KL = 0, VL = 34816, SFL = VL + 32768, SBL = SFL + 32768, RED = SBL + 32768;
    const bf16_t* Z = (const bf16_t*)(ws + WS_Z); bf16_t* Y = (bf16_t*)(ws + WS_XN);
    const int h = sh & 3, seq = sh >> 2;
    const int lane = tid & 63, wave = tid >> 6, i = lane & 31, hi = lane >> 5, ib = wave & 3, eh = wave >> 2;
    const int pi = (i & 0x13) | ((i & 4) << 1) | ((i & 8) >> 1);
    const size_t tok0 = LAT ? (size_t)NCTXTOK + (size_t)seq * 4096 + c * 128 : (size_t)seq * 256 + c * 128;
    const int iloc = ib * 32 + i;
    {
        const bf16_t* ksrc = Z + (tok0 + (tid >> 2)) * PZ + 512 + h * 128 + (tid & 3) * 32;
        const char* vsrc = (const char*)((const bf16_t*)(ws + (LAT ? L1_VTL : L1_VTC)) + (size_t)sh * 128 * NS + (size_t)c * 16384);
        const char* fsrc = (const char*)((const bf16_t*)(ws + (LAT ? L1_STF_L : L1_STF_C)) + ((size_t)sh * NCH + c) * 16384);
        const char* bsrc = (const char*)((const bf16_t*)(ws + (LAT ? L1_STB_L : L1_STB_C)) + ((size_t)sh * NCH + c) * 16384);
        u32x4 kr[4], vr[4], fr[4], br[4];
#pragma unroll
        for (int q = 0; q < 4; ++q) {
            kr[q] = *(const u32x4*)(ksrc + q * 8);
            vr[q] = *(const u32x4*)(vsrc + (size_t)(tid + 512 * q) * 16);
            fr[q] = *(const u32x4*)(fsrc + (size_t)(tid + 512 * q) * 16);
            br[q] = *(const u32x4*)(bsrc + (size_t)(tid + 512 * q) * 16);
        }
        __syncthreads();
#pragma unroll
        for (int q = 0; q < 4; ++q) {
            *(u32x4*)(lds + KL + (tid >> 2) * 272 + (tid & 3) * 64 + q * 16) = kr[q];
            *(u32x4*)(lds + VL + (tid + 512 * q) * 16) = vr[q];
            *(u32x4*)(lds + SFL + (tid + 512 * q) * 16) = fr[q];
            *(u32x4*)(lds + SBL + (tid + 512 * q) * 16) = br[q];
        }
    }
    bf16x8 qf[8];
    {
        const bf16_t* zq = Z + (tok0 + iloc) * PZ + h * 128;
#pragma unroll
        for (int kk = 0; kk < 8; ++kk) qf[kk] = *(const bf16x8*)(zq + 16 * kk + 8 * hi);
    }
    const float lgf2 = -expf(p.in[I_DECF][h]) * LOG2E, lgb2 = -expf(p.in[I_DECB][h]) * LOG2E;
    __syncthreads();
    f32x16 O[2];
#pragma unroll
    for (int e2 = 0; e2 < 2; ++e2)
#pragma unroll
        for (int r = 0; r < 16; ++r) O[e2][r] = 0.f;
    const unsigned char* kbase = lds + KL + pi * 272 + hi * 16;
    const unsigned char* vbase = lds + VL + (2 * eh) * 8192 + lane * 16;
#pragma unroll 1
    for (int jb = 0; jb < 4; ++jb) {
        f32x16 s;
#pragma unroll
        for (int r = 0; r < 16; ++r) s[r] = 0.f;
#pragma unroll
        for (int kk = 0; kk < 8; ++kk) s = MFMA32(*(const bf16x8*)(kbase + jb * 32 * 272 + kk * 32), qf[kk], s);
#pragma unroll
        for (int r = 0; r < 16; ++r) {
            const int j = 32 * jb + 16 * (r >> 3) + 8 * hi + (r & 7);
            const int dl = iloc - j;
            const float w = dl >= 0 ? fexp2(lgf2 * (float)dl) : fexp2(lgb2 * (float)(-dl - 1));
            s[r] *= w * KSCALE_C;
        }
        u32x4 w0, w1;
        w0.x = cvtpk(s[0], s[1]); w0.y = cvtpk(s[2], s[3]); w0.z = cvtpk(s[4], s[5]); w0.w = cvtpk(s[6], s[7]);
        w1.x = cvtpk(s[8], s[9]); w1.y = cvtpk(s[10], s[11]); w1.z = cvtpk(s[12], s[13]); w1.w = cvtpk(s[14], s[15]);
        const bf16x8 p0 = __builtin_bit_cast(bf16x8, w0), p1 = __builtin_bit_cast(bf16x8, w1);
#pragma unroll
        for (int e2 = 0; e2 < 2; ++e2) {
            O[e2] = MFMA32(*(const bf16x8*)(vbase + e2 * 8192 + jb * 2048), p0, O[e2]);
            O[e2] = MFMA32(*(const bf16x8*)(vbase + e2 * 8192 + jb * 2048 + 1024), p1, O[e2]);
        }
    }
    const float wf = fexp2(lgf2 * (float)(iloc + 1)), wb = fexp2(lgb2 * (float)(127 - iloc));
#pragma unroll
    for (int e2 = 0; e2 < 2; ++e2) {
        f32x16 xf, xb;
#pragma unroll
        for (int r = 0; r < 16; ++r) { xf[r] = 0.f; xb[r] = 0.f; }
        const unsigned char* sf = lds + SFL + (2 * eh + e2) * 8192 + lane * 16;
        const unsigned char* sb = lds + SBL + (2 * eh + e2) * 8192 + lane * 16;
#pragma unroll
        for (int kk = 0; kk < 8; ++kk) {
            xf = MFMA32(*(const bf16x8*)(sf + kk * 1024), qf[kk], xf);
            xb = MFMA32(*(const bf16x8*)(sb + kk * 1024), qf[kk], xb);
        }
#pragma unroll
        for (int r = 0; r < 16; ++r) O[e2][r] += wf * xf[r] + wb * xb[r];
    }
    float s1 = 0.f, s2 = 0.f;
#pragma unroll
    for (int e2 = 0; e2 < 2; ++e2)
#pragma unroll
        for (int r = 0; r < 16; ++r) { s1 += O[e2][r]; s2 += O[e2][r] * O[e2][r]; }
    s1 += __shfl_xor(s1, 32); s2 += __shfl_xor(s2, 32);
    float* red = (float*)(lds + RED);
    if (hi == 0) { red[(eh * 128 + iloc) * 2] = s1; red[(eh * 128 + iloc) * 2 + 1] = s2; }
    __syncthreads();
    {
        const float o1 = red[((1 - eh) * 128 + iloc) * 2], o2 = red[((1 - eh) * 128 + iloc) * 2 + 1];
        s1 += o1; s2 += o2;
    }
    const float mu = s1 * (1.0f / 128.0f);
    const float var = fmaxf(s2 * (1.0f / 128.0f) - mu * mu, 0.f);
    const float rinv = rsqrtf(var + EPS);
    const float* cng = p.in[I_CNG] + h * 128 + 64 * eh;
#pragma unroll
    for (int e2 = 0; e2 < 2; ++e2)
#pragma unroll
        for (int g = 0; g < 4; ++g) {
            const f32x4 gg = *(const f32x4*)(cng + 32 * e2 + 8 * g + 4 * hi);
            O[e2][4 * g] = (O[e2][4 * g] - mu) * rinv * gg.x; O[e2][4 * g + 1] = (O[e2][4 * g + 1] - mu) * rinv * gg.y;
            O[e2][4 * g + 2] = (O[e2][4 * g + 2] - mu) * rinv * gg.z; O[e2][4 * g + 3] = (O[e2][4 * g + 3] - mu) * rinv * gg.w;
        }
    const size_t tok = tok0 + iloc;
    write_y<2>(O, Z + tok * PZ + 2304 + h * 128 + 64 * eh, Y + tok * DM + h * 128 + 64 * eh, hi);
}

__global__ void __launch_bounds__(512) mega_fwd(Params p) {
    extern __shared__ __attribute__((aligned(16))) unsigned char lds[];
    cg::grid_group grid = cg::this_grid();
    const int blk = blockIdx.x, G = gridDim.x;
    const int vb = (G % 8 == 0) ? (blk % 8) * (G / 8) + blk / 8 : blk;
    const int NGW = G * 8;
    unsigned char* ws = p.ws;
    bf16_t* XN = (bf16_t*)(ws + WS_XN); bf16_t* Zb = (bf16_t*)(ws + WS_Z);
    const float* mod0 = (const float*)(ws + WS_MOD); const float* mod1 = mod0 + 9 * 3072;
    LAS unsigned char* lds3 = (LAS unsigned char*)lds;
#define FRESH() int tid = threadIdx.x; asm volatile("" : "+v"(tid)); const int lane = tid & 63, wave = __builtin_amdgcn_readfirstlane(tid >> 6), gw = blk * 8 + wave; (void)lane; (void)gw;

    unsigned* barw = (unsigned*)(ws + WS_BAR);
    volatile LAS unsigned* bst = (volatile LAS unsigned*)(lds3 + LDS_BAR);
    if (threadIdx.x < 2) bst[threadIdx.x] = 0u;
    if (blk == 0) for (int w = threadIdx.x; w < XCD_BAR_WORDS; w += 512) barw[w] = 0u;
    __syncthreads();
    for (int rs_ = 0; rs_ < REP_SM; ++rs_) { FRESH(); phase0(p, lds, tid, blk, G); __syncthreads(); }
    grid.sync();
    XcdBarrier bar = xcd_barrier_post(barw, bst);
#define GSYNC() xcd_barrier(bar)
    for (int rs_ = 0; rs_ < REP_SM; ++rs_) { FRESH(); adaln_rows(p.in[I_XP], p.in[I_XS], p.in[I_NORMG], mod0, XN, gw, NGW, lane); }
    GSYNC();
    for (int rg_ = 0; rg_ < REP_G2; ++rg_) {
        pg8::Gemm g{XN, (const bf16_t*)(ws + WS_WIN_AB), MTOT, PZ, DM}; pg8::StaticOrder S; S.init(MTOT, PZ, G, blk);
        pg8::EpiBf16<0> E{Zb, PZ, nullptr, 0, 0, 1.f};
        pg8::gemm_phase<pg8::EpiBf16<0>, pg8::StaticOrder, true, true>(lds3, g, S, E);
    }
    GSYNC();
    for (int rs_ = 0; rs_ < REP_PREP; ++rs_) { FRESH(); prep_layer0(p, lds, tid, blk, G); }
    GSYNC();
    for (int rep_ = 0; rep_ < REP_P4; ++rep_) {
        if (PHM & 16) { FRESH(); for (int u = vb; u < 512; u += G) unit_B<true>(p, u, lds, tid); }
        for (int ra_ = 0; ra_ < REP_A; ++ra_) { FRESH(); for (int u = vb; u < 512; u += G) unit_A2(p, u, lds, tid); }
        if (PHM & 64) { FRESH(); for (int u = vb; u < 128; u += G) unit_A<false>(p, u, lds, tid); }
        if (PHM & 128) { FRESH(); for (int u = (vb + 8 * G - 128) % G; u < 64; u += G) unit_B<false>(p, u, lds, tid); }
    }
    GSYNC();
    if (PHM & 256) {
        pg8::Gemm g{XN, (const bf16_t*)(ws + WS_WOUT_AB), MTOT, DM, DM}; pg8::StaticOrder S; S.init(MTOT, DM, G, blk);
        EpiResid E{p.in[I_XP], p.in[I_XS], p.out, mod0};
        pg8::gemm_phase<EpiResid, pg8::StaticOrder, true, true>(lds3, g, S, E);
    }
    GSYNC();
    for (int rs_ = 0; rs_ < REP_SM; ++rs_) { FRESH(); adaln_rows(p.out, p.out + (size_t)NCTXTOK * DM, p.in[I_NORMG] + DM, mod1, XN, gw, NGW, lane); }
    GSYNC();
    {
        pg8::Gemm g{XN, (const bf16_t*)(ws + WS_WIN_CD), MTOT, PZ, DM}; pg8::StaticOrder S; S.init(MTOT, PZ, G, blk);
        pg8::EpiBf16<0> E{Zb, PZ, nullptr, 0, 0, 1.f};
        pg8::gemm_phase<pg8::EpiBf16<0>, pg8::StaticOrder, true, true>(lds3, g, S, E);
    }
    GSYNC();
    for (int rs_ = 0; rs_ < REP_PREP; ++rs_) { FRESH(); prep_layer1(p, lds, tid, blk, G); }
    GSYNC();
    for (int rs_ = 0; rs_ < REP_SCAN; ++rs_) {
        FRESH(); const int sw = wave * G + blk;
        for (int u = sw; u < 1024 + 2048; u += NGW) { if (u < 1024) scan_unit<true>(p, u, lane); else scan_unit<false>(p, u - 1024, lane); }
    }
    GSYNC();
    for (int rep_ = 0; rep_ < REP_P10; ++rep_) {
        if (PHM & 2048) { FRESH(); for (int u = vb; u < 512; u += G) unit_D2(p, u, lds, tid); }
        if (PHM & 2048) { FRESH(); for (int u = (vb + 8 * G - 128) % G; u < 128; u += G) unit_D<false>(p, u, lds, tid); }
        for (int rr_ = 0; rr_ < REP_RET; ++rr_) { FRESH();
            for (int u = vb; u < 1152; u += G) { if (u < 1024) retout_block<true>(p, u >> 5, u & 31, lds, tid); else retout_block<false>(p, (u - 1024) >> 1, (u - 1024) & 1, lds, tid); }
            __syncthreads(); }
    }
    GSYNC();
    {
        pg8::Gemm g{XN, (const bf16_t*)(ws + WS_WOUT_CD), MTOT, DM, DM}; pg8::StaticOrder S; S.init(MTOT, DM, G, blk);
        EpiResid E{p.out, p.out + (size_t)NCTXTOK * DM, p.out, mod1};
        pg8::gemm_phase<EpiResid, pg8::StaticOrder, true, true>(lds3, g, S, E);
    }
    GSYNC();
    { FRESH(); final_rows(p.out, p.in[I_FING], gw, NGW, lane); }
}

extern "C" void kernel_launch(void* const* d_in, const int* in_sizes, int n_in, void* d_out, int out_size, void* d_ws, size_t ws_size, hipStream_t stream) {
    static int grid = 0;
    if (grid == 0) {
        if (n_in != 31 || (size_t)out_size != O_END || ws_size < WS_NEED) {
            fprintf(stderr, "kernel_launch: unexpected problem: n_in %d out %d ws %zu (need %zu)\n", n_in, out_size, ws_size, (size_t)WS_NEED); grid = -1; return; }
        int dev = 0, cus = 0, per_cu = 0;
        hipGetDevice(&dev);
        hipDeviceGetAttribute(&cus, hipDeviceAttributeMultiprocessorCount, dev);
        if (hipFuncSetAttribute((const void*)mega_fwd, hipFuncAttributeMaxDynamicSharedMemorySize, LDS_BYTES) != hipSuccess) { fprintf(stderr, "kernel_launch: hipFuncSetAttribute failed\n"); }
        if (hipOccupancyMaxActiveBlocksPerMultiprocessor(&per_cu, (const void*)mega_fwd, 512, LDS_BYTES) != hipSuccess || per_cu < 1) { fprintf(stderr, "kernel_launch: occupancy query gave %d\n", per_cu); per_cu = 1; }
        (void)hipGetLastError();
        if (per_cu > 1) per_cu = 1;
        grid = cus * per_cu;
    }
    if (grid < 0) return;
    Params p{};
    for (int i = 0; i < 31; ++i) p.in[i] = (const float*)d_in[i];
    p.out = (float*)d_out; p.ws = (unsigned char*)d_ws;
    void* args[] = {&p};
    hipError_t e = hipLaunchCooperativeKernel((const void*)mega_fwd, dim3(grid), dim3(512), args, LDS_BYTES, stream);
    if (e != hipSuccess) fprintf(stderr, "kernel_launch: cooperative launch failed: %s (grid %d)\n", hipGetErrorString(e), grid);
}
```
